# Optimizing an MI355X kernel written in HIP

```python
import math, functools
import jax, jax.numpy as jnp
from jax import lax
import numpy as np

D_MODEL = 2048
BATCH = 2
SEQ = 8192
DEPTH = 1
DEC_BATCH = 32
DEC_SEQ = 32
PAST_LEN = 2048

CHUNK = 64
D_MIX = D_MODEL
D_SSM = D_MIX // 2
SSM_GROUP = 16
N_SSM_GROUPS = D_SSM // SSM_GROUP
SSM_STATE = 64
D_ATTN = D_MIX - D_SSM
HEAD_DIM = 128
N_HEADS = D_ATTN // HEAD_DIM
D_IN = D_SSM + 3 * D_ATTN + N_HEADS
D_FF = 4 * D_MODEL
Q_BLOCK = 128
EPS = 1e-6
DT_MIN = 1e-3
DT_MAX = 1e-1
FORGET_BIAS = 3.0
NEG_INF = -1e30

kernel_name = 'hymba_s5_fox_stream_step'


def rmsnorm(x, g):
    x32 = x.astype(jnp.float32)
    y = x32 * lax.rsqrt(jnp.mean(x32 * x32, axis=-1, keepdims=True) + EPS)
    return (y * g.astype(jnp.float32)).astype(x.dtype)


def _cmul(ar, ai, br, bi):
    return ar * br - ai * bi, ar * bi + ai * br


def _scan_combine(e1, e2):
    a1r, a1i, b1r, b1i = e1
    a2r, a2i, b2r, b2i = e2
    ar, ai = _cmul(a2r, a2i, a1r, a1i)
    br, bi = _cmul(a2r, a2i, b1r, b1i)
    return ar, ai, br + b2r, bi + b2i


def s5_mixer(u, h0_re, h0_im, a_re, a_im, log_step, b_re, b_im, c_re, c_im, d, w_glu):
    n, l, _ = u.shape
    f32 = jnp.float32
    u32 = u.astype(f32).reshape(n, l, N_SSM_GROUPS, SSM_GROUP)
    a_re = a_re.astype(f32)
    a_im = a_im.astype(f32)
    step = jnp.exp(log_step.astype(f32))[:, None]
    mag = jnp.exp(a_re * step)
    abar_re = mag * jnp.cos(a_im * step)
    abar_im = mag * jnp.sin(a_im * step)
    den = a_re * a_re + a_im * a_im
    nr = abar_re - 1.0
    ni = abar_im
    fr = (nr * a_re + ni * a_im) / den
    fi = (ni * a_re - nr * a_im) / den
    b_re = b_re.astype(f32)
    b_im = b_im.astype(f32)
    bbar_re = fr[..., None] * b_re - fi[..., None] * b_im
    bbar_im = fr[..., None] * b_im + fi[..., None] * b_re
    bu_re = jnp.einsum('nlgh,gph->nlgp', u32, bbar_re)
    bu_im = jnp.einsum('nlgh,gph->nlgp', u32, bbar_im)
    ih_re, ih_im = _cmul(abar_re, abar_im, h0_re.astype(f32), h0_im.astype(f32))
    bu_re = bu_re.at[:, 0].add(ih_re)
    bu_im = bu_im.at[:, 0].add(ih_im)
    a_br = jnp.broadcast_to(abar_re, bu_re.shape)
    a_bi = jnp.broadcast_to(abar_im, bu_im.shape)
    _, _, h_re, h_im = lax.associative_scan(_scan_combine, (a_br, a_bi, bu_re, bu_im), axis=1)
    y = (jnp.einsum('nlgp,ghp->nlgh', h_re, c_re.astype(f32))
         - jnp.einsum('nlgp,ghp->nlgh', h_im, c_im.astype(f32))
         + d.astype(f32) * u32)
    y = y.reshape(n, l, D_SSM)
    gy = jax.nn.gelu(y)
    out = gy * jax.nn.sigmoid(gy @ w_glu.astype(f32))
    return out.astype(u.dtype), h_re[:, -1], h_im[:, -1]


def _attend(q, cq, q_pos, k, v, ck, k_pos):
    s = jnp.einsum('nqhd,nkhd->nhqk', q, k).astype(jnp.float32) * (HEAD_DIM ** -0.5)
    s = s + jnp.transpose(cq, (0, 2, 1))[..., None] - jnp.transpose(ck, (0, 2, 1))[:, :, None, :]
    mask = k_pos[None, :] <= q_pos[:, None]
    s = jnp.where(mask, s, NEG_INF)
    p = jax.nn.softmax(s, axis=-1)
    return jnp.einsum('nhqk,nkhd->nqhd', p.astype(v.dtype), v)


def fox_prompt(q, k, v, logf):
    n, l = q.shape[0], q.shape[1]
    c = jnp.cumsum(logf.astype(jnp.float32), axis=1)
    pos = jnp.arange(l)

    def block(i):
        start = i * Q_BLOCK
        qb = lax.dynamic_slice_in_dim(q, start, Q_BLOCK, axis=1)
        cb = lax.dynamic_slice_in_dim(c, start, Q_BLOCK, axis=1)
        qp = start + jnp.arange(Q_BLOCK)
        return _attend(qb, cb, qp, k, v, c, pos)

    o = lax.map(block, jnp.arange(l // Q_BLOCK))
    return jnp.transpose(o, (1, 0, 2, 3, 4)).reshape(n, l, D_ATTN)


def fox_sample(q, k, v, logf, cache_k, cache_v, cache_logf):
    n, s = q.shape[0], q.shape[1]
    past = cache_k.shape[1]
    k_all = jnp.concatenate([cache_k.astype(k.dtype), k], axis=1)
    v_all = jnp.concatenate([cache_v.astype(v.dtype), v], axis=1)
    c_all = jnp.cumsum(jnp.concatenate([cache_logf.astype(jnp.float32), logf.astype(jnp.float32)], axis=1), axis=1)
    k_pos = jnp.arange(past + s)
    q_pos = past + jnp.arange(s)
    o = _attend(q, c_all[:, past:], q_pos, k_all, v_all, c_all, k_pos)
    return o.reshape(n, s, D_ATTN)


def trunk_layer(x, h0_re, h0_im, attn_fn, g_norm_mix, w_in, b_f, a_re, a_im, log_step,
                b_re, b_im, c_re, c_im, d, w_glu, g_q, g_k, g_out_ssm, g_out_attn,
                w_out, g_norm_mlp, w_up, w_down):
    lead = x.shape[:2]
    h = rmsnorm(x, g_norm_mix)
    z = h @ w_in
    u = z[..., :D_SSM]
    q = z[..., D_SSM:D_SSM + D_ATTN].reshape(lead + (N_HEADS, HEAD_DIM))
    k = z[..., D_SSM + D_ATTN:D_SSM + 2 * D_ATTN].reshape(lead + (N_HEADS, HEAD_DIM))
    v = z[..., D_SSM + 2 * D_ATTN:D_SSM + 3 * D_ATTN].reshape(lead + (N_HEADS, HEAD_DIM))
    logf = jax.nn.log_sigmoid((z[..., D_SSM + 3 * D_ATTN:] + b_f).astype(jnp.float32))
    q = rmsnorm(q, g_q)
    k = rmsnorm(k, g_k)
    ssm_out, h_re, h_im = s5_mixer(u, h0_re, h0_im, a_re, a_im, log_step, b_re, b_im, c_re, c_im, d, w_glu)
    attn_out = attn_fn(q, k, v, logf)
    mix = jnp.concatenate([rmsnorm(ssm_out, g_out_ssm), rmsnorm(attn_out.astype(x.dtype), g_out_attn)], axis=-1)
    x = x + mix @ w_out
    hm = rmsnorm(x, g_norm_mlp)
    x = x + jnp.square(jax.nn.relu(hm @ w_up)) @ w_down
    return x, k, v, logf, h_re, h_im


def setup_inputs(seed: int = 0) -> dict:
    key = jax.random.key(seed)
    ks = jax.random.split(key, 32)
    f32 = jnp.float32

    def nrm(k, shape, scale):
        return jax.random.normal(k, shape, f32) * scale

    def gain(k, shape):
        return 1.0 + 0.02 * jax.random.normal(k, shape, f32)

    G, P, H = N_SSM_GROUPS, SSM_STATE, SSM_GROUP
    x_prompt = nrm(ks[0], (BATCH, SEQ, D_MODEL), 1.0)
    x_sample = nrm(ks[1], (DEC_BATCH, DEC_SEQ, D_MODEL), 1.0)
    cache_k = nrm(ks[2], (DEPTH, DEC_BATCH, PAST_LEN, N_HEADS, HEAD_DIM), 1.0)
    cache_v = nrm(ks[3], (DEPTH, DEC_BATCH, PAST_LEN, N_HEADS, HEAD_DIM), 1.0)
    cache_logf = jax.nn.log_sigmoid(FORGET_BIAS + jax.random.normal(ks[4], (DEPTH, DEC_BATCH, PAST_LEN, N_HEADS), f32))
    state_ssm_re = nrm(ks[5], (DEPTH, DEC_BATCH, G, P), 0.5)
    state_ssm_im = nrm(ks[6], (DEPTH, DEC_BATCH, G, P), 0.5)
    g_norm_mix = gain(ks[7], (DEPTH, D_MODEL))
    w_in = nrm(ks[8], (DEPTH, D_MODEL, D_IN), D_MODEL ** -0.5)
    b_f = FORGET_BIAS + nrm(ks[9], (DEPTH, N_HEADS), 0.1)
    n_idx = jnp.arange(P, dtype=f32)
    ssm_a_re = -0.5 + nrm(ks[10], (DEPTH, G, P), 0.01)
    ssm_a_im = math.pi * n_idx + nrm(ks[11], (DEPTH, G, P), 0.01)
    ssm_log_step = jax.random.uniform(ks[12], (DEPTH, G), f32, math.log(DT_MIN), math.log(DT_MAX))
    ssm_b_re = nrm(ks[13], (DEPTH, G, P, H), (2 * H) ** -0.5)
    ssm_b_im = nrm(ks[14], (DEPTH, G, P, H), (2 * H) ** -0.5)
    ssm_c_re = nrm(ks[15], (DEPTH, G, H, P), P ** -0.5)
    ssm_c_im = nrm(ks[16], (DEPTH, G, H, P), P ** -0.5)
    ssm_d = nrm(ks[17], (DEPTH, G, H), 1.0)
    w_glu = nrm(ks[18], (DEPTH, D_SSM, D_SSM), D_SSM ** -0.5)
    g_q = gain(ks[19], (DEPTH, HEAD_DIM))
    g_k = gain(ks[20], (DEPTH, HEAD_DIM))
    g_out_ssm = gain(ks[21], (DEPTH, D_SSM))
    g_out_attn = gain(ks[22], (DEPTH, D_ATTN))
    w_out = nrm(ks[23], (DEPTH, D_MIX, D_MODEL), D_MIX ** -0.5)
    g_norm_mlp = gain(ks[24], (DEPTH, D_MODEL))
    w_up = nrm(ks[25], (DEPTH, D_MODEL, D_FF), D_MODEL ** -0.5)
    w_down = nrm(ks[26], (DEPTH, D_FF, D_MODEL), D_FF ** -0.5)
    return {'x_prompt': x_prompt, 'x_sample': x_sample,
            'cache_k': cache_k, 'cache_v': cache_v, 'cache_logf': cache_logf,
            'state_ssm_re': state_ssm_re, 'state_ssm_im': state_ssm_im,
            'g_norm_mix': g_norm_mix, 'w_in': w_in, 'b_f': b_f,
            'ssm_a_re': ssm_a_re, 'ssm_a_im': ssm_a_im, 'ssm_log_step': ssm_log_step,
            'ssm_b_re': ssm_b_re, 'ssm_b_im': ssm_b_im, 'ssm_c_re': ssm_c_re, 'ssm_c_im': ssm_c_im,
            'ssm_d': ssm_d, 'w_glu': w_glu, 'g_q': g_q, 'g_k': g_k,
            'g_out_ssm': g_out_ssm, 'g_out_attn': g_out_attn, 'w_out': w_out,
            'g_norm_mlp': g_norm_mlp, 'w_up': w_up, 'w_down': w_down}


def reference(x_prompt, x_sample, cache_k, cache_v, cache_logf, state_ssm_re, state_ssm_im,
              g_norm_mix, w_in, b_f, ssm_a_re, ssm_a_im, ssm_log_step, ssm_b_re, ssm_b_im,
              ssm_c_re, ssm_c_im, ssm_d, w_glu, g_q, g_k, g_out_ssm, g_out_attn, w_out,
              g_norm_mlp, w_up, w_down):
    y_p = x_prompt
    y_s = x_sample
    kp, vp, lfp, hrp, hip = [], [], [], [], []
    ks_, vs_, lfs, hrs, his = [], [], [], [], []
    for l in range(DEPTH):
        w = (g_norm_mix[l], w_in[l], b_f[l], ssm_a_re[l], ssm_a_im[l], ssm_log_step[l],
             ssm_b_re[l], ssm_b_im[l], ssm_c_re[l], ssm_c_im[l], ssm_d[l], w_glu[l],
             g_q[l], g_k[l], g_out_ssm[l], g_out_attn[l], w_out[l], g_norm_mlp[l], w_up[l], w_down[l])
        h0 = jnp.zeros((y_p.shape[0], N_SSM_GROUPS, SSM_STATE), jnp.float32)
        y_p, k1, v1, lf1, hr1, hi1 = trunk_layer(y_p, h0, h0, fox_prompt, *w)
        samp_attn = functools.partial(fox_sample, cache_k=cache_k[l], cache_v=cache_v[l], cache_logf=cache_logf[l])
        y_s, k2, v2, lf2, hr2, hi2 = trunk_layer(y_s, state_ssm_re[l], state_ssm_im[l], samp_attn, *w)
        kp.append(k1); vp.append(v1); lfp.append(lf1); hrp.append(hr1); hip.append(hi1)
        ks_.append(k2); vs_.append(v2); lfs.append(lf2); hrs.append(hr2); his.append(hi2)
    return (y_p, y_s,
            jnp.stack(kp), jnp.stack(vp), jnp.stack(lfp), jnp.stack(hrp), jnp.stack(hip),
            jnp.stack(ks_), jnp.stack(vs_), jnp.stack(lfs), jnp.stack(hrs), jnp.stack(his))
```

```cpp
#include <hip/hip_runtime.h>
#include <hip/hip_cooperative_groups.h>
#include <cstdio>
#include <cstdint>
namespace cg = cooperative_groups;
#ifndef PHMASK
#define PHMASK 2047
#endif
#ifndef DBL
#define DBL 0
#endif
#define REPS(bit) (((DBL) & (bit)) ? 2 : 1)

#define LAS __attribute__((address_space(3)))
typedef unsigned short bf16;
typedef short bf16x8 __attribute__((ext_vector_type(8)));
typedef short s16x4 __attribute__((ext_vector_type(4)));
typedef float f32x4 __attribute__((ext_vector_type(4)));
typedef float f32x16 __attribute__((ext_vector_type(16)));
typedef unsigned u32x4 __attribute__((ext_vector_type(4)));
typedef unsigned u32x2 __attribute__((ext_vector_type(2)));

constexpr int DM = 2048, MP = 16384, MS = 1024, MT = MP + MS, SEQ = 8192, NH = 8, HD = 128, DSSM = 1024, DATT = 1024, DFF = 8192;
constexpr int NINW = 4104, PAST = 2048, DSEQ = 32, DB = 32, NG = 64, NP = 64;
constexpr float EPS = 1e-6f;
constexpr float LOG2E = 1.4426950408889634f;
constexpr float QSCALE = 0.08838834764831845f * 1.4426950408889634f;

constexpr size_t O_Y = 0, O_KP = 35651584, O_VP = 52428800, O_LFP = 69206016, O_HRP = 69337088, O_HIP = 69345280,
                 O_KS = 69353472, O_VS = 70402048, O_LFS = 71450624, O_HRS = 71458816, O_HIS = 71589888;

constexpr size_t MiB = 1u << 20;
constexpr size_t WS_WIN = 1 * MiB;
constexpr size_t WS_WGLU = 17 * MiB;
constexpr size_t WS_WOUT = 19 * MiB;
constexpr size_t WS_WUP = 27 * MiB;
constexpr size_t WS_WDN = 59 * MiB;
constexpr size_t WS_SMALL = 91 * MiB;
constexpr size_t WS_XB = 96 * MiB;
constexpr size_t WS_U = 164 * MiB;
constexpr size_t WS_QKRAW = 198 * MiB;
constexpr size_t WS_QH = 334 * MiB;
constexpr size_t WS_KH = 368 * MiB;
constexpr size_t WS_VH = 402 * MiB;
constexpr size_t WS_GY = 436 * MiB;
constexpr size_t WS_MIX = 470 * MiB;
constexpr size_t WS_X1B = 538 * MiB;
constexpr size_t WS_H = 606 * MiB;
constexpr size_t WS_END = 878 * MiB;
constexpr size_t SM_RS1 = 0;
constexpr size_t SM_ABAR = 128 * 1024;
constexpr size_t SM_APOW = 192 * 1024;
constexpr size_t SM_CLF = 4 * MiB;
constexpr size_t SM_S5EX = 3 * MiB;
constexpr size_t SM_BMT = 256 * 1024;
constexpr size_t SM_CMT = 512 * 1024;
constexpr size_t SM_SSQ1 = 1 * MiB;
constexpr size_t SM_SSQ2 = 2 * MiB + 256 * 1024;
constexpr size_t SM_SSQ3 = 3 * MiB;
constexpr size_t WS_CLK = 878 * MiB;
constexpr size_t WS_CLQ = 882 * MiB;
constexpr size_t WS_SSQ3 = 886 * MiB;
constexpr size_t WS_TOTAL = 890 * MiB;

constexpr int RING_BYTES = 131072, AUX_OFF = 131072, AUX_BYTES = 32768, LDS_BYTES = 163840;

__device__ __forceinline__ int opaque_tid(int wave) { int t = (wave << 6) | (int)__builtin_amdgcn_mbcnt_hi(~0u, __builtin_amdgcn_mbcnt_lo(~0u, 0u)); asm volatile("" : "+v"(t)); return t; }
__device__ __forceinline__ unsigned f2bf(float f) { unsigned u = __builtin_bit_cast(unsigned, f); return (u + 0x7fffu + ((u >> 16) & 1u)) >> 16; }
__device__ __forceinline__ float bf2f(unsigned short b) { return __builtin_bit_cast(float, (unsigned)b << 16); }
__device__ __forceinline__ unsigned pk2(float lo, float hi) { return f2bf(lo) | (f2bf(hi) << 16); }
__device__ __forceinline__ unsigned cvtpk(float lo, float hi) { unsigned r; asm volatile("v_cvt_pk_bf16_f32 %0, %1, %2" : "=v"(r) : "v"(lo), "v"(hi)); return r; }
__device__ __forceinline__ unsigned cvtpk_nv(float lo, float hi) { unsigned r; asm("v_cvt_pk_bf16_f32 %0, %1, %2" : "=v"(r) : "v"(lo), "v"(hi)); return r; }
__device__ __forceinline__ bf16x8 pack8(f32x4 a, f32x4 b) { u32x4 w = {cvtpk(a[0], a[1]), cvtpk(a[2], a[3]), cvtpk(b[0], b[1]), cvtpk(b[2], b[3])}; return __builtin_bit_cast(bf16x8, w); }
__device__ __forceinline__ void st16_wt(void* p, u32x4 v) { asm volatile("global_store_dwordx4 %0, %1, off sc1\n\ts_nop 1" :: "v"(p), "v"(v) : "memory"); }
template <int K> __device__ __forceinline__ float lane_xor(float v) {
    return __builtin_bit_cast(float, __builtin_amdgcn_ds_swizzle(__builtin_bit_cast(int, v), (K << 10) | 0x1f));
}
__device__ __forceinline__ float half_swap_add(float v) { auto rr = __builtin_amdgcn_permlane32_swap(__float_as_uint(v), __float_as_uint(v), false, false); return __uint_as_float(rr[0]) + __uint_as_float(rr[1]); }
__device__ __forceinline__ float half_swap_max(float v) { auto rr = __builtin_amdgcn_permlane32_swap(__float_as_uint(v), __float_as_uint(v), false, false); return fmaxf(__uint_as_float(rr[0]), __uint_as_float(rr[1])); }
__device__ __forceinline__ float sum32(float v) { v += lane_xor<1>(v); v += lane_xor<2>(v); v += lane_xor<4>(v); v += lane_xor<8>(v); v += lane_xor<16>(v); return v; }
__device__ __forceinline__ float max32(float v) { v = fmaxf(v, lane_xor<1>(v)); v = fmaxf(v, lane_xor<2>(v)); v = fmaxf(v, lane_xor<4>(v)); v = fmaxf(v, lane_xor<8>(v)); v = fmaxf(v, lane_xor<16>(v)); return v; }
__device__ __forceinline__ float wave_sum(float v) { return half_swap_add(sum32(v)); }
__device__ __forceinline__ float wave_max(float v) { return half_swap_max(max32(v)); }
__device__ __forceinline__ int wave_min_i(int v) {
#define SWZI(K) v = min(v, __builtin_amdgcn_ds_swizzle(v, ((K) << 10) | 0x1f))
    SWZI(1); SWZI(2); SWZI(4); SWZI(8); SWZI(16);
#undef SWZI
    auto rr = __builtin_amdgcn_permlane32_swap((unsigned)v, (unsigned)v, false, false); return min((int)rr[0], (int)rr[1]);
}
__device__ __forceinline__ float wave_incl_scan(float v) {
#define DPPADD(ctrl, rmask) v += __builtin_bit_cast(float, __builtin_amdgcn_update_dpp(0, __builtin_bit_cast(int, v), ctrl, rmask, 0xf, false))
    DPPADD(0x111, 0xf); DPPADD(0x112, 0xf); DPPADD(0x114, 0xf); DPPADD(0x118, 0xf); DPPADD(0x142, 0xa); DPPADD(0x143, 0xc);
#undef DPPADD
    return v;
}
__device__ __forceinline__ float gelu_tanh(float y) {
    const float t = 0.7978845608028654f * (y + 0.044715f * y * y * y);
    const float e = __builtin_amdgcn_exp2f(-2.0f * LOG2E * fabsf(t));
    float th = (1.0f - e) * __builtin_amdgcn_rcpf(1.0f + e); th = t < 0.f ? -th : th;
    return 0.5f * y * (1.0f + th);
}
__device__ __forceinline__ float sigmoidf_(float x) { return __builtin_amdgcn_rcpf(1.0f + __builtin_amdgcn_exp2f(-LOG2E * x)); }
__device__ __forceinline__ float log_sigmoidf_(float z) { return fminf(z, 0.f) - log1pf(expf(-fabsf(z))); }

namespace pg8 {
#define PG8_LAS __attribute__((address_space(3)))
typedef unsigned short bf16_t;
constexpr int BM = 256, BK = 64, HALF = 128, HTB = HALF * BK * 2, STAGE_BYTES = 8 * HTB, NXCD = 8, WGM = 4;
__host__ __device__ __forceinline__ int lds_byte(int r, int c) { const int st = (r >> 4) * 2 + (c >> 5), rr = r & 15, cc = c & 31, ob = rr * 64 + cc * 2; return st * 1024 + (ob ^ (((ob >> 9) & 1) << 5)); }
__host__ __device__ __forceinline__ void stage_rc(int b, int& R, int& C) { const int st = b / 1024, sb = b % 1024, swz = sb ^ (((sb >> 9) & 1) << 5); R = (st >> 1) * 16 + swz / 64; C = (st & 1) * 32 + (swz % 64) / 2; }
__host__ __device__ __forceinline__ int perm32(int rho) { const int n = rho >> 4, i = rho & 15; return 8 * (i >> 2) + 4 * n + (i & 3); }
struct Unit { int pm, pn, ko; };
struct Gemm { const bf16_t* A; const bf16_t* Bt; int M, N, K, ld; };
struct StaticOrder {
    int nM, nN, nwg, G, c;
    __host__ __device__ __forceinline__ void init(int M, int N, int G_, int c_) { nM = M / BM; nN = N / BM; nwg = nM * nN; G = G_; c = c_; }
    __host__ __device__ __forceinline__ bool next(int i, Unit& u) const {
        const long L = (long)i * G + c; if (L >= nwg) return false;
        int wgid = (int)L; { const int q = nwg / NXCD, r = nwg % NXCD, xcd = wgid % NXCD, off = wgid / NXCD; wgid = (xcd < r ? xcd * (q + 1) : r * (q + 1) + (xcd - r) * q) + off; }
        const int nig = WGM * nN, gid = wgid / nig, fm = gid * WGM, gsz = (nM - fm) < WGM ? (nM - fm) : WGM;
        u.pm = fm + ((wgid % nig) % gsz); u.pn = (wgid % nig) / gsz; u.ko = 0; return true;
    }
};
struct SplitOrder {
    int c, kslice;
    __host__ __device__ __forceinline__ bool next(int i, Unit& u) const { if (i > 0 || c >= 256) return false; u.pm = 64 + (c >> 6); u.pn = (c >> 3) & 7; u.ko = (c & 7) * kslice; return true; }
};
struct OneUnit {
    int pm, pn; bool on;
    __host__ __device__ __forceinline__ bool next(int i, Unit& u) const { if (i > 0 || !on) return false; u.pm = pm; u.pn = pn; u.ko = 0; return true; }
};
template <class Epi, class Sched, bool ALIGN_EPI = true, bool SP2 = true>
__device__ __forceinline__ void gemm_phase(PG8_LAS unsigned char* lds, const Gemm g, const Sched& S, const Epi& E, const int wave) {
    const int tid = opaque_tid(wave), wid = wave, lane = tid & 63, wr = wid >> 2, wc = wid & 3, fr = lane & 15, fq = lane >> 4;
    const int K = g.K, nt = K / BK;
    unsigned voffA[2], voffB[2];
#pragma unroll
    for (int i = 0; i < 2; ++i) { int R, C; stage_rc(tid * 16 + i * 8192, R, C); const int Rb = Epi::PERM ? ((R & ~31) + perm32(R & 31)) : R;
        voffA[i] = (unsigned)(R * g.ld + C) * 2u; voffB[i] = (unsigned)(Rb * g.ld + C) * 2u; }
    const size_t kstep = (size_t)(BK * 2);
    const size_t hstep = (size_t)HALF * g.ld * 2;
    const size_t tstep = 2 * hstep;
    const unsigned ldsw = (unsigned)wid * 1024u;
    const int aoff = lds_byte(wr * 64 + fr, fq * 8), boff = lds_byte(wc * 32 + fr, fq * 8);
#define PG8_SA(b, h) (((b) * 2 + (h)) * HTB)
#define PG8_SB(b, h) ((4 + (b) * 2 + (h)) * HTB)
#define PG8_STAGE(bufoff, gbase, voff) do { _Pragma("unroll") for (int _i = 0; _i < 2; ++_i) \
        __builtin_amdgcn_global_load_lds((const unsigned*)((const char*)(gbase) + (voff)[_i]), (PG8_LAS unsigned*)(lds + (bufoff) + ldsw + _i * 8192), 16, 0, 0); } while (0)
#define PG8_LDA(dst, b, h) do { _Pragma("unroll") for (int m = 0; m < 4; ++m) _Pragma("unroll") for (int k = 0; k < 2; ++k) dst[m][k] = *(const PG8_LAS bf16x8*)(lds + PG8_SA(b, h) + aoff + m * 2048 + k * 1024); } while (0)
#define PG8_LDB(dst, b, h) do { _Pragma("unroll") for (int n = 0; n < 2; ++n) _Pragma("unroll") for (int k = 0; k < 2; ++k) dst[n][k] = *(const PG8_LAS bf16x8*)(lds + PG8_SB(b, h) + boff + n * 2048 + k * 1024); } while (0)
#define PG8_MMA(ai, bj, At, Bt) do { __builtin_amdgcn_s_setprio(1); _Pragma("unroll") for (int m = 0; m < 4; ++m) _Pragma("unroll") for (int n = 0; n < 2; ++n) _Pragma("unroll") for (int k = 0; k < 2; ++k) \
        acc[ai][bj][m][n] = __builtin_amdgcn_mfma_f32_16x16x32_bf16(Bt[n][k], At[m][k], acc[ai][bj][m][n], 0, 0, 0); __builtin_amdgcn_s_setprio(0); } while (0)
#define PG8_WAIT_V(n) asm volatile("s_waitcnt vmcnt(" #n ")" ::: "memory")
#define PG8_WAIT_L(n) asm volatile("s_waitcnt lgkmcnt(" #n ")" ::: "memory")
#define PG8_BAR __builtin_amdgcn_s_barrier()
#define PG8_SCHED __builtin_amdgcn_sched_barrier(0)
    Unit cur, nxt; int ui = 0;
    if (!S.next(0, cur)) return;
    f32x4 acc[2][2][4][2];
#pragma unroll
    for (int a = 0; a < 2; ++a)
#pragma unroll
        for (int b = 0; b < 2; ++b)
#pragma unroll
            for (int m = 0; m < 4; ++m)
#pragma unroll
                for (int n = 0; n < 2; ++n) acc[a][b][m][n] = (f32x4){0.f, 0.f, 0.f, 0.f};
    bf16x8 At[4][2], B0[2][2], B1[2][2];
    const char* cA = (const char*)g.A + (size_t)cur.pm * tstep + (size_t)cur.ko * 2; const char* cB = (const char*)g.Bt + (size_t)cur.pn * tstep + (size_t)cur.ko * 2;
    {
        PG8_STAGE(PG8_SB(0, 0), cB, voffB); PG8_STAGE(PG8_SB(0, 1), cB + hstep, voffB); PG8_STAGE(PG8_SA(0, 0), cA, voffA); PG8_STAGE(PG8_SA(0, 1), cA + hstep, voffA);
        if (wr == 1) PG8_BAR;
        PG8_WAIT_V(2); PG8_BAR;
        PG8_STAGE(PG8_SB(1, 0), cB + kstep, voffB); PG8_STAGE(PG8_SA(1, 0), cA + kstep, voffA); PG8_STAGE(PG8_SB(1, 1), cB + hstep + kstep, voffB);
        PG8_WAIT_V(6); PG8_BAR;
    }
    for (;;) {
        const bool has_next = S.next(ui + 1, nxt);
        const char* nA = has_next ? (const char*)g.A + (size_t)nxt.pm * tstep + (size_t)nxt.ko * 2 : cA; const char* nB = has_next ? (const char*)g.Bt + (size_t)nxt.pn * tstep + (size_t)nxt.ko * 2 : cB;
        for (int t = 0; t < nt; t += 2) {
            const bool last = (t == nt - 2);
            const char* a1 = cA + (size_t)(t + 1) * kstep;
            const char* a2 = last ? nA : cA + (size_t)(t + 2) * kstep; const char* b2 = last ? nB : cB + (size_t)(t + 2) * kstep;
            const char* a3 = a2 + kstep; const char* b3 = b2 + kstep;
            if constexpr (Epi::HAS_MID) { if (t == (nt >> 1)) E.mid(acc, ui, wr, fr); }
            PG8_LDB(B0, 0, 0); PG8_LDB(B1, 0, 1); PG8_SCHED; PG8_LDA(At, 0, 0); PG8_STAGE(PG8_SA(1, 1), a1 + hstep, voffA);
            PG8_WAIT_V(8); PG8_WAIT_L(0); PG8_BAR; PG8_MMA(0, 0, At, B0); PG8_MMA(0, 1, At, B1); PG8_BAR; PG8_SCHED;
            PG8_LDA(At, 0, 1); PG8_STAGE(PG8_SB(0, 0), b2, voffB); PG8_STAGE(PG8_SB(0, 1), b2 + hstep, voffB); PG8_STAGE(PG8_SA(0, 0), a2, voffA);
            PG8_WAIT_V(8); PG8_WAIT_L(0); PG8_BAR; PG8_MMA(1, 0, At, B0); PG8_MMA(1, 1, At, B1); PG8_BAR; PG8_SCHED;
            PG8_LDB(B0, 1, 0); PG8_LDB(B1, 1, 1); PG8_SCHED; PG8_LDA(At, 1, 0); PG8_STAGE(PG8_SA(0, 1), a2 + hstep, voffA);
            PG8_WAIT_V(8); PG8_WAIT_L(0); PG8_BAR; PG8_MMA(0, 0, At, B0); PG8_MMA(0, 1, At, B1); PG8_BAR; PG8_SCHED;
            PG8_LDA(At, 1, 1); PG8_STAGE(PG8_SB(1, 0), b3, voffB); PG8_STAGE(PG8_SB(1, 1), b3 + hstep, voffB); PG8_STAGE(PG8_SA(1, 0), a3, voffA);
            PG8_WAIT_V(8); PG8_WAIT_L(0); PG8_BAR; PG8_MMA(1, 0, At, B0); PG8_MMA(1, 1, At, B1); PG8_BAR; PG8_SCHED;
        }
        if constexpr (ALIGN_EPI) { if (wr == 0) PG8_BAR; }
        E(acc, cur, ui, wr, wc, fr, fq);
        if (!has_next) break;
#pragma unroll
        for (int a = 0; a < 2; ++a)
#pragma unroll
            for (int b = 0; b < 2; ++b)
#pragma unroll
                for (int m = 0; m < 4; ++m)
#pragma unroll
                    for (int n = 0; n < 2; ++n) acc[a][b][m][n] = (f32x4){0.f, 0.f, 0.f, 0.f};
        cur = nxt; cA = nA; cB = nB; ++ui;
        if constexpr (ALIGN_EPI) { if (wr == 1) PG8_BAR; }
    }
    PG8_WAIT_V(0);
    if constexpr (!ALIGN_EPI) { if (wr == 0) PG8_BAR; }
    PG8_BAR;
#undef PG8_SA
#undef PG8_SB
#undef PG8_STAGE
#undef PG8_LDA
#undef PG8_LDB
#undef PG8_MMA
#undef PG8_WAIT_V
#undef PG8_WAIT_L
#undef PG8_BAR
#undef PG8_SCHED
}
}

struct Args {
    const float* in[27];
    float* out;
    unsigned char* ws;
};

__device__ __forceinline__ size_t headmajor_off_u(bool smp, int m, int h) {
    if (!smp) { const int b = m >> 13, t = m & 8191; return ((size_t)(b * NH + h) * SEQ + t) * HD; }
    const int ms = m - MP, n = ms >> 5, i = ms & 31; return (size_t)2 * NH * SEQ * HD + ((size_t)(n * NH + h) * DSEQ + i) * HD;
}
__device__ __forceinline__ size_t headmajor_off(int m, int h) {
    if (m < MP) { const int b = m >> 13, t = m & 8191; return ((size_t)(b * NH + h) * SEQ + t) * HD; }
    const int ms = m - MP, n = ms >> 5, i = ms & 31; return (size_t)2 * NH * SEQ * HD + ((size_t)(n * NH + h) * DSEQ + i) * HD;
}

struct EpiIn {
    static constexpr bool PERM = true, HAS_MID = false;
    const float* rs1; bf16* U; float* out; bf16* Qh; bf16* Kh; bf16* Vh; const float* gq; const float* gk; LAS float* RED;
    __device__ __forceinline__ void operator()(const f32x4 (&acc)[2][2][4][2], const pg8::Unit& u, int ui, int wr, int wc, int fr, int fq) const {
        asm volatile("" : "+v"(fr), "+v"(fq));
        const int row0 = u.pm * 256 + wr * 64 + fr, colb = u.pn * 256 + wc * 32 + 8 * fq;
        const bool smp = u.pm >= MP / 256;
        float* outv = out + (u.pm < MP / 256 ? (size_t)O_VP : (size_t)O_VS - (size_t)MP * 1024); float* outk = out + (u.pm < MP / 256 ? (size_t)O_KP : (size_t)O_KS - (size_t)MP * 1024);
        float rsv[2][4];
#pragma unroll
        for (int ai = 0; ai < 2; ++ai)
#pragma unroll
            for (int m = 0; m < 4; ++m) rsv[ai][m] = rs1[row0 + ai * 128 + m * 16];
        asm volatile("" : "+v"(rsv[0][0]), "+v"(rsv[0][1]), "+v"(rsv[0][2]), "+v"(rsv[0][3]), "+v"(rsv[1][0]), "+v"(rsv[1][1]), "+v"(rsv[1][2]), "+v"(rsv[1][3]));
        if (u.pn < 4 || u.pn >= 12) {
#pragma unroll
            for (int ai = 0; ai < 2; ++ai)
#pragma unroll
                for (int m = 0; m < 4; ++m) {
                    const int row = row0 + ai * 128 + m * 16; const float rs = rsv[ai][m];
#pragma unroll
                    for (int bj = 0; bj < 2; ++bj) {
                        const int col = colb + bj * 128; const f32x4 v0 = acc[ai][bj][m][0] * rs, v1 = acc[ai][bj][m][1] * rs;
                        if (u.pn < 4) { *(bf16x8*)(U + (size_t)row * DSSM + col) = pack8(v0, v1); }
                        else { const int c = col - 3072, h = c >> 7, d = c & 127;
                            float* p = outv + (size_t)row * 1024 + c; *(f32x4*)p = v0; *(f32x4*)(p + 4) = v1;
                            *(bf16x8*)(Vh + headmajor_off_u(smp, row, h) + d) = pack8(v0, v1); }
                    }
                }
        } else {
#pragma unroll
            for (int ai = 0; ai < 2; ++ai)
#pragma unroll
                for (int m = 0; m < 4; ++m)
#pragma unroll
                    for (int bj = 0; bj < 2; ++bj) { const f32x4 a = acc[ai][bj][m][0], b = acc[ai][bj][m][1];
                        float s = (a[0] * a[0] + a[1] * a[1]) + (a[2] * a[2] + a[3] * a[3]) + (b[0] * b[0] + b[1] * b[1]) + (b[2] * b[2] + b[3] * b[3]);
                        s += lane_xor<16>(s); s = half_swap_add(s);
                        if (fq == 0) RED[((ai * 128 + wr * 64 + m * 16 + fr) * 2 + bj) * 4 + wc] = s; }
            asm volatile("s_waitcnt lgkmcnt(0)" ::: "memory"); __builtin_amdgcn_s_barrier(); asm volatile("" ::: "memory");
            const bool isq = u.pn < 8; const float* g = isq ? gq : gk; const int hb = ((u.pn - (isq ? 4 : 8)) * 2);
            const f32x4 g0 = *(const f32x4*)(g + wc * 32 + 8 * fq), g1 = *(const f32x4*)(g + wc * 32 + 8 * fq + 4);
#pragma unroll
            for (int ai = 0; ai < 2; ++ai)
#pragma unroll
                for (int m = 0; m < 4; ++m) {
                    const int rl = ai * 128 + wr * 64 + m * 16 + fr, row = u.pm * 256 + rl; const float rs = rsv[ai][m];
#pragma unroll
                    for (int bj = 0; bj < 2; ++bj) {
                        const f32x4 t = *(const LAS f32x4*)(RED + (rl * 2 + bj) * 4); const float tot = ((t[0] + t[1]) + (t[2] + t[3])) * rs * rs;
                        const float rn = rs * __builtin_amdgcn_rsqf(tot * (1.0f / HD) + EPS);
                        const int h = hb + bj, d = wc * 32 + 8 * fq;
                        f32x4 v0 = acc[ai][bj][m][0] * rn * g0, v1 = acc[ai][bj][m][1] * rn * g1;
                        if (isq) { v0 = v0 * QSCALE; v1 = v1 * QSCALE; *(bf16x8*)(Qh + headmajor_off_u(smp, row, h) + d) = pack8(v0, v1); }
                        else { float* p = outk + (size_t)row * 1024 + h * HD + d; *(f32x4*)p = v0; *(f32x4*)(p + 4) = v1;
                            *(bf16x8*)(Kh + headmajor_off_u(smp, row, h) + d) = pack8(v0, v1); }
                    }
                }
        }
    }
};
struct EpiGlu {
    static constexpr bool PERM = true, HAS_MID = false;
    const bf16* GY; bf16* MIX; float* SSQ1;
    __device__ __forceinline__ void operator()(const f32x4 (&acc)[2][2][4][2], const pg8::Unit& u, int ui, int wr, int wc, int fr, int fq) const {
        asm volatile("" : "+v"(fr), "+v"(fq));
        const int row0 = u.pm * 256 + wr * 64 + fr, colb = u.pn * 256 + wc * 32 + 8 * fq;
        bf16x8 gvv[2][4][2];
#pragma unroll
        for (int ai = 0; ai < 2; ++ai)
#pragma unroll
            for (int m = 0; m < 4; ++m)
#pragma unroll
                for (int bj = 0; bj < 2; ++bj) gvv[ai][m][bj] = *(const bf16x8*)(GY + (size_t)(row0 + ai * 128 + m * 16) * DSSM + colb + bj * 128);
        asm volatile("" : "+v"(gvv[0][0][0]), "+v"(gvv[0][0][1]), "+v"(gvv[0][1][0]), "+v"(gvv[0][1][1]), "+v"(gvv[0][2][0]), "+v"(gvv[0][2][1]), "+v"(gvv[0][3][0]), "+v"(gvv[0][3][1]),
                          "+v"(gvv[1][0][0]), "+v"(gvv[1][0][1]), "+v"(gvv[1][1][0]), "+v"(gvv[1][1][1]), "+v"(gvv[1][2][0]), "+v"(gvv[1][2][1]), "+v"(gvv[1][3][0]), "+v"(gvv[1][3][1]));
#pragma unroll
        for (int ai = 0; ai < 2; ++ai)
#pragma unroll
            for (int m = 0; m < 4; ++m) {
                const int row = row0 + ai * 128 + m * 16; float ssq = 0.f;
#pragma unroll
                for (int bj = 0; bj < 2; ++bj) {
                    const int col = colb + bj * 128; const bf16x8 gv = gvv[ai][m][bj];
                    f32x4 o0, o1;
#pragma unroll
                    for (int e = 0; e < 4; ++e) { o0[e] = bf2f((unsigned short)gv[e]) * sigmoidf_(acc[ai][bj][m][0][e]); o1[e] = bf2f((unsigned short)gv[4 + e]) * sigmoidf_(acc[ai][bj][m][1][e]);
                        ssq += o0[e] * o0[e] + o1[e] * o1[e]; }
                    *(bf16x8*)(MIX + (size_t)row * DM + col) = pack8(o0, o1);
                }
                ssq += lane_xor<16>(ssq); ssq = half_swap_add(ssq);
                if (fq == 0) SSQ1[(size_t)row * 16 + u.pn * 4 + wc] = ssq;
            }
    }
};
struct EpiOut {
    static constexpr bool PERM = true, HAS_MID = true;
    const bf16* XBr; float* out; bf16* X1B; float* SSQ3; const LAS float* RT;
    __device__ __forceinline__ void mid(f32x4 (&acc)[2][2][4][2], int ui, int wr, int fr) const {
        asm volatile("" : "+v"(fr));
#pragma unroll
        for (int ai = 0; ai < 2; ++ai)
#pragma unroll
            for (int m = 0; m < 4; ++m) { const float r = RT[(ui * 256 + ai * 128 + wr * 64 + m * 16 + fr) * 2];
#pragma unroll
                for (int bj = 0; bj < 2; ++bj)
#pragma unroll
                    for (int n = 0; n < 2; ++n) acc[ai][bj][m][n] *= r; }
    }
    __device__ __forceinline__ void operator()(const f32x4 (&acc)[2][2][4][2], const pg8::Unit& u, int ui, int wr, int wc, int fr, int fq) const {
        asm volatile("" : "+v"(fr), "+v"(fq));
        const int col0 = u.pn * 256 + wc * 32 + 8 * fq;
        u32x4 xv[2][4][2];
#pragma unroll
        for (int ai = 0; ai < 2; ++ai)
#pragma unroll
            for (int m = 0; m < 4; ++m) { const bf16* xrow = XBr + (size_t)(u.pm * 256 + ai * 128 + wr * 64 + m * 16 + fr) * DM;
#pragma unroll
                for (int bj = 0; bj < 2; ++bj) xv[ai][m][bj] = *(const u32x4*)(xrow + col0 + bj * 128); }
        asm volatile("" : "+v"(xv[0][0][0]), "+v"(xv[0][0][1]), "+v"(xv[0][1][0]), "+v"(xv[0][1][1]), "+v"(xv[0][2][0]), "+v"(xv[0][2][1]), "+v"(xv[0][3][0]), "+v"(xv[0][3][1]),
                          "+v"(xv[1][0][0]), "+v"(xv[1][0][1]), "+v"(xv[1][1][0]), "+v"(xv[1][1][1]), "+v"(xv[1][2][0]), "+v"(xv[1][2][1]), "+v"(xv[1][3][0]), "+v"(xv[1][3][1]));
#pragma unroll
        for (int ai = 0; ai < 2; ++ai) { float ssel = 0.f;
#pragma unroll
            for (int m = 0; m < 4; ++m) {
                const int rl = ai * 128 + wr * 64 + m * 16 + fr, row = u.pm * 256 + rl; const float rB = RT[(ui * 256 + rl) * 2 + 1];
                float ssq = 0.f;
#pragma unroll
                for (int bj = 0; bj < 2; ++bj) { const u32x4 xw = xv[ai][m][bj]; u32x4 w;
#pragma unroll
                    for (int n = 0; n < 2; ++n) { const unsigned w0 = xw[2 * n], w1 = xw[2 * n + 1];
                        f32x4 xf; xf[0] = __builtin_bit_cast(float, w0 << 16); xf[1] = __builtin_bit_cast(float, w0 & 0xffff0000u); xf[2] = __builtin_bit_cast(float, w1 << 16); xf[3] = __builtin_bit_cast(float, w1 & 0xffff0000u);
                        const f32x4 x1 = xf + acc[ai][bj][m][n] * rB;
                        w[2 * n] = cvtpk(x1[0], x1[1]); w[2 * n + 1] = cvtpk(x1[2], x1[3]);
                        ssq += (x1[0] * x1[0] + x1[1] * x1[1]) + (x1[2] * x1[2] + x1[3] * x1[3]); }
                    *(u32x4*)(X1B + (size_t)row * DM + col0 + bj * 128) = w; }
                ssq += lane_xor<16>(ssq); ssq = half_swap_add(ssq);
                ssel = (fq == m) ? ssq : ssel;
            }
            SSQ3[(size_t)(u.pm * 256 + ai * 128 + wr * 64 + fq * 16 + fr) * 32 + u.pn * 4 + wc] = ssel; }
    }
};
struct EpiUp {
    static constexpr bool PERM = true, HAS_MID = false;
    bf16* H; const LAS float* RT;
    __device__ __forceinline__ void operator()(const f32x4 (&acc)[2][2][4][2], const pg8::Unit& u, int ui, int wr, int wc, int fr, int fq) const {
        asm volatile("" : "+v"(fr), "+v"(fq));
        const int colb = u.pn * 256 + wc * 32 + 8 * fq;
#pragma unroll
        for (int ai = 0; ai < 2; ++ai)
#pragma unroll
            for (int m = 0; m < 4; ++m) {
                const int rl = ai * 128 + wr * 64 + m * 16 + fr, row = u.pm * 256 + rl; const float rs = RT[ui * 256 + rl];
#pragma unroll
                for (int bj = 0; bj < 2; ++bj) { f32x4 v0 = acc[ai][bj][m][0] * rs, v1 = acc[ai][bj][m][1] * rs;
#pragma unroll
                    for (int e = 0; e < 4; ++e) { const float a = fmaxf(v0[e], 0.f), b = fmaxf(v1[e], 0.f); v0[e] = a * a; v1[e] = b * b; }
                    st16_wt(H + (size_t)row * DFF + colb + bj * 128, __builtin_bit_cast(u32x4, pack8(v0, v1))); }
            }
    }
};
struct EpiDown {
    static constexpr bool PERM = false, HAS_MID = false;
    float* out; const bf16* X1B;
    __device__ __forceinline__ void operator()(const f32x4 (&acc)[2][2][4][2], const pg8::Unit& u, int ui, int wr, int wc, int fr, int fq) const {
        asm volatile("" : "+v"(fr), "+v"(fq));
        const int row0 = u.pm * 256 + wr * 64 + fr, col0 = u.pn * 256 + wc * 32 + 4 * fq;
        u32x2 wv[2][4][2][2];
#pragma unroll
        for (int ai = 0; ai < 2; ++ai)
#pragma unroll
            for (int m = 0; m < 4; ++m)
#pragma unroll
                for (int bj = 0; bj < 2; ++bj)
#pragma unroll
                    for (int n = 0; n < 2; ++n) wv[ai][m][bj][n] = *(const u32x2*)(X1B + (size_t)(row0 + ai * 128 + m * 16) * DM + col0 + bj * 128 + n * 16);
#pragma unroll
        for (int ai = 0; ai < 2; ++ai)
            asm volatile("" : "+v"(wv[ai][0][0][0]), "+v"(wv[ai][0][0][1]), "+v"(wv[ai][0][1][0]), "+v"(wv[ai][0][1][1]), "+v"(wv[ai][1][0][0]), "+v"(wv[ai][1][0][1]), "+v"(wv[ai][1][1][0]), "+v"(wv[ai][1][1][1]),
                              "+v"(wv[ai][2][0][0]), "+v"(wv[ai][2][0][1]), "+v"(wv[ai][2][1][0]), "+v"(wv[ai][2][1][1]), "+v"(wv[ai][3][0][0]), "+v"(wv[ai][3][0][1]), "+v"(wv[ai][3][1][0]), "+v"(wv[ai][3][1][1]));
#pragma unroll
        for (int ai = 0; ai < 2; ++ai)
#pragma unroll
            for (int m = 0; m < 4; ++m) { const size_t ro = (size_t)(row0 + ai * 128 + m * 16) * DM + col0;
#pragma unroll
                for (int bj = 0; bj < 2; ++bj)
#pragma unroll
                    for (int n = 0; n < 2; ++n) { const size_t o = ro + bj * 128 + n * 16; const u32x2 w = wv[ai][m][bj][n];
                        f32x4 x1; x1[0] = __builtin_bit_cast(float, w.x << 16); x1[1] = __builtin_bit_cast(float, w.x & 0xffff0000u); x1[2] = __builtin_bit_cast(float, w.y << 16); x1[3] = __builtin_bit_cast(float, w.y & 0xffff0000u);
                        *(f32x4*)(out + O_Y + o) = x1 + acc[ai][bj][m][n]; } }
    }
};
struct EpiDownSlab {
    static constexpr bool PERM = false, HAS_MID = false;
    float* SL; int kslice;
    __device__ __forceinline__ void operator()(const f32x4 (&acc)[2][2][4][2], const pg8::Unit& u, int ui, int wr, int wc, int fr, int fq) const {
        asm volatile("" : "+v"(fr), "+v"(fq));
        const int row0 = (u.pm - 64) * 256 + wr * 64 + fr, col0 = u.pn * 256 + wc * 32 + 4 * fq;
        float* base = SL + (size_t)(u.ko / kslice) * (MS * DM);
#pragma unroll
        for (int ai = 0; ai < 2; ++ai)
#pragma unroll
            for (int m = 0; m < 4; ++m) { float* rowp = base + (size_t)(row0 + ai * 128 + m * 16) * DM + col0;
#pragma unroll
                for (int bj = 0; bj < 2; ++bj)
#pragma unroll
                    for (int n = 0; n < 2; ++n) *(f32x4*)(rowp + bj * 128 + n * 16) = acc[ai][bj][m][n]; }
    }
};
__device__ __forceinline__ void slab_done(unsigned* cnt) {
    if (threadIdx.x == 0) { __builtin_amdgcn_fence(__ATOMIC_RELEASE, "agent"); asm volatile("s_waitcnt vmcnt(0)" ::: "memory"); __hip_atomic_fetch_add(cnt, 1u, __ATOMIC_RELAXED, __HIP_MEMORY_SCOPE_AGENT); }
}
__device__ __forceinline__ void slab_wait(unsigned* cnt, unsigned need) {
    if (threadIdx.x == 0) { unsigned sp = 0; while (__hip_atomic_load(cnt, __ATOMIC_RELAXED, __HIP_MEMORY_SCOPE_AGENT) < need) { __builtin_amdgcn_s_sleep(2); if (++sp > (1u << 22)) break; }
        __builtin_amdgcn_fence(__ATOMIC_ACQUIRE, "agent"); asm volatile("s_waitcnt vmcnt(0)" ::: "memory"); }
    __syncthreads();
}
__device__ __forceinline__ void p0_transpose_item(const float* W, int ldw, int K, int nblk, const float* g0, const float* g1, bf16* WT, LAS float* scr, int item, int lane) {
    const int kb = item / nblk, nb = item % nblk, k0 = 64 * kb, n0 = 32 * nb;
    f32x4 v[8];
#pragma unroll
    for (int i = 0; i < 8; ++i) { const int k = k0 + 8 * i + (lane >> 3); v[i] = *(const f32x4*)(W + (size_t)k * ldw + n0 + (lane & 7) * 4); }
#pragma unroll
    for (int i = 0; i < 8; ++i) { const int kk = 8 * i + (lane >> 3), k = k0 + kk;
        float gv = 1.f; if (g0) gv = (g1 && k >= 1024) ? g1[k - 1024] : g0[k];
        LAS float* d = scr + kk * 33 + (lane & 7) * 4; d[0] = v[i][0] * gv; d[1] = v[i][1] * gv; d[2] = v[i][2] * gv; d[3] = v[i][3] * gv; }
    asm volatile("s_waitcnt lgkmcnt(0)" ::: "memory");
    const int c = lane & 7;
#pragma unroll
    for (int j = 0; j < 4; ++j) { const int n = (lane >> 3) + 8 * j; const LAS float* s = scr + (8 * c) * 33 + n;
        u32x4 o; o.x = pk2(s[0 * 33], s[1 * 33]); o.y = pk2(s[2 * 33], s[3 * 33]); o.z = pk2(s[4 * 33], s[5 * 33]); o.w = pk2(s[6 * 33], s[7 * 33]);
        *(u32x4*)(WT + (size_t)(n0 + n) * K + k0 + 8 * c) = o; }
    asm volatile("s_waitcnt lgkmcnt(0)" ::: "memory");
}

namespace fox {
constexpr int D = 128, NW = 8, QBLK = 32, KVBLK = 64, QB = 256;
constexpr int SHM_V = 16384, SHM_K = 16384, SHM_X = 2048;
constexpr int QROWB = 144, SHM_Q = 32 * QROWB;
constexpr int NVB = 3;
constexpr int OFF_V = 0, OFF_K = NVB * SHM_V, OFF_X = OFF_K + 2 * SHM_K, OFF_WS = OFF_X + 2 * SHM_X, OFF_Q = OFF_WS + NW * 64 * 4, OFF_QX = OFF_Q + NW * SHM_Q, LDSB = OFF_QX + NW * 1024;
#define KSWZ(row, colB) ((row) * 256 + ((colB) ^ (((row) & 15) << 4)))
#define SBAR() __builtin_amdgcn_sched_barrier(0)
__device__ __forceinline__ int v_st(int k, int c) { const int kk = (k & ~0xC) | ((k & 4) << 1) | ((k & 8) >> 1); return ((kk >> 3) * 4 + (c >> 5)) * 512 + ((kk & 7) * 32 + (c & 31)) * 2; }
__device__ __forceinline__ int v_rd_base(int lane) { return ((lane & 3) << 3) | (((lane >> 2) & 3) << 6) | (((lane >> 4) & 1) << 5) | (((lane >> 5) & 1) << 8); }
constexpr int v_rd_off(int d0, int ks, int half) { return d0 * 512 + ks * 4096 + half * 2048; }
__device__ __forceinline__ int crow(int r, int hi) { return (r & 3) + 8 * (r >> 2) + 4 * hi; }
__device__ __forceinline__ bf16x8 load8(const bf16* p) { return *reinterpret_cast<const bf16x8*>(p); }
__device__ __forceinline__ void mask_tile(f32x16& p0, f32x16& p1, int dq) {
#pragma unroll
    for (int r = 0; r < 16; ++r) { const int c = (r & 3) + 8 * (r >> 2);
        const unsigned m0 = (unsigned)((dq - c) >> 31), m1 = (unsigned)((dq - c - 32) >> 31);
        p0[r] = __uint_as_float((m0 & 0xff800000u) | (~m0 & __float_as_uint(p0[r])));
        p1[r] = __uint_as_float((m1 & 0xff800000u) | (~m1 & __float_as_uint(p1[r]))); }
}
__device__ __forceinline__ void partialSM(f32x16& p0) {
#pragma unroll
    for (int r = 0; r < 16; ++r) p0[r] = __builtin_amdgcn_exp2f(p0[r]);
}
__device__ __forceinline__ void finishSM(f32x16& p0, f32x16& p1, float& l_reg, bf16x8& pa0, bf16x8& pa1, bf16x8& pa2, bf16x8& pa3) {
#pragma unroll
    for (int r = 0; r < 16; ++r) p1[r] = __builtin_amdgcn_exp2f(p1[r]);
    float ps = 0;
#pragma unroll
    for (int r = 0; r < 16; ++r) ps += p0[r];
#pragma unroll
    for (int r = 0; r < 16; ++r) ps += p1[r];
    l_reg += ps;
#define PK4(P, B_, OUT) do { unsigned a0 = cvtpk(P[B_+0], P[B_+1]), a1 = cvtpk(P[B_+2], P[B_+3]);                          \
        unsigned b0 = cvtpk(P[B_+4], P[B_+5]), b1 = cvtpk(P[B_+6], P[B_+7]);                                             \
        auto r0 = __builtin_amdgcn_permlane32_swap(a0, b0, false, false); auto r1 = __builtin_amdgcn_permlane32_swap(a1, b1, false, false); \
        u32x4 w = {r0[0], r1[0], r0[1], r1[1]}; OUT = __builtin_bit_cast(bf16x8, w); } while (0)
    PK4(p0, 0, pa0); PK4(p0, 8, pa1); PK4(p1, 0, pa2); PK4(p1, 8, pa3);
#undef PK4
}
template <int VB>
__device__ __forceinline__ void pv_tile(f32x16* o, int vb0, bf16x8 pa0, bf16x8 pa1, bf16x8 pa2, bf16x8 pa3) {
#define TRRD(dst, off) asm volatile("ds_read_b64_tr_b16 %0, %1 offset:%2" : "=&v"(dst) : "v"(vb0), "i"(off) : "memory")
#define PV_D0(d0) do { s16x4 l0, l1, l2, l3, h0, h1, h2, h3; constexpr int b_ = VB * SHM_V + v_rd_off(d0, 0, 0); \
        TRRD(l0, b_); TRRD(h0, b_ + 2048); TRRD(l1, b_ + 4096); TRRD(h1, b_ + 6144); TRRD(l2, b_ + 8192); TRRD(h2, b_ + 10240); TRRD(l3, b_ + 12288); TRRD(h3, b_ + 14336); \
        asm volatile("s_waitcnt lgkmcnt(0)" ::: "memory"); SBAR();   \
        o[d0] = __builtin_amdgcn_mfma_f32_32x32x16_bf16(pa0, (bf16x8){l0[0], l0[1], l0[2], l0[3], h0[0], h0[1], h0[2], h0[3]}, o[d0], 0, 0, 0);   \
        o[d0] = __builtin_amdgcn_mfma_f32_32x32x16_bf16(pa1, (bf16x8){l1[0], l1[1], l1[2], l1[3], h1[0], h1[1], h1[2], h1[3]}, o[d0], 0, 0, 0);   \
        o[d0] = __builtin_amdgcn_mfma_f32_32x32x16_bf16(pa2, (bf16x8){l2[0], l2[1], l2[2], l2[3], h2[0], h2[1], h2[2], h2[3]}, o[d0], 0, 0, 0);   \
        o[d0] = __builtin_amdgcn_mfma_f32_32x32x16_bf16(pa3, (bf16x8){l3[0], l3[1], l3[2], l3[3], h3[0], h3[1], h3[2], h3[3]}, o[d0], 0, 0, 0); } while (0)
    PV_D0(0); PV_D0(1); PV_D0(2); PV_D0(3);
#undef PV_D0
#undef TRRD
}
typedef __amdgpu_buffer_rsrc_t srd_t;
__device__ __forceinline__ srd_t mksrd(const void* p, unsigned bytes) { return __builtin_amdgcn_make_buffer_rsrc((void*)p, 0, (int)bytes, 0x00020000); }
__device__ __forceinline__ bf16x8 bload8(srd_t r, unsigned voff, unsigned soff) { return __builtin_bit_cast(bf16x8, __builtin_amdgcn_raw_buffer_load_b128(r, (int)voff, (int)soff, 0)); }
struct Ctx { srd_t W; unsigned char* ws; };
struct Seam { bf16x8 qr[8]; bf16x8 qx; };
#define WAITBAR() asm volatile("s_waitcnt vmcnt(0) lgkmcnt(0)\n\ts_barrier" ::: "memory")
#define OKV(bh, t) ((unsigned)(bh) * (SEQ * HD * 2) + (unsigned)(t) * (KVBLK * D * 2))
#define DMA16(dst, voff, soff, imm) __builtin_amdgcn_raw_ptr_buffer_load_lds(C.W, (LAS void*)(dst), 16, (int)(voff), (int)(soff), (imm), 0)
#define DMA_TILE(bh, t, kb, vb) do { const unsigned so_ = OKV(bh, t); \
        DMA16(lds + OFF_K + (kb) * SHM_K + wid * 2048, vok0, (unsigned)WS_KH + so_, 0); DMA16(lds + OFF_K + (kb) * SHM_K + wid * 2048 + 1024, vok1, (unsigned)WS_KH + so_, 0); \
        DMA16(lds + OFF_V + (vb) * SHM_V + wid * 2048, vov, (unsigned)WS_VH + so_, 0);  DMA16(lds + OFF_V + (vb) * SHM_V + wid * 2048 + 1024, vov, (unsigned)WS_VH + so_ + 128u, 0);   \
        if (wid < 2) DMA16(lds + OFF_X + (kb) * SHM_X + wid * 1024, vox, (unsigned)WS_CLK + (unsigned)(bh) * (SEQ * 32) + (unsigned)(t) * (KVBLK * 32), 0); } while (0)
#define DMA_OFFS(tid_) const int lane_ = (tid_) & 63; \
        const int kr0_ = 8 * wid + (lane_ >> 4), kr1_ = kr0_ + 4;                                     \
        const unsigned vok0 = (unsigned)(kr0_ * 256 + (((lane_ & 15) ^ (kr0_ & 15)) << 4)), vok1 = (unsigned)(kr1_ * 256 + (((lane_ & 15) ^ (kr1_ & 15)) << 4)); \
        const int vkk_ = 8 * wid + ((lane_ >> 2) & 7), vk_ = (vkk_ & ~0xC) | ((vkk_ & 4) << 1) | ((vkk_ & 8) >> 1);     \
        const unsigned vov = (unsigned)(vk_ * 256 + ((lane_ >> 5) * 32 + (lane_ & 3) * 8) * 2), vox = (unsigned)(tid_) * 16u
#define QLOAD(bh, qb, R32, HI) do { const unsigned voq_ = (unsigned)(((wid * QBLK + (R32)) * D + (HI) * 8) * 2); const unsigned row0_ = (unsigned)(bh) * SEQ + (unsigned)(qb) * QB; \
    _Pragma("unroll") for (int d0 = 0; d0 < 8; ++d0) S.qr[d0] = bload8(C.W, voq_ + d0 * 32, (unsigned)WS_QH + row0_ * (HD * 2)); \
    S.qx = bload8(C.W, (unsigned)(((wid * QBLK + (R32)) * 16 + (HI) * 8) * 2), (unsigned)WS_CLQ + row0_ * 32); } while (0)
__device__ __forceinline__ int tile_lo(const Ctx& C, int bh, int qb, int lane) {
    const unsigned base = (unsigned)(WS_SMALL + SM_CLF) + (unsigned)bh * (SEQ * 4);
    const float thr = __builtin_bit_cast(float, __builtin_amdgcn_raw_buffer_load_b32(C.W, 0, (int)((unsigned)(WS_SMALL + SM_CLF) + 16u * SEQ * 4u), 0));
    const float cr0 = __builtin_bit_cast(float, __builtin_amdgcn_raw_buffer_load_b32(C.W, 0, (int)(base + (unsigned)qb * (QB * 4)), 0));
    const int NT = 4 * qb + 4; int first = NT - 4;
    for (int j = lane; j < NT - 4; j += 64) { const float ce = __builtin_bit_cast(float, __builtin_amdgcn_raw_buffer_load_b32(C.W, (int)((KVBLK * j + KVBLK - 1) * 4), (int)base, 0));
        if (cr0 - ce >= -thr) first = min(first, j); }
    first = __builtin_amdgcn_readfirstlane(wave_min_i(first));
    return first & ~1;
}
__device__ __forceinline__ void prime(const Ctx& C, int bh, int qb, int jlo, LAS char* lds, Seam& S, const int wave) {
    const int tid = opaque_tid(wave), wid = wave, r32 = tid & 31, hi = (tid >> 5) & 1;
    DMA_OFFS(tid);
    QLOAD(bh, qb, r32, hi);
    DMA_TILE(bh, jlo, 0, 0);
}
template <int KB>
__device__ __forceinline__ void qkt(f32x16& p0, f32x16& p1, LAS const char* lds, int r32, int hi, const bf16x8 (&q4)[4], LAS const char* qb, LAS const char* qxb) {
    p0 = f32x16{}; p1 = f32x16{};
    unsigned kb0 = (unsigned)(uintptr_t)(lds + OFF_K + KB * SHM_K) + (unsigned)KSWZ(r32, hi * 16);
    asm volatile("" : "+v"(kb0));
#pragma unroll
    for (int d0 = 0; d0 < 8; ++d0) { LAS const char* a = (LAS const char*)(uintptr_t)(kb0 ^ (unsigned)(d0 << 5));
        bf16x8 b0 = *reinterpret_cast<LAS const bf16x8*>(a);
        bf16x8 b1 = *reinterpret_cast<LAS const bf16x8*>(a + 32 * 256);
        bf16x8 qf; if (d0 < 4) qf = q4[d0]; else qf = *reinterpret_cast<LAS const bf16x8*>(qb + (d0 - 4) * 32);
        p0 = __builtin_amdgcn_mfma_f32_32x32x16_bf16(b0, qf, p0, 0, 0, 0);
        p1 = __builtin_amdgcn_mfma_f32_32x32x16_bf16(b1, qf, p1, 0, 0, 0); }
    { LAS const char* xa = lds + OFF_X + KB * SHM_X + r32 * 32 + hi * 16;
        bf16x8 x0 = *reinterpret_cast<LAS const bf16x8*>(xa); bf16x8 x1 = *reinterpret_cast<LAS const bf16x8*>(xa + 32 * 32);
        const bf16x8 qx = *reinterpret_cast<LAS const bf16x8*>(qxb);
        p0 = __builtin_amdgcn_mfma_f32_32x32x16_bf16(x0, qx, p0, 0, 0, 0);
        p1 = __builtin_amdgcn_mfma_f32_32x32x16_bf16(x1, qx, p1, 0, 0, 0); }
}
__device__ __forceinline__ void block(const Ctx& C, int bh, int qb_cur, int jlo, int qb_nxt, int jlo_nxt, LAS char* lds, Seam& S, const int wave) {
    const int tid = opaque_tid(wave), wid = wave, lane = tid & 63, r32 = lane & 31, hi = lane >> 5;
    const int P0 = qb_cur * QB;
    const int NT = (P0 + QB - 1) / KVBLK + 1 - jlo;
    const int qlo = P0 + wid * QBLK, qm = qlo + r32 - 4 * hi;
    float l_reg = 0; f32x16 o[4] = {};
    DMA_OFFS(tid);
    const int vb0 = (int)(unsigned)(uintptr_t)(lds + OFF_V) + v_rd_base(lane);
#define KBASE(t) ((jlo + (t)) * KVBLK)
#define MASKT(P0_, P1_, t) do { const int kb_ = KBASE(t); if (kb_ + KVBLK - 1 > qlo) mask_tile(P0_, P1_, qm - kb_); } while (0)
    f32x16 pA0, pA1, pB0, pB1; bf16x8 pa0, pa1, pa2, pa3;
    bf16x8 q4[4] = {S.qr[0], S.qr[1], S.qr[2], S.qr[3]};
    LAS char* qb = lds + OFF_Q + wid * SHM_Q + r32 * QROWB + hi * 16;
#pragma unroll
    for (int d0 = 4; d0 < 8; ++d0) *reinterpret_cast<LAS bf16x8*>(qb + (d0 - 4) * 32) = S.qr[d0];
    LAS char* qxb = lds + OFF_QX + wid * 1024 + r32 * 32 + hi * 16; *reinterpret_cast<LAS bf16x8*>(qxb) = S.qx;
    WAITBAR();
    SBAR(); qkt<0>(pA0, pA1, lds, r32, hi, q4, qb, qxb);
    DMA_TILE(bh, jlo + 1, 1, 1); SBAR();
    MASKT(pA0, pA1, 0); partialSM(pA0);
    WAITBAR();
    int vr = 0, vw = 2;
#define HALF_STEP(PX0, PX1, PY0, PY1, t, KB) do {                                                      \
        SBAR(); qkt<KB>(PX0, PX1, lds, r32, hi, q4, qb, qxb);                                             \
        finishSM(PY0, PY1, l_reg, pa0, pa1, pa2, pa3); SBAR();                                                           \
        if ((t) + 1 < NT) { DMA_TILE(bh, jlo + (t) + 1, (KB) ^ 1, vw); SBAR(); }                                         \
        pv_tile<0>(o, vb0 + vr * SHM_V, pa0, pa1, pa2, pa3); MASKT(PX0, PX1, (t)); partialSM(PX0);                         \
        WAITBAR();                                                                                                            \
        vr = (vr == NVB - 1) ? 0 : vr + 1; vw = (vw == NVB - 1) ? 0 : vw + 1; } while (0)
    for (int t = 1; t + 1 < NT; t += 2) {
        HALF_STEP(pB0, pB1, pA0, pA1, t, 1);
        HALF_STEP(pA0, pA1, pB0, pB1, t + 1, 0);
    }
    SBAR(); qkt<1>(pB0, pB1, lds, r32, hi, q4, qb, qxb); SBAR();
    finishSM(pA0, pA1, l_reg, pa0, pa1, pa2, pa3); SBAR();
    pv_tile<0>(o, vb0 + vr * SHM_V, pa0, pa1, pa2, pa3);
    vr = (vr == NVB - 1) ? 0 : vr + 1;
    MASKT(pB0, pB1, NT - 1); partialSM(pB0);
    finishSM(pB0, pB1, l_reg, pa0, pa1, pa2, pa3); SBAR(); pv_tile<0>(o, vb0 + vr * SHM_V, pa0, pa1, pa2, pa3);
    WAITBAR();
    { const int tid2 = opaque_tid(wave), r32b = tid2 & 31, hib = (tid2 >> 5) & 1;
      QLOAD(bh, qb_nxt, r32b, hib);
      DMA_TILE(bh, jlo_nxt, 0, 0); SBAR();
      l_reg = half_swap_add(l_reg);
      LAS float* li2 = (LAS float*)(lds + OFF_WS) + wid * 64;
      if (hib == 0) li2[r32b] = l_reg; asm volatile("s_waitcnt lgkmcnt(0)" ::: "memory");
      const unsigned tok0 = (unsigned)(bh >> 3) * SEQ + (unsigned)P0 + (unsigned)(wid * QBLK);
      bf16* Ow = (bf16*)(C.ws + WS_MIX) + (size_t)tok0 * DM + 1024 + (bh & 7) * HD; float* SSw = (float*)(C.ws + WS_SMALL + SM_SSQ2) + (size_t)tok0 * 8 + (bh & 7);
      const unsigned stg0 = (unsigned)(uintptr_t)lds + (unsigned)(wid < 4 ? 16384 + wid * 8192 : wid < 6 ? 65536 + (wid - 4) * 8192 : LDSB + (wid - 6) * 8192);
      unsigned swa = stg0 + (unsigned)hib * 1024u + (unsigned)r32b * 2u; asm volatile("" : "+v"(swa));
      LAS unsigned char* swp = (LAS unsigned char*)(uintptr_t)swa;
      const unsigned sbase = (unsigned)(4 * hib) * 8; float sqk = 0.f;
#pragma unroll
      for (int r = 0; r < 16; ++r) { const unsigned ro = (unsigned)((r & 3) + 8 * (r >> 2)); const float rli = __builtin_amdgcn_rcpf(li2[ro + 4 * hib]); float sq = 0.f;
#pragma unroll
          for (int d0 = 0; d0 < 4; ++d0) { const float v = o[d0][r] * rli; sq += v * v;
              const float vn = lane_xor<1>(v);
              if ((r32b & 1) == 0) *(LAS unsigned*)(swp + ro * 256 + d0 * 64) = cvtpk(v, vn); }
          sq = sum32(sq);
          sqk = (r32b == r) ? sq : sqk; }
      if (r32b < 16) SSw[sbase + ((r32b & 3) + 8 * (r32b >> 2)) * 8] = sqk;
      asm volatile("s_waitcnt lgkmcnt(0)" ::: "memory");
      { const int ln = r32b + 32 * hib; unsigned sra = stg0 + (unsigned)(ln >> 4) * 256u + (unsigned)(ln & 15) * 16u; asm volatile("" : "+v"(sra));
        const LAS unsigned char* srp = (const LAS unsigned char*)(uintptr_t)sra;
        bf16* Or = Ow + (size_t)(ln >> 4) * DM + (ln & 15) * 8;
#pragma unroll
        for (int hb = 0; hb < 2; ++hb) { u32x4 vq[4];
#pragma unroll
          for (int it = 0; it < 4; ++it) vq[it] = *(const LAS u32x4*)(srp + (16 * hb + 4 * it) * 256);
#pragma unroll
          for (int it = 0; it < 4; ++it) *(u32x4*)(Or + (size_t)(16 * hb + 4 * it) * DM) = vq[it]; } } }
#undef KBASE
#undef MASKT
#undef HALF_STEP
}
__device__ __forceinline__ void finish(Seam& S) { asm volatile("" :: "v"(S.qx)); asm volatile("s_waitcnt vmcnt(0) lgkmcnt(0)" ::: "memory"); __syncthreads(); }
#undef WAITBAR
#undef OKV
#undef DMA16
#undef DMA_TILE
#undef DMA_OFFS
#undef QLOAD
}


struct S5Frag { bf16x8 ua, uf0, uf1; };
template <bool READOUT>
__device__ __forceinline__ S5Frag s5_load(const bf16* U, int tok0, int g, int lane) {
    S5Frag f; const int r32 = lane & 31, hi = lane >> 5;
    f.ua = *(const bf16x8*)(U + (size_t)(tok0 + r32) * DSSM + g * 16 + 8 * hi);
    if (READOUT) { f.uf0 = *(const bf16x8*)(U + (size_t)(tok0 + (lane & 15)) * DSSM + g * 16 + 8 * ((lane >> 4) & 1));
                   f.uf1 = *(const bf16x8*)(U + (size_t)(tok0 + 16 + (lane & 15)) * DSSM + g * 16 + 8 * ((lane >> 4) & 1)); }
    else { f.uf0 = f.ua; f.uf1 = f.ua; }
    return f;
}
#ifndef PSTAGE
#define PSTAGE true
#endif
#ifndef SSTAGE
#define SSTAGE true
#endif
template <bool READOUT, bool STAGE = true>
__device__ __forceinline__ void s5_scan32(const S5Frag& F, bf16* GYD, LAS unsigned char* ST, int srow, int tok0, int g, float a_re, float a_im, const bf16x8 (&bm)[4], const bf16x8 (&cm)[4], const bf16x8 dfrag,
                                          LAS unsigned char* Hs, float& h_re, float& h_im, int lane) {
    const int r32 = lane & 31, hi = lane >> 5, p = r32 + 32 * hi;
    f32x16 D0 = __builtin_amdgcn_mfma_f32_32x32x16_bf16(F.ua, bm[0], f32x16{}, 0, 0, 0);
    f32x16 D1 = __builtin_amdgcn_mfma_f32_32x32x16_bf16(F.ua, bm[1], f32x16{}, 0, 0, 0);
    f32x16 D2 = __builtin_amdgcn_mfma_f32_32x32x16_bf16(F.ua, bm[2], f32x16{}, 0, 0, 0);
    f32x16 D3 = __builtin_amdgcn_mfma_f32_32x32x16_bf16(F.ua, bm[3], f32x16{}, 0, 0, 0);
#pragma unroll
    for (int r = 0; r < 16; ++r) {
        auto s0 = __builtin_amdgcn_permlane32_swap(__float_as_uint(D0[r]), __float_as_uint(D1[r]), false, false); D0[r] = __uint_as_float(s0[0]); D1[r] = __uint_as_float(s0[1]);
        auto s1 = __builtin_amdgcn_permlane32_swap(__float_as_uint(D2[r]), __float_as_uint(D3[r]), false, false); D2[r] = __uint_as_float(s1[0]); D3[r] = __uint_as_float(s1[1]);
    }
#pragma unroll
    for (int s = 0; s < 32; ++s) {
        const int hs = (s >> 2) & 1, rs_ = (s & 3) + 4 * (s >> 3);
        const float bre = hs ? D1[rs_] : D0[rs_], bim = hs ? D3[rs_] : D2[rs_];
        const float nre = fmaf(a_re, h_re, fmaf(-a_im, h_im, bre)), nim = fmaf(a_re, h_im, fmaf(a_im, h_re, bim));
        h_re = nre; h_im = nim;
        if (READOUT) *(LAS unsigned*)(Hs + s * 272 + p * 4) = cvtpk_nv(h_re, h_im);
    }
    if (READOUT) {
        asm volatile("s_waitcnt lgkmcnt(0)" ::: "memory");
#pragma unroll
        for (int tb = 0; tb < 2; ++tb) {
            f32x4 y = __builtin_amdgcn_mfma_f32_16x16x32_bf16(tb == 0 ? F.uf0 : F.uf1, dfrag, (f32x4){0.f, 0.f, 0.f, 0.f}, 0, 0, 0);
#pragma unroll
            for (int kk = 0; kk < 4; ++kk) { const bf16x8 ha = *(const LAS bf16x8*)(Hs + (16 * tb + (lane & 15)) * 272 + kk * 64 + (lane >> 4) * 16);
                y = __builtin_amdgcn_mfma_f32_16x16x32_bf16(ha, cm[kk], y, 0, 0, 0); }
#pragma unroll
            for (int r = 0; r < 4; ++r) { const int t = 16 * tb + 4 * (lane >> 4) + r; const size_t tok = (size_t)(tok0 + t);
                if (STAGE) *(LAS unsigned short*)(ST + (srow + t) * 32 + (lane & 15) * 2) = (unsigned short)f2bf(gelu_tanh(y[r]));
                else GYD[tok * DSSM + g * 16 + (lane & 15)] = f2bf(gelu_tanh(y[r])); }
        }
        asm volatile("s_waitcnt lgkmcnt(0)" ::: "memory");
    }
}
__device__ __forceinline__ void s5_flush(LAS const unsigned char* ST, bf16* GY, int tok0, int nrow, int g, int lane) {
    asm volatile("s_waitcnt lgkmcnt(0)" ::: "memory");
    for (int r = lane >> 1; r < nrow; r += 32) { const u32x4 v = *(const LAS u32x4*)(ST + r * 32 + (lane & 1) * 16);
        *(u32x4*)(GY + (size_t)(tok0 + r) * DSSM + g * 16 + (lane & 1) * 8) = v; }
    asm volatile("s_waitcnt lgkmcnt(0)" ::: "memory");
}
__device__ __forceinline__ bf16x8 s5_dfrag(float dsk, int lane) {
    const int i = lane & 15, kq = lane >> 4; bf16x8 d = {0, 0, 0, 0, 0, 0, 0, 0};
    const short dv = (short)f2bf(dsk);
#pragma unroll
    for (int jj = 0; jj < 8; ++jj) d[jj] = (8 * kq + jj == i) ? dv : (short)0;
    return d;
}

#define XB_TMO      128
#define XB_XCNT(j)  (256  + 64 * (j))
#define XB_XSUB(j)  (1280 + 64 * (j))
#define XB_XGEN(j)  (2304 + 64 * (j))
#define XB_TOP      3328
#define XB_TOPGEN   3392
#define XCD_BAR_WORDS 3456
#define XB_SPIN_CAP (1u << 18)
__device__ __forceinline__ unsigned xb_ld(unsigned* p)              { return __hip_atomic_load(p, __ATOMIC_RELAXED, __HIP_MEMORY_SCOPE_AGENT); }
__device__ __forceinline__ unsigned xb_add(unsigned* p, unsigned v) { return __hip_atomic_fetch_add(p, v, __ATOMIC_RELAXED, __HIP_MEMORY_SCOPE_AGENT); }
__device__ __forceinline__ unsigned xb_xcc_id() { return (unsigned)__builtin_amdgcn_s_getreg((3 << 11) | 20) & 0xFu; }
#define XB_SPIN(cond, bar) do { unsigned _sp = 0; while (cond) { __builtin_amdgcn_s_sleep(1); \
    if ((++_sp & 255u) == 0u) { if (xb_ld(&(bar)[XB_TMO])) break; if (_sp > XB_SPIN_CAP) { atomicAdd(&(bar)[XB_TMO], 1u); break; } } } } while (0)
struct XcdBarrier { unsigned* bar; unsigned x; volatile LAS unsigned* st; };
__device__ __forceinline__ XcdBarrier xcd_barrier_post(unsigned* bar, volatile LAS unsigned* st) {
    XcdBarrier b; b.bar = bar; b.x = xb_xcc_id(); b.st = st;
    if (threadIdx.x == 0) (void)xb_add(&bar[XB_XCNT(b.x)], 1u);
    return b;
}
__device__ __forceinline__ void xcd_barrier_complete(unsigned* bar, unsigned x, unsigned& nloc, unsigned& nx) {
    const unsigned G = gridDim.x * gridDim.y * gridDim.z;
    unsigned sum, cnt, mine, sp = 0u;
    for (;;) {
        sum = 0u; cnt = 0u; mine = 0u;
#pragma unroll
        for (unsigned j = 0; j < 16; ++j) { const unsigned c = xb_ld(&bar[XB_XCNT(j)]); sum += c; cnt += (c > 0u) ? 1u : 0u; mine = (j == x) ? c : mine; }
        if (sum == G) break;
        __builtin_amdgcn_s_sleep(1);
        if ((++sp & 255u) == 0u) { if (xb_ld(&bar[XB_TMO])) break; if (sp > XB_SPIN_CAP) { atomicAdd(&bar[XB_TMO], 1u); break; } }
    }
    nloc = mine > 0u ? mine : 1u; nx = cnt > 0u ? cnt : 1u;
}
__device__ __forceinline__ void xcd_barrier(const XcdBarrier& b) {
    asm volatile("s_waitcnt vmcnt(0)" ::: "memory");
    __syncthreads();
    if (threadIdx.x == 0) {
        unsigned* bar = b.bar;
        __builtin_amdgcn_s_waitcnt(0);
        unsigned nloc = b.st[0], nx = b.st[1];
        if (nloc == 0u) { xcd_barrier_complete(bar, b.x, nloc, nx); b.st[0] = nloc; b.st[1] = nx; }
        const unsigned old = xb_add(&bar[XB_XSUB(b.x)], 1u);
        const unsigned gen = old / nloc;
        if (old + 1u == (gen + 1u) * nloc) {
            __builtin_amdgcn_fence(__ATOMIC_RELEASE, "agent");
            asm volatile("s_waitcnt vmcnt(0)" ::: "memory");
            const unsigned og = xb_add(&bar[XB_TOP], 1u);
            const unsigned tg = og / nx;
            if (og + 1u == (tg + 1u) * nx) xb_add(&bar[XB_TOPGEN], 1u);
            else XB_SPIN(xb_ld(&bar[XB_TOPGEN]) == tg, bar);
            xb_add(&bar[XB_XGEN(b.x)], 1u);
            __builtin_amdgcn_fence(__ATOMIC_ACQUIRE, "agent");
            asm volatile("s_waitcnt vmcnt(0)" ::: "memory");
        } else {
            XB_SPIN(xb_ld(&bar[XB_XGEN(b.x)]) == gen, bar);
            __builtin_amdgcn_fence(__ATOMIC_ACQUIRE, "agent");
            asm volatile("s_waitcnt vmcnt(0)" ::: "memory");
        }
    }
    __syncthreads();
}

__device__ __forceinline__ void split3(float x, unsigned short& h, unsigned short& m, unsigned short& l) {
    h = (unsigned short)f2bf(x); const float r1 = x - bf2f(h); m = (unsigned short)f2bf(r1); const float r2 = r1 - bf2f(m); l = (unsigned short)f2bf(r2);
}

__global__ void __launch_bounds__(512, 2) hymba_fwd(Args args) {
    extern __shared__ __attribute__((aligned(16))) unsigned char lds_raw[];
    cg::grid_group grid = cg::this_grid();
    LAS unsigned char* lds = (LAS unsigned char*)lds_raw;
    const int wave = __builtin_amdgcn_readfirstlane(threadIdx.x >> 6);
    const int G = gridDim.x, bx = blockIdx.x;
    volatile LAS unsigned* xst = (volatile LAS unsigned*)(lds + LDS_BYTES - 16);
    if (threadIdx.x < 4) xst[threadIdx.x] = 0u;
    __syncthreads();
    const XcdBarrier xbar = xcd_barrier_post((unsigned*)((const __attribute__((address_space(4))) Args*)__builtin_amdgcn_kernarg_segment_ptr())->ws, xst);
    if (gridDim.y == 0x7fffffffu) grid.sync();
#define GRID_SYNC() xcd_barrier(xbar)
    const int gw = bx * 8 + wave, NGW = G * 8;
#define PHASE_PTRS \
    const __attribute__((address_space(4))) Args* A_ = (const __attribute__((address_space(4))) Args*)__builtin_amdgcn_kernarg_segment_ptr(); asm volatile("" : "+s"(A_)); \
    unsigned char* const ws = A_->ws; float* const out = A_->out; (void)ws; (void)out;
#define IN(i) (A_->in[i])
#define x_prompt IN(0)
#define x_sample IN(1)
#define cache_k IN(2)
#define cache_v IN(3)
#define cache_logf IN(4)
#define st_re IN(5)
#define st_im IN(6)
#define Win_t ((bf16*)(ws + WS_WIN))
#define Wglu_t ((bf16*)(ws + WS_WGLU))
#define Wout_t ((bf16*)(ws + WS_WOUT))
#define Wup_t ((bf16*)(ws + WS_WUP))
#define Wdn_t ((bf16*)(ws + WS_WDN))
#define RS1 ((float*)(ws + WS_SMALL + SM_RS1))
#define ABAR ((float*)(ws + WS_SMALL + SM_ABAR))
#define APOW ((float*)(ws + WS_SMALL + SM_APOW))
#define BMT ((bf16*)(ws + WS_SMALL + SM_BMT))
#define CMT ((bf16*)(ws + WS_SMALL + SM_CMT))
#define SSQ1 ((float*)(ws + WS_SMALL + SM_SSQ1))
#define SSQ2 ((float*)(ws + WS_SMALL + SM_SSQ2))
#define SSQ3 ((float*)(ws + WS_SSQ3))
#define XB ((bf16*)(ws + WS_XB))
#define U ((bf16*)(ws + WS_U))
#define QKraw ((float*)(ws + WS_QKRAW))
#define Qh ((bf16*)(ws + WS_QH))
#define Kh ((bf16*)(ws + WS_KH))
#define Vh ((bf16*)(ws + WS_VH))
#define GY ((bf16*)(ws + WS_GY))
#define MIX ((bf16*)(ws + WS_MIX))
#define X1B ((bf16*)(ws + WS_X1B))
#define Hb ((bf16*)(ws + WS_H))
#define CLK ((bf16*)(ws + WS_CLK))
#define CLQ ((bf16*)(ws + WS_CLQ))

    for (int rep_ = 0; rep_ < REPS(1); ++rep_) { if (rep_) GRID_SYNC();
        PHASE_PTRS
        const int tid = opaque_tid(wave), lane = tid & 63;
        LAS float* scr = (LAS float*)(lds + wave * 16384);
        constexpr int I_IN = 32 * 128;
        for (int it = gw; it < I_IN; it += NGW) p0_transpose_item(IN(8), NINW, DM, 128, IN(7), nullptr, Win_t, scr, it, lane);
        __syncthreads();
        LAS float* wfT = (LAS float*)lds;
        for (int e = tid; e < 8 * DM; e += 512) { const int k = e >> 3, h = e & 7; wfT[h * DM + k] = IN(8)[(size_t)k * NINW + 4096 + h] * IN(7)[k]; }
        __syncthreads();
        f32x4 vn[8];
        { const int m0 = gw < MT ? gw : 0; const float* xr0 = m0 < MP ? x_prompt + (size_t)m0 * DM : x_sample + (size_t)(m0 - MP) * DM;
#pragma unroll
          for (int j = 0; j < 8; ++j) vn[j] = *(const f32x4*)(xr0 + 4 * lane + 256 * j); }
        for (int m = gw; m < MT; m += NGW) {
            f32x4 v[8]; float s = 0.f; float dt[8];
#pragma unroll
            for (int h = 0; h < 8; ++h) dt[h] = 0.f;
#pragma unroll
            for (int j = 0; j < 8; ++j) { v[j] = vn[j]; s += (v[j][0] * v[j][0] + v[j][1] * v[j][1]) + (v[j][2] * v[j][2] + v[j][3] * v[j][3]); }
#pragma unroll
            for (int j = 0; j < 8; ++j) { u32x2 w; w.x = cvtpk(v[j][0], v[j][1]); w.y = cvtpk(v[j][2], v[j][3]); *(u32x2*)(XB + (size_t)m * DM + 4 * lane + 256 * j) = w; }
            { const int mn = m + NGW < MT ? m + NGW : m; const float* xrn = mn < MP ? x_prompt + (size_t)mn * DM : x_sample + (size_t)(mn - MP) * DM;
#pragma unroll
              for (int j = 0; j < 8; ++j) vn[j] = *(const f32x4*)(xrn + 4 * lane + 256 * j); }
#pragma unroll
            for (int j = 0; j < 8; ++j)
#pragma unroll
                for (int h = 0; h < 8; ++h) { const f32x4 w = *(const LAS f32x4*)(wfT + h * DM + 4 * lane + 256 * j); dt[h] += (v[j][0] * w[0] + v[j][1] * w[1]) + (v[j][2] * w[2] + v[j][3] * w[3]); }
            s = wave_sum(s); const float rs = 1.0f / sqrtf(s * (1.0f / DM) + EPS);
#pragma unroll
            for (int h = 0; h < 8; ++h) dt[h] = wave_sum(dt[h]);
            if (lane == 0) RS1[m] = rs;
            if (lane < 8) { float z = 0.f;
#pragma unroll
                for (int h = 0; h < 8; ++h) z = (lane == h) ? dt[h] : z;
                z = z * rs + IN(9)[lane];
                const float lf = log_sigmoidf_(z);
                out[(m < MP ? O_LFP + (size_t)m * 8 : O_LFS + (size_t)(m - MP) * 8) + lane] = lf; }
        }
    }
    GRID_SYNC();

    for (int rep_ = 0; rep_ < REPS(2); ++rep_) { if (rep_) GRID_SYNC();
        PHASE_PTRS
        pg8::Gemm g{XB, Win_t, MT, 4096, DM, DM}; pg8::StaticOrder S; S.init(MT, 4096, G, bx);
        EpiIn E{RS1, U, out, Qh, Kh, Vh, IN(19), IN(20), (LAS float*)(lds + AUX_OFF)};
        pg8::gemm_phase<EpiIn, pg8::StaticOrder>(lds, g, S, E, wave);
        { const int busy = S.nwg % G, nfree = busy ? G - busy : G, fi = busy ? bx - busy : bx;
          if (fi >= 0 && rep_ == 0) { const int tq_ = opaque_tid(wave);
            if (tq_ < 32) for (int gt = fi * 32 + tq_; gt < NG * NP; gt += nfree * 32) {
            const int g = gt >> 6, p = gt & 63;
            const float a_re = IN(10)[gt], a_im = IN(11)[gt], step = expf(IN(12)[g]);
            const float mag = expf(a_re * step); float sn, cs; sincosf(a_im * step, &sn, &cs);
            const float ab_re = mag * cs, ab_im = mag * sn;
            const float den = a_re * a_re + a_im * a_im, nr = ab_re - 1.0f, ni = ab_im;
            const float fr_ = (nr * a_re + ni * a_im) / den, fi_ = (ni * a_re - nr * a_im) / den;
            ABAR[gt * 2] = ab_re; ABAR[gt * 2 + 1] = ab_im;
            float pr = ab_re, pi = ab_im;
#pragma unroll 1
            for (int q = 0; q < 9; ++q) { const float nr2 = pr * pr - pi * pi, ni2 = 2.f * pr * pi; pr = nr2; pi = ni2; }
            APOW[gt * 2] = pr; APOW[gt * 2 + 1] = pi;
            const float* bre = IN(13) + (size_t)gt * 16; const float* bim = IN(14) + (size_t)gt * 16;
#pragma unroll
            for (int j = 0; j < 16; ++j) { const float br = bre[j], bi = bim[j];
                BMT[((size_t)g * 128 + p) * 16 + j] = (bf16)f2bf(fr_ * br - fi_ * bi);
                BMT[((size_t)g * 128 + 64 + p) * 16 + j] = (bf16)f2bf(fr_ * bi + fi_ * br); }
#pragma unroll
            for (int i = 0; i < 16; ++i) { const float cr = IN(15)[((size_t)g * 16 + i) * 64 + p], ci = IN(16)[((size_t)g * 16 + i) * 64 + p];
                CMT[((size_t)g * 16 + i) * 128 + 2 * p] = (bf16)f2bf(cr); CMT[((size_t)g * 16 + i) * 128 + 2 * p + 1] = (bf16)f2bf(-ci); }
            } }
          if (fi >= 0 && fi < 16 && rep_ == 0) {
            const int tid = opaque_tid(wave), lane = tid & 63;
            const int bh = fi, b = bh >> 3, h = bh & 7;
            LAS float* red = (LAS float*)(lds + AUX_OFF);
            float gm = 0.f; if (tid < 128) gm = fabsf(IN(19)[tid] * IN(20)[tid]);
            gm = wave_max(gm);
            if (lane == 0) red[16 + wave] = gm;
            const float* lf = out + O_LFP + (size_t)b * SEQ * 8 + h;
            float loc[16]; float s = 0.f;
#pragma unroll
            for (int i = 0; i < 16; ++i) { loc[i] = lf[(size_t)(tid * 16 + i) * 8]; s += loc[i]; }
            const float inc = wave_incl_scan(s);
            if (lane == 63) red[wave] = inc;
            __syncthreads();
            float base = inc - s; for (int w2 = 0; w2 < wave; ++w2) base += red[w2];
            const float MB = fmaxf(red[16], red[17]) * 11.313708498984761f * LOG2E;
            float run = base;
#pragma unroll
            for (int i = 0; i < 16; ++i) { run += loc[i]; const int t = tid * 16 + i; const float cl = run * LOG2E;
                unsigned short a, bb, c; split3(-cl, a, bb, c);
                u32x4 w0 = {(unsigned)a | ((unsigned)bb << 16), (unsigned)c | (0x3F80u << 16), 0x3F803F80u, 0u}; const u32x4 z = {0u, 0u, 0u, 0u};
                u32x4* kx = (u32x4*)(CLK + ((size_t)bh * SEQ + t) * 16); kx[0] = w0; kx[1] = z;
                split3(cl - MB, a, bb, c);
                u32x4 w1 = {0x3F803F80u, 0x3F80u | ((unsigned)a << 16), (unsigned)bb | ((unsigned)c << 16), 0u};
                u32x4* qx = (u32x4*)(CLQ + ((size_t)bh * SEQ + t) * 16); qx[0] = w1; qx[1] = z;
                ((float*)(ws + WS_SMALL + SM_CLF))[(size_t)bh * SEQ + t] = cl; }
            if (tid == 0) ((float*)(ws + WS_SMALL + SM_CLF))[16 * SEQ] = 2.f * MB + 37.f;
            __syncthreads();
          }
          if (fi >= 0) { const int lane = opaque_tid(wave) & 63; LAS float* scr = (LAS float*)(lds + wave * 16384);
              constexpr int I_GLU = 16 * 32, I_OUT = 32 * 64, I_UP = 32 * 256;
              for (int it = fi * 8 + wave; it < I_GLU + I_OUT + I_UP; it += nfree * 8) { int r = it;
                  if (r < I_GLU) { p0_transpose_item(IN(18), 1024, 1024, 32, nullptr, nullptr, Wglu_t, scr, r, lane); continue; } r -= I_GLU;
                  if (r < I_OUT) { p0_transpose_item(IN(23), DM, DM, 64, IN(21), IN(22), Wout_t, scr, r, lane); continue; } r -= I_OUT;
                  p0_transpose_item(IN(25), DFF, DM, 256, IN(24), nullptr, Wup_t, scr, r, lane); } } }
    }
    GRID_SYNC();

    for (int rep_ = 0; rep_ < REPS(4); ++rep_) { if (rep_) GRID_SYNC();
        PHASE_PTRS
        const int tid = opaque_tid(wave), lane = tid & 63;
        {
            const int nb = bx >> 7, oc = (bx >> 4) & 7, seg = bx & 15, g = oc * 8 + wave, ng = nb * 64 + g;
            const int r32 = lane & 31, hi = lane >> 5, p = r32 + 32 * hi;
            const float a_re = ABAR[(g * 64 + p) * 2], a_im = ABAR[(g * 64 + p) * 2 + 1];
            bf16x8 bm[4], cm[4];
#pragma unroll
            for (int b = 0; b < 4; ++b) bm[b] = *(const bf16x8*)(BMT + ((size_t)g * 128 + 32 * b + r32) * 16 + 8 * hi);
#pragma unroll
            for (int kk = 0; kk < 4; ++kk) cm[kk] = *(const bf16x8*)(CMT + ((size_t)g * 16 + (lane & 15)) * 128 + 32 * kk + 8 * (lane >> 4));
            const float dsk = IN(17)[g * 16 + (lane & 15)];
            LAS unsigned char* Hs = lds + wave * 8704;
            LAS unsigned char* STG = lds + 8 * 8704 + wave * 4096;
            float* EX = (float*)(ws + WS_SMALL + SM_S5EX) + (size_t)ng * (16 * 128); unsigned* xcnt = (unsigned*)(ws + 40960) + (nb * 8 + oc);
            const int tokb = nb * SEQ + seg * 512;
            const bf16x8 dfrag = s5_dfrag(dsk, lane);
            float h_re = 0.f, h_im = 0.f;
            { S5Frag F = s5_load<false>(U, tokb, g, lane);
#pragma unroll 1
              for (int blk = 0; blk < 16; ++blk) { const S5Frag Fn = s5_load<false>(U, tokb + 32 * (blk < 15 ? blk + 1 : blk), g, lane);
                  s5_scan32<false>(F, nullptr, Hs, 0, tokb + 32 * blk, g, a_re, a_im, bm, cm, dfrag, Hs, h_re, h_im, lane); F = Fn; } }
            __hip_atomic_store(EX + (seg * 64 + p) * 2, h_re, __ATOMIC_RELAXED, __HIP_MEMORY_SCOPE_AGENT); __hip_atomic_store(EX + (seg * 64 + p) * 2 + 1, h_im, __ATOMIC_RELAXED, __HIP_MEMORY_SCOPE_AGENT);
            asm volatile("s_waitcnt vmcnt(0)" ::: "memory");
            __syncthreads();
            if (tid == 0) { __builtin_amdgcn_fence(__ATOMIC_RELEASE, "agent"); asm volatile("s_waitcnt vmcnt(0)" ::: "memory"); __hip_atomic_fetch_add(xcnt, 1u, __ATOMIC_RELAXED, __HIP_MEMORY_SCOPE_AGENT); }
            { const int n = nb * 16 + seg;
              float s_re = st_re[((size_t)n * 64 + g) * 64 + p], s_im = st_im[((size_t)n * 64 + g) * 64 + p];
              const S5Frag F = s5_load<true>(U, MP + n * 32, g, lane);
              s5_scan32<true, true>(F, GY, STG, 0, MP + n * 32, g, a_re, a_im, bm, cm, dfrag, Hs, s_re, s_im, lane);
              out[O_HRS + ((size_t)n * 64 + g) * 64 + p] = s_re; out[O_HIS + ((size_t)n * 64 + g) * 64 + p] = s_im;
              s5_flush(STG, GY, MP + n * 32, 32, g, lane); }
            if (tid == 0) { unsigned sp = 0; while (__hip_atomic_load(xcnt, __ATOMIC_RELAXED, __HIP_MEMORY_SCOPE_AGENT) < 16u) { __builtin_amdgcn_s_sleep(2); if (++sp > (1u << 22)) break; }
                __builtin_amdgcn_fence(__ATOMIC_ACQUIRE, "agent"); asm volatile("s_waitcnt vmcnt(0)" ::: "memory"); }
            __syncthreads();
            const float pw_re = APOW[(g * 64 + p) * 2], pw_im = APOW[(g * 64 + p) * 2 + 1];
            h_re = 0.f; h_im = 0.f;
            { float er[15], ei[15];
#pragma unroll
              for (int s2 = 0; s2 < 15; ++s2) { er[s2] = 0.f; ei[s2] = 0.f;
                  if (s2 < seg) { er[s2] = __hip_atomic_load(EX + (s2 * 64 + p) * 2, __ATOMIC_RELAXED, __HIP_MEMORY_SCOPE_AGENT); ei[s2] = __hip_atomic_load(EX + (s2 * 64 + p) * 2 + 1, __ATOMIC_RELAXED, __HIP_MEMORY_SCOPE_AGENT); } }
#pragma unroll
              for (int s2 = 0; s2 < 15; ++s2) if (s2 < seg) { const float nre = pw_re * h_re - pw_im * h_im + er[s2], nim = pw_re * h_im + pw_im * h_re + ei[s2]; h_re = nre; h_im = nim; } }
            { S5Frag F = s5_load<true>(U, tokb, g, lane);
#pragma unroll 1
              for (int ob = 0; ob < 4; ++ob) {
#pragma unroll 1
                for (int ib = 0; ib < 4; ++ib) { const int blk = ob * 4 + ib; const S5Frag Fn = s5_load<true>(U, tokb + 32 * (blk < 15 ? blk + 1 : blk), g, lane);
                  s5_scan32<true, PSTAGE>(F, GY, STG, ib * 32, tokb + 32 * blk, g, a_re, a_im, bm, cm, dfrag, Hs, h_re, h_im, lane); F = Fn; }
                if (PSTAGE) s5_flush(STG, GY, tokb + 128 * ob, 128, g, lane); } }
            if (seg == 15) { out[O_HRP + (size_t)(nb * 64 + g) * 64 + p] = h_re; out[O_HIP + (size_t)(nb * 64 + g) * 64 + p] = h_im; }
        }
    }
    GRID_SYNC();

    if (PHMASK & 8) {
        PHASE_PTRS
        const int tid = opaque_tid(wave), lane = tid & 63;
        for (int rep_ = 0; rep_ < REPS(256); ++rep_) { if (rep_) GRID_SYNC(); pg8::Gemm g{GY, Wglu_t, MT, 1024, 1024, 1024}; pg8::StaticOrder S; S.init(MT, 1024, G, bx);
          EpiGlu E{GY, MIX, SSQ1};
          pg8::gemm_phase<EpiGlu, pg8::StaticOrder>(lds, g, S, E, wave); }
        __syncthreads();
#pragma unroll 1
        for (int st_ = 0; st_ < 3; ++st_) {
        const int role_ = (bx & 1) ? (st_ == 0 ? 1 : st_ == 1 ? 0 : 2) : st_;
        if (role_ == 0) {
        for (int rep_ = 0; rep_ < REPS(512); ++rep_) for (int item = bx; item < DB * NH; item += G) {
            const int n = item >> 3, h = item & 7;
            const int tid = opaque_tid(wave), lane = tid & 63;
            const int r32 = lane & 31, hi = lane >> 5;
            LAS float* CLs = (LAS float*)(lds + AUX_OFF);
            LAS float* red = CLs + 2096;
            { const float* lfc = cache_logf + ((size_t)n * PAST) * 8 + h;
              float loc[4]; float s = 0.f;
#pragma unroll
              for (int i = 0; i < 4; ++i) { loc[i] = lfc[(size_t)(tid * 4 + i) * 8]; s += loc[i]; }
              const float inc = wave_incl_scan(s);
              float gm = 0.f; if (tid < 128) gm = fabsf(IN(19)[tid] * IN(20)[tid]);
              gm = wave_max(gm);
              if (lane == 63) red[wave] = inc;
              if (lane == 0) red[16 + wave] = gm;
              __syncthreads();
              float base = inc - s; float tot = 0.f;
              for (int w2 = 0; w2 < 8; ++w2) { const float rv = red[w2]; if (w2 < wave) base += rv; tot += rv; }
              float run = base;
#pragma unroll
              for (int i = 0; i < 4; ++i) { run += loc[i]; CLs[tid * 4 + i] = run * LOG2E; }
              if (wave == 0) { float v = (lane < 32) ? out[O_LFS + (size_t)(n * 32 + lane) * 8 + h] : 0.f;
                  v = wave_incl_scan(v);
                  if (lane < 32) CLs[2048 + lane] = (tot + v) * LOG2E; }
              __syncthreads(); }
            const float MB = fmaxf(red[16], red[17]) * 11.313708498984761f * LOG2E;
            int kb_lo;
            { const float thr = 2.f * MB + 37.f; const float ce = CLs[lane * 32 + 31];
              kb_lo = __builtin_amdgcn_readfirstlane(wave_min_i((CLs[2048] - ce >= -thr) ? lane : 64)); }
            const fox::srd_t sK = fox::mksrd(cache_k, (unsigned)DB * PAST * NH * HD * 4u), sV = fox::mksrd(cache_v, (unsigned)DB * PAST * NH * HD * 4u);
            const fox::srd_t sQh = fox::mksrd(Qh, 34u * 1048576u), sKh = fox::mksrd(Kh, 34u * 1048576u), sVh = fox::mksrd(Vh, 34u * 1048576u);
            const unsigned onew = (unsigned)(2 * NH * SEQ * HD + (n * NH + h) * DSEQ * HD) * 2u;
            bf16x8 qf[8];
#pragma unroll
            for (int d0 = 0; d0 < 8; ++d0) qf[d0] = fox::bload8(sQh, (unsigned)((r32 * HD + 64 * hi + 8 * d0) * 2), onew);
            bf16x8 qx;
            { unsigned short a, bb, c; split3(CLs[2048 + r32] - MB, a, bb, c);
              u32x4 w = {0x3F803F80u, 0x3F80u | ((unsigned)a << 16), (unsigned)bb | ((unsigned)c << 16), 0u}; if (hi) w = (u32x4){0u, 0u, 0u, 0u};
              qx = __builtin_bit_cast(bf16x8, w); }
            f32x16 o[4] = {}; float l_reg = 0.f;
            const unsigned vok = (unsigned)(r32 * (NH * HD * 4) + hi * 256), vov = (unsigned)(hi * 4 * (NH * HD * 4) + r32 * 4);
            const unsigned vokn = (unsigned)((r32 * HD + 64 * hi) * 2), vovn = (unsigned)((hi * 4 * HD + r32) * 2);
#pragma unroll 1
            for (int kb = kb_lo + wave; kb < 65; kb += 8) {
                unsigned vok_ = vok, vokn_ = vokn, vovn_ = vovn, vqv = (unsigned)hi * (NH * HD * 4) + (unsigned)r32 * 16u;
                asm volatile("" : "+v"(vok_), "+v"(vokn_), "+v"(vovn_), "+v"(vqv));
                f32x16 sc = {};
                bf16x8 kx;
                { unsigned short a, bb, c; const float clk = CLs[kb * 32 + r32]; split3(-clk, a, bb, c);
                  u32x4 w = {(unsigned)a | ((unsigned)bb << 16), (unsigned)c | (0x3F80u << 16), 0x3F803F80u, 0u}; if (hi) w = (u32x4){0u, 0u, 0u, 0u};
                  kx = __builtin_bit_cast(bf16x8, w); }
                const unsigned sob = (unsigned)(((n * PAST + kb * 32) * NH + h) * HD) * 4u;
                if (kb < 64) {
                    bf16x8 kf8[8];
                    { f32x4 kr[8][2];
#pragma unroll
                      for (int d0 = 0; d0 < 8; ++d0) {
                          kr[d0][0] = __builtin_bit_cast(f32x4, __builtin_amdgcn_raw_buffer_load_b128(sK, (int)(vok_ + d0 * 32), (int)sob, 0));
                          kr[d0][1] = __builtin_bit_cast(f32x4, __builtin_amdgcn_raw_buffer_load_b128(sK, (int)(vok_ + d0 * 32 + 16), (int)sob, 0)); }
                      asm volatile("" : "+v"(kr[0][0]), "+v"(kr[0][1]), "+v"(kr[1][0]), "+v"(kr[1][1]), "+v"(kr[2][0]), "+v"(kr[2][1]), "+v"(kr[3][0]), "+v"(kr[3][1]),
                                        "+v"(kr[4][0]), "+v"(kr[4][1]), "+v"(kr[5][0]), "+v"(kr[5][1]), "+v"(kr[6][0]), "+v"(kr[6][1]), "+v"(kr[7][0]), "+v"(kr[7][1]));
#pragma unroll
                      for (int d0 = 0; d0 < 8; ++d0) kf8[d0] = pack8(kr[d0][0], kr[d0][1]); }
#pragma unroll
                    for (int d0 = 0; d0 < 8; ++d0) sc = __builtin_amdgcn_mfma_f32_32x32x16_bf16(kf8[d0], qf[d0], sc, 0, 0, 0);
                    asm volatile("s_nop 15\n\ts_nop 15" :: "v"(kf8[0]), "v"(kf8[1]), "v"(kf8[2]), "v"(kf8[3]), "v"(kf8[4]), "v"(kf8[5]), "v"(kf8[6]), "v"(kf8[7]));
                } else {
                    { bf16x8 kn8[8];
#pragma unroll
                      for (int d0 = 0; d0 < 8; ++d0) kn8[d0] = fox::bload8(sKh, vokn_ + d0 * 16, onew);
                      asm volatile("" : "+v"(kn8[0]), "+v"(kn8[1]), "+v"(kn8[2]), "+v"(kn8[3]), "+v"(kn8[4]), "+v"(kn8[5]), "+v"(kn8[6]), "+v"(kn8[7]));
#pragma unroll
                      for (int d0 = 0; d0 < 8; ++d0) sc = __builtin_amdgcn_mfma_f32_32x32x16_bf16(kn8[d0], qf[d0], sc, 0, 0, 0);
                      asm volatile("s_nop 15\n\ts_nop 15" :: "v"(kn8[0]), "v"(kn8[1]), "v"(kn8[2]), "v"(kn8[3]), "v"(kn8[4]), "v"(kn8[5]), "v"(kn8[6]), "v"(kn8[7])); }
                }
                sc = __builtin_amdgcn_mfma_f32_32x32x16_bf16(kx, qx, sc, 0, 0, 0);
                if (kb == 64) {
#pragma unroll
                    for (int r = 0; r < 16; ++r) if (fox::crow(r, hi) > r32) sc[r] = -__builtin_inff();
                }
                float ps = 0.f;
#pragma unroll
                for (int r = 0; r < 16; ++r) { sc[r] = __builtin_amdgcn_exp2f(sc[r]); ps += sc[r]; }
                l_reg += ps;
                bf16x8 pa[2];
#pragma unroll
                for (int ks = 0; ks < 2; ++ks) { u32x4 w = {cvtpk(sc[8 * ks + 0], sc[8 * ks + 1]), cvtpk(sc[8 * ks + 2], sc[8 * ks + 3]), cvtpk(sc[8 * ks + 4], sc[8 * ks + 5]), cvtpk(sc[8 * ks + 6], sc[8 * ks + 7])};
                    pa[ks] = __builtin_bit_cast(bf16x8, w); }
                if (kb < 64) {
                    unsigned vta = (unsigned)(uintptr_t)lds + (unsigned)wave * 4224u + (unsigned)hi * 264u + (unsigned)r32 * 8u; asm volatile("" : "+v"(vta));
                    unsigned vra = (unsigned)(uintptr_t)lds + (unsigned)wave * 4224u + (unsigned)hi * (4u * 264u) + (unsigned)r32 * 2u; asm volatile("" : "+v"(vra));
                    LAS unsigned char* vtp = (LAS unsigned char*)(uintptr_t)vta; const LAS unsigned char* vrp = (const LAS unsigned char*)(uintptr_t)vra;
#pragma unroll
                    for (int ks = 0; ks < 2; ++ks) {
                        asm volatile("s_waitcnt lgkmcnt(0)" ::: "memory");
#pragma unroll
                        for (int qv = 0; qv < 2; ++qv) { f32x4 va[4];
#pragma unroll
                            for (int i = 0; i < 4; ++i) va[i] = __builtin_bit_cast(f32x4, __builtin_amdgcn_raw_buffer_load_b128(sV, (int)vqv, (int)(sob + (16 * ks + 8 * qv + 2 * i) * (NH * HD * 4)), 0));
                            asm volatile("" : "+v"(va[0]), "+v"(va[1]), "+v"(va[2]), "+v"(va[3]));
#pragma unroll
                            for (int i = 0; i < 4; ++i) { u32x2 w2; w2.x = cvtpk(va[i][0], va[i][1]); w2.y = cvtpk(va[i][2], va[i][3]); *(LAS u32x2*)(vtp + (8 * qv + 2 * i) * 264) = w2; } }
                        asm volatile("s_waitcnt lgkmcnt(0)" ::: "memory");
                        bf16x8 vw[4];
#pragma unroll
                        for (int d0 = 0; d0 < 4; ++d0) { u32x4 w;
#pragma unroll
                            for (int jj = 0; jj < 4; ++jj) { const int klo = 8 * (jj >> 1) + 2 * (jj & 1);
                                const unsigned lo16 = *(const LAS unsigned short*)(vrp + klo * 264 + d0 * 64), hi16 = *(const LAS unsigned short*)(vrp + (klo + 1) * 264 + d0 * 64);
                                w[jj] = lo16 | (hi16 << 16); }
                            vw[d0] = __builtin_bit_cast(bf16x8, w); }
                        asm volatile("" : "+v"(vw[0]), "+v"(vw[1]), "+v"(vw[2]), "+v"(vw[3]));
#pragma unroll
                        for (int d0 = 0; d0 < 4; ++d0) o[d0] = __builtin_amdgcn_mfma_f32_32x32x16_bf16(pa[ks], vw[d0], o[d0], 0, 0, 0);
                        asm volatile("s_nop 15\n\ts_nop 15" : "+v"(o[3]) : "v"(vw[0]), "v"(vw[1]), "v"(vw[2]), "v"(vw[3]), "v"(pa[ks]));
                    }
                } else {
                    unsigned vna = (unsigned)(uintptr_t)lds + (unsigned)wave * 4224u + (unsigned)(lane >> 4) * 264u + (unsigned)(lane & 15) * 16u; asm volatile("" : "+v"(vna));
                    unsigned vra = (unsigned)(uintptr_t)lds + (unsigned)wave * 4224u + (unsigned)hi * (4u * 264u) + (unsigned)r32 * 2u; asm volatile("" : "+v"(vra));
                    unsigned vnq = (unsigned)(lane >> 4) * 256u + (unsigned)(lane & 15) * 16u; asm volatile("" : "+v"(vnq));
                    LAS unsigned char* vnp = (LAS unsigned char*)(uintptr_t)vna; const LAS unsigned char* vrp = (const LAS unsigned char*)(uintptr_t)vra;
#pragma unroll
                    for (int ks = 0; ks < 2; ++ks) {
                        u32x4 vn4[4];
#pragma unroll
                        for (int i = 0; i < 4; ++i) vn4[i] = __builtin_amdgcn_raw_buffer_load_b128(sVh, (int)vnq, (int)(onew + (16 * ks + 4 * i) * (HD * 2)), 0);
                        asm volatile("" : "+v"(vn4[0]), "+v"(vn4[1]), "+v"(vn4[2]), "+v"(vn4[3]));
                        asm volatile("s_waitcnt lgkmcnt(0)" ::: "memory");
#pragma unroll
                        for (int i = 0; i < 4; ++i) { *(LAS u32x2*)(vnp + (4 * i) * 264) = (u32x2){vn4[i][0], vn4[i][1]}; *(LAS u32x2*)(vnp + (4 * i) * 264 + 8) = (u32x2){vn4[i][2], vn4[i][3]}; }
                        asm volatile("s_waitcnt lgkmcnt(0)" ::: "memory");
                        bf16x8 vw[4];
#pragma unroll
                        for (int d0 = 0; d0 < 4; ++d0) { u32x4 w;
#pragma unroll
                            for (int jj = 0; jj < 4; ++jj) { const int klo = 8 * (jj >> 1) + 2 * (jj & 1);
                                const unsigned lo16 = *(const LAS unsigned short*)(vrp + klo * 264 + d0 * 64), hi16 = *(const LAS unsigned short*)(vrp + (klo + 1) * 264 + d0 * 64);
                                w[jj] = lo16 | (hi16 << 16); }
                            vw[d0] = __builtin_bit_cast(bf16x8, w); }
                        asm volatile("" : "+v"(vw[0]), "+v"(vw[1]), "+v"(vw[2]), "+v"(vw[3]));
#pragma unroll
                        for (int d0 = 0; d0 < 4; ++d0) o[d0] = __builtin_amdgcn_mfma_f32_32x32x16_bf16(pa[ks], vw[d0], o[d0], 0, 0, 0);
                        asm volatile("s_nop 15\n\ts_nop 15" : "+v"(o[3]) : "v"(vw[0]), "v"(vw[1]), "v"(vw[2]), "v"(vw[3]), "v"(pa[ks]));
                    }
                }
                asm volatile("s_nop 15\n\ts_nop 15" : "+v"(o[3]));
            }
            __syncthreads();
            { const int tid = opaque_tid(wave), lane = tid & 63, r32 = lane & 31, hi = lane >> 5;
            LAS float* R = (LAS float*)lds;
#pragma unroll
            for (int d0 = 0; d0 < 4; ++d0)
#pragma unroll
                for (int r = 0; r < 16; ++r) R[(wave * 64 + d0 * 16 + r) * 64 + lane] = o[d0][r];
            red[32 + wave * 64 + lane] = l_reg;
            __syncthreads();
            float lt = 0.f;
#pragma unroll
            for (int w2 = 0; w2 < 8; ++w2) lt += red[32 + w2 * 64 + lane];
            { auto rr = __builtin_amdgcn_permlane32_swap(__float_as_uint(lt), __float_as_uint(lt), false, false); lt = __uint_as_float(rr[0]) + __uint_as_float(rr[1]); }
            float acc8[8];
#pragma unroll
            for (int k = 0; k < 8; ++k) { float a = 0.f;
#pragma unroll
                for (int w2 = 0; w2 < 8; ++w2) a += R[(w2 * 64 + wave * 8 + k) * 64 + lane];
                acc8[k] = a; }
            __syncthreads();
            LAS float* Of = (LAS float*)lds; LAS float* Lq = Of + 32 * 128;
            if (wave == 0 && hi == 0) Lq[r32] = lt;
            __syncthreads();
#pragma unroll
            for (int k = 0; k < 8; ++k) { const int r = 8 * (wave & 1) + k, q = fox::crow(r, hi); Of[q * 128 + (wave >> 1) * 32 + r32] = acc8[k] * __builtin_amdgcn_rcpf(Lq[q]); }
            __syncthreads();
            { const int q = wave * 4 + (lane >> 4), c8 = (lane & 15) * 8; const f32x4 a0 = *(const LAS f32x4*)(Of + q * 128 + c8), a1 = *(const LAS f32x4*)(Of + q * 128 + c8 + 4);
              float sq = (a0[0] * a0[0] + a0[1] * a0[1]) + (a0[2] * a0[2] + a0[3] * a0[3]) + (a1[0] * a1[0] + a1[1] * a1[1]) + (a1[2] * a1[2] + a1[3] * a1[3]);
              sq += lane_xor<1>(sq); sq += lane_xor<2>(sq); sq += lane_xor<4>(sq); sq += lane_xor<8>(sq);
              const size_t tok = (size_t)MP + n * 32 + q;
              *(bf16x8*)(MIX + tok * DM + 1024 + h * HD + c8) = pack8(a0, a1);
              if ((lane & 15) == 0) SSQ2[tok * 8 + h] = sq; }
            }
            __syncthreads();
        }
        } else {
        for (int rep_ = 0; rep_ < REPS(1024); ++rep_) for (int Lw = bx; Lw < 256; Lw += G) {
            int iw_ = Lw >> 3; iw_ = (iw_ == 1) ? 16 : (iw_ == 16) ? 1 : iw_;
            const int L = (Lw & 7) * 32 + iw_; const int bh = L >> 4, x = L & 15, qb_ = role_ == 1 ? x : 31 - x;
            const fox::Ctx FC{fox::mksrd(ws, (unsigned)WS_TOTAL), ws};
            fox::Seam Sm;
            const int lane_p = opaque_tid(wave) & 63; const int jl_ = fox::tile_lo(FC, bh, qb_, lane_p);
            fox::prime(FC, bh, qb_, jl_, (LAS char*)lds, Sm, wave);
            fox::block(FC, bh, qb_, jl_, qb_, jl_, (LAS char*)lds, Sm, wave);
            fox::finish(Sm);
        }
        }
        }
    }
    GRID_SYNC();

    for (int rep_ = 0; rep_ < REPS(16); ++rep_) { if (rep_) GRID_SYNC();
        PHASE_PTRS
        const int tid = opaque_tid(wave), lane = tid & 63;
        const bool tailfill = (G == 256);
        unsigned* cntS = (unsigned*)(ws + 32768 + 512);
        LAS float* RT = (LAS float*)(lds + AUX_OFF);
#define P4_RT(i_, pm_) do { if (tid < 256) { const int row = (pm_) * 256 + tid; float a = 0.f, c = 0.f; \
              _Pragma("unroll") for (int k = 0; k < 16; ++k) a += SSQ1[(size_t)row * 16 + k]; \
              _Pragma("unroll") for (int k = 0; k < 8; ++k) c += SSQ2[(size_t)row * 8 + k]; \
              const float rA = 1.0f / sqrtf(a * (1.0f / 1024.f) + EPS), rB = 1.0f / sqrtf(c * (1.0f / 1024.f) + EPS); \
              RT[((i_) * 256 + tid) * 2] = rA / rB; RT[((i_) * 256 + tid) * 2 + 1] = rB; } } while (0)
        const pg8::Gemm g{MIX, Wout_t, MT, DM, DM, DM};
        if (tailfill) {
            const pg8::OneUnit S1{64 + (bx >> 3), bx & 7, bx < 32};
            if (bx < 32) { P4_RT(0, S1.pm); }
            __syncthreads();
            { EpiOut E{XB, out, X1B, SSQ3, RT}; pg8::gemm_phase<EpiOut, pg8::OneUnit>(lds, g, S1, E, wave); }
            if (bx < 32) slab_done(cntS);
            __syncthreads();
        }
        { pg8::StaticOrder S; S.init(tailfill ? MP : MT, DM, G, bx);
          { pg8::Unit u; for (int i = 0; S.next(i, u); ++i) P4_RT(i, u.pm); }
          __syncthreads();
          EpiOut E{XB, out, X1B, SSQ3, RT};
          pg8::gemm_phase<EpiOut, pg8::StaticOrder>(lds, g, S, E, wave); }
#undef P4_RT
        if (tailfill && bx >= 32 && bx < 160) {
            slab_wait(cntS, 32u);
            const int j = bx - 32; const pg8::OneUnit S2{64 + (j >> 5), j & 31, true};
            LAS float* RT2 = (LAS float*)(lds + AUX_OFF);
            if (tid < 256) { const int row = S2.pm * 256 + tid; float a = 0.f;
#pragma unroll
                for (int k = 0; k < 32; ++k) a += SSQ3[(size_t)row * 32 + k];
                RT2[tid] = 1.0f / sqrtf(a * (1.0f / DM) + EPS); }
            __syncthreads();
            const pg8::Gemm g2{X1B, Wup_t, MT, DFF, DM, DM}; EpiUp E2{Hb, RT2};
            pg8::gemm_phase<EpiUp, pg8::OneUnit>(lds, g2, S2, E2, wave);
        }
        { const int fi = tailfill ? bx - 160 : bx, nfree = tailfill ? 96 : G;
          if (fi >= 0) { const int lane2 = opaque_tid(wave) & 63; LAS float* scr = (LAS float*)(lds + wave * 16384);
              for (int it = fi * 8 + wave; it < 128 * 64; it += nfree * 8) p0_transpose_item(IN(26), DM, DFF, 64, nullptr, nullptr, Wdn_t, scr, it, lane2); } }
    }
    GRID_SYNC();

    for (int rep_ = 0; rep_ < REPS(32); ++rep_) { if (rep_) GRID_SYNC();
        PHASE_PTRS
        const int tid = opaque_tid(wave), lane = tid & 63;
        pg8::StaticOrder S; S.init(G == 256 ? MP : MT, DFF, G, bx);
        LAS float* RT = (LAS float*)(lds + AUX_OFF);
        if (G == 256) {
            const int rowl = tid & 255, hf = wave >> 2; pg8::Unit u; f32x4 sv[4][8];
#pragma unroll
            for (int j = 0; j < 4; ++j) { S.next(2 * j + hf, u); const float* p = SSQ3 + (size_t)(u.pm * 256 + rowl) * 32;
#pragma unroll
                for (int q = 0; q < 8; ++q) sv[j][q] = *(const f32x4*)(p + 4 * q); }
#pragma unroll
            for (int j = 0; j < 4; ++j) asm volatile("" : "+v"(sv[j][0]), "+v"(sv[j][1]), "+v"(sv[j][2]), "+v"(sv[j][3]), "+v"(sv[j][4]), "+v"(sv[j][5]), "+v"(sv[j][6]), "+v"(sv[j][7]));
#pragma unroll
            for (int j = 0; j < 4; ++j) { f32x4 t = sv[j][0];
#pragma unroll
                for (int q = 1; q < 8; ++q) t += sv[j][q];
                RT[(2 * j + hf) * 256 + rowl] = 1.0f / sqrtf(((t[0] + t[1]) + (t[2] + t[3])) * (1.0f / DM) + EPS); }
        } else { pg8::Unit u;
          for (int i = 0; S.next(i, u); ++i) if (tid < 256) { const int row = u.pm * 256 + tid; float a = 0.f;
#pragma unroll
              for (int k = 0; k < 32; ++k) a += SSQ3[(size_t)row * 32 + k];
              RT[i * 256 + tid] = 1.0f / sqrtf(a * (1.0f / DM) + EPS); } }
        __syncthreads();
        pg8::Gemm g{X1B, Wup_t, MT, DFF, DM, DM};
        EpiUp E{Hb, RT};
        pg8::gemm_phase<EpiUp, pg8::StaticOrder>(lds, g, S, E, wave);
    }
    GRID_SYNC();

    if (PHMASK & 64) {
        PHASE_PTRS
        float* SL = (float*)(ws + WS_QKRAW); unsigned* slab_cnt = (unsigned*)(ws + 32768);
        const bool split = (G == 256);
        if (split) { pg8::Gemm g{Hb, Wdn_t, MT, DM, DFF / 8, DFF}; pg8::SplitOrder S{bx, DFF / 8}; EpiDownSlab E{SL, DFF / 8};
            pg8::gemm_phase<EpiDownSlab, pg8::SplitOrder>(lds, g, S, E, wave);
            if (threadIdx.x == 0) { __builtin_amdgcn_fence(__ATOMIC_RELEASE, "agent"); asm volatile("s_waitcnt vmcnt(0)" ::: "memory");
                __hip_atomic_fetch_add(slab_cnt, 1u, __ATOMIC_RELAXED, __HIP_MEMORY_SCOPE_AGENT); } }
        { pg8::Gemm g{Hb, Wdn_t, MT, DM, DFF, DFF}; pg8::StaticOrder S; S.init(split ? MP : MT, DM, G, bx);
          EpiDown E{out, X1B};
          pg8::gemm_phase<EpiDown, pg8::StaticOrder>(lds, g, S, E, wave); }
        if (split) {
            if (threadIdx.x == 0) { unsigned sp = 0; while (__hip_atomic_load(slab_cnt, __ATOMIC_RELAXED, __HIP_MEMORY_SCOPE_AGENT) < 256u) { __builtin_amdgcn_s_sleep(2); if (++sp > (1u << 22)) break; }
                __builtin_amdgcn_fence(__ATOMIC_ACQUIRE, "agent"); asm volatile("s_waitcnt vmcnt(0)" ::: "memory"); }
            __syncthreads();
            const int tid = opaque_tid(wave); const int r = 4 * bx + (tid >> 7);
            u32x2 xw[4]; f32x4 sv[4][8];
#pragma unroll
            for (int j = 0; j < 4; ++j) { const int c = (tid & 127) * 4 + 512 * j; xw[j] = *(const u32x2*)(X1B + (size_t)(MP + r) * DM + c);
#pragma unroll
                for (int s = 0; s < 8; ++s) sv[j][s] = *(const f32x4*)(SL + (size_t)s * (MS * DM) + (size_t)r * DM + c); }
#pragma unroll
            for (int j = 0; j < 4; ++j)
                asm volatile("" : "+v"(xw[j]), "+v"(sv[j][0]), "+v"(sv[j][1]), "+v"(sv[j][2]), "+v"(sv[j][3]), "+v"(sv[j][4]), "+v"(sv[j][5]), "+v"(sv[j][6]), "+v"(sv[j][7]));
#pragma unroll
            for (int j = 0; j < 4; ++j) { const int c = (tid & 127) * 4 + 512 * j; float* yp = out + O_Y + (size_t)(MP + r) * DM + c;
                f32x4 y; y[0] = __builtin_bit_cast(float, xw[j].x << 16); y[1] = __builtin_bit_cast(float, xw[j].x & 0xffff0000u); y[2] = __builtin_bit_cast(float, xw[j].y << 16); y[3] = __builtin_bit_cast(float, xw[j].y & 0xffff0000u);
#pragma unroll
                for (int s = 0; s < 8; ++s) y += sv[j][s];
                *(f32x4*)yp = y; }
        }
    }
}

extern "C" void kernel_launch(void* const* d_in, const int* in_sizes, int n_in, void* d_out, int out_size, void* d_ws, size_t ws_size, hipStream_t stream) {
    static int grid = 0;
    if (grid == 0) {
        if (n_in != 27 || ws_size < WS_TOTAL) { fprintf(stderr, "kernel_launch: unexpected n_in %d / ws_size %zu (need %zu)\n", n_in, ws_size, (size_t)WS_TOTAL); grid = -1; return; }
        int dev = 0, cus = 0, per_cu = 0;
        hipGetDevice(&dev);
        hipDeviceGetAttribute(&cus, hipDeviceAttributeMultiprocessorCount, dev);
        hipFuncSetAttribute((const void*)hymba_fwd, hipFuncAttributeMaxDynamicSharedMemorySize, LDS_BYTES);
        hipOccupancyMaxActiveBlocksPerMultiprocessor(&per_cu, (const void*)hymba_fwd, 512, LDS_BYTES);
        if (per_cu < 1) { fprintf(stderr, "kernel_launch: occupancy query says %d blocks per CU\n", per_cu); per_cu = 1; }
        if (per_cu > 1) per_cu = 1;
        grid = cus * per_cu;
        if (grid != 256) { fprintf(stderr, "kernel_launch: this kernel's work decomposition is written for 256 workgroups (one per CU of a 256-CU device); got %d; nothing launched\n", grid); grid = -1; return; }
        fprintf(stderr, "kernel_launch: grid %d (cus %d), ws %zu\n", grid, cus, ws_size);
    }
    if (grid < 0) return;
    if (hipMemsetAsync(d_ws, 0, 65536, stream) != hipSuccess) { fprintf(stderr, "kernel_launch: hipMemsetAsync failed\n"); return; }
    Args a{};
    for (int i = 0; i < 27; ++i) a.in[i] = (const float*)d_in[i];
    a.out = (float*)d_out; a.ws = (unsigned char*)d_ws;
    void* kargs[] = {&a};
    hipError_t e = hipLaunchCooperativeKernel((const void*)hymba_fwd, dim3(grid), dim3(512), kargs, LDS_BYTES, stream);
    if (e != hipSuccess) fprintf(stderr, "kernel_launch: cooperative launch failed: %s (grid %d)\n", hipGetErrorString(e), grid);
}
```

```cpp
#include <hip/hip_runtime.h>
#include <hip/hip_cooperative_groups.h>
#include <cstdio>
#include <cstdint>
namespace cg = cooperative_groups;
#ifndef PHMASK
#define PHMASK 2047
#endif
#ifndef DBL
#define DBL 0
#endif
#define REPS(bit) (((DBL) & (bit)) ? 2 : 1)

#define LAS __attribute__((address_space(3)))
typedef unsigned short bf16;
typedef short bf16x8 __attribute__((ext_vector_type(8)));
typedef short s16x4 __attribute__((ext_vector_type(4)));
typedef float f32x4 __attribute__((ext_vector_type(4)));
typedef float f32x16 __attribute__((ext_vector_type(16)));
typedef unsigned u32x4 __attribute__((ext_vector_type(4)));
typedef unsigned u32x2 __attribute__((ext_vector_type(2)));

constexpr int DM = 2048, MP = 16384, MS = 1024, MT = MP + MS, SEQ = 8192, NH = 8, HD = 128, DSSM = 1024, DATT = 1024, DFF = 8192;
constexpr int NINW = 4104, PAST = 2048, DSEQ = 32, DB = 32, NG = 64, NP = 64;
constexpr float EPS = 1e-6f;
constexpr float LOG2E = 1.4426950408889634f;
constexpr float QSCALE = 0.08838834764831845f * 1.4426950408889634f;

constexpr size_t O_Y = 0, O_KP = 35651584, O_VP = 52428800, O_LFP = 69206016, O_HRP = 69337088, O_HIP = 69345280,
                 O_KS = 69353472, O_VS = 70402048, O_LFS = 71450624, O_HRS = 71458816, O_HIS = 71589888;

constexpr size_t MiB = 1u << 20;
constexpr size_t WS_WIN = 1 * MiB;
constexpr size_t WS_WGLU = 17 * MiB;
constexpr size_t WS_WOUT = 19 * MiB;
constexpr size_t WS_WUP = 27 * MiB;
constexpr size_t WS_WDN = 59 * MiB;
constexpr size_t WS_SMALL = 91 * MiB;
constexpr size_t WS_XB = 96 * MiB;
constexpr size_t WS_U = 164 * MiB;
constexpr size_t WS_QKRAW = 198 * MiB;
constexpr size_t WS_QH = 334 * MiB;
constexpr size_t WS_KH = 368 * MiB;
constexpr size_t WS_VH = 402 * MiB;
constexpr size_t WS_GY = 436 * MiB;
constexpr size_t WS_MIX = 470 * MiB;
constexpr size_t WS_X1B = 538 * MiB;
constexpr size_t WS_H = 606 * MiB;
constexpr size_t WS_END = 878 * MiB;
constexpr size_t SM_RS1 = 0;
constexpr size_t SM_ABAR = 128 * 1024;
constexpr size_t SM_APOW = 192 * 1024;
constexpr size_t SM_CLF = 4 * MiB;
constexpr size_t SM_S5EX = 3 * MiB;
constexpr size_t SM_BMT = 256 * 1024;
constexpr size_t SM_CMT = 512 * 1024;
constexpr size_t SM_SSQ1 = 1 * MiB;
constexpr size_t SM_SSQ2 = 2 * MiB + 256 * 1024;
constexpr size_t SM_SSQ3 = 3 * MiB;
constexpr size_t WS_CLK = 878 * MiB;
constexpr size_t WS_CLQ = 882 * MiB;
constexpr size_t WS_SSQ3 = 886 * MiB;
constexpr size_t WS_TOTAL = 890 * MiB;

constexpr int RING_BYTES = 131072, AUX_OFF = 131072, AUX_BYTES = 32768, LDS_BYTES = 163840;

__device__ __forceinline__ int opaque_tid(int wave) { int t = (wave << 6) | (int)__builtin_amdgcn_mbcnt_hi(~0u, __builtin_amdgcn_mbcnt_lo(~0u, 0u)); asm volatile("" : "+v"(t)); return t; }
__device__ __forceinline__ unsigned f2bf(float f) { unsigned u = __builtin_bit_cast(unsigned, f); return (u + 0x7fffu + ((u >> 16) & 1u)) >> 16; }
__device__ __forceinline__ float bf2f(unsigned short b) { return __builtin_bit_cast(float, (unsigned)b << 16); }
__device__ __forceinline__ unsigned pk2(float lo, float hi) { return f2bf(lo) | (f2bf(hi) << 16); }
__device__ __forceinline__ unsigned cvtpk(float lo, float hi) { unsigned r; asm volatile("v_cvt_pk_bf16_f32 %0, %1, %2" : "=v"(r) : "v"(lo), "v"(hi)); return r; }
__device__ __forceinline__ unsigned cvtpk_nv(float lo, float hi) { unsigned r; asm("v_cvt_pk_bf16_f32 %0, %1, %2" : "=v"(r) : "v"(lo), "v"(hi)); return r; }
__device__ __forceinline__ bf16x8 pack8(f32x4 a, f32x4 b) { u32x4 w = {cvtpk(a[0], a[1]), cvtpk(a[2], a[3]), cvtpk(b[0], b[1]), cvtpk(b[2], b[3])}; return __builtin_bit_cast(bf16x8, w); }
__device__ __forceinline__ void st16_wt(void* p, u32x4 v) { asm volatile("global_store_dwordx4 %0, %1, off sc1\n\ts_nop 1" :: "v"(p), "v"(v) : "memory"); }
template <int K> __device__ __forceinline__ float lane_xor(float v) {
    return __builtin_bit_cast(float, __builtin_amdgcn_ds_swizzle(__builtin_bit_cast(int, v), (K << 10) | 0x1f));
}
__device__ __forceinline__ float half_swap_add(float v) { auto rr = __builtin_amdgcn_permlane32_swap(__float_as_uint(v), __float_as_uint(v), false, false); return __uint_as_float(rr[0]) + __uint_as_float(rr[1]); }
__device__ __forceinline__ float half_swap_max(float v) { auto rr = __builtin_amdgcn_permlane32_swap(__float_as_uint(v), __float_as_uint(v), false, false); return fmaxf(__uint_as_float(rr[0]), __uint_as_float(rr[1])); }
__device__ __forceinline__ float sum32(float v) { v += lane_xor<1>(v); v += lane_xor<2>(v); v += lane_xor<4>(v); v += lane_xor<8>(v); v += lane_xor<16>(v); return v; }
__device__ __forceinline__ float max32(float v) { v = fmaxf(v, lane_xor<1>(v)); v = fmaxf(v, lane_xor<2>(v)); v = fmaxf(v, lane_xor<4>(v)); v = fmaxf(v, lane_xor<8>(v)); v = fmaxf(v, lane_xor<16>(v)); return v; }
__device__ __forceinline__ float wave_sum(float v) { return half_swap_add(sum32(v)); }
__device__ __forceinline__ float wave_max(float v) { return half_swap_max(max32(v)); }
__device__ __forceinline__ int wave_min_i(int v) {
#define SWZI(K) v = min(v, __builtin_amdgcn_ds_swizzle(v, ((K) << 10) | 0x1f))
    SWZI(1); SWZI(2); SWZI(4); SWZI(8); SWZI(16);
#undef SWZI
    auto rr = __builtin_amdgcn_permlane32_swap((unsigned)v, (unsigned)v, false, false); return min((int)rr[0], (int)rr[1]);
}
__device__ __forceinline__ float wave_incl_scan(float v) {
#define DPPADD(ctrl, rmask) v += __builtin_bit_cast(float, __builtin_amdgcn_update_dpp(0, __builtin_bit_cast(int, v), ctrl, rmask, 0xf, false))
    DPPADD(0x111, 0xf); DPPADD(0x112, 0xf); DPPADD(0x114, 0xf); DPPADD(0x118, 0xf); DPPADD(0x142, 0xa); DPPADD(0x143, 0xc);
#undef DPPADD
    return v;
}
__device__ __forceinline__ float gelu_tanh(float y) {
    const float t = 0.7978845608028654f * (y + 0.044715f * y * y * y);
    const float e = __builtin_amdgcn_exp2f(-2.0f * LOG2E * fabsf(t));
    float th = (1.0f - e) * __builtin_amdgcn_rcpf(1.0f + e); th = t < 0.f ? -th : th;
    return 0.5f * y * (1.0f + th);
}
__device__ __forceinline__ float sigmoidf_(float x) { return __builtin_amdgcn_rcpf(1.0f + __builtin_amdgcn_exp2f(-LOG2E * x)); }
__device__ __forceinline__ float log_sigmoidf_(float z) { return fminf(z, 0.f) - log1pf(expf(-fabsf(z))); }

namespace pg8 {
#define PG8_LAS __attribute__((address_space(3)))
typedef unsigned short bf16_t;
constexpr int BM = 256, BK = 64, HALF = 128, HTB = HALF * BK * 2, STAGE_BYTES = 8 * HTB, NXCD = 8, WGM = 4;
__host__ __device__ __forceinline__ int lds_byte(int r, int c) { const int st = (r >> 4) * 2 + (c >> 5), rr = r & 15, cc = c & 31, ob = rr * 64 + cc * 2; return st * 1024 + (ob ^ (((ob >> 9) & 1) << 5)); }
__host__ __device__ __forceinline__ void stage_rc(int b, int& R, int& C) { const int st = b / 1024, sb = b % 1024, swz = sb ^ (((sb >> 9) & 1) << 5); R = (st >> 1) * 16 + swz / 64; C = (st & 1) * 32 + (swz % 64) / 2; }
__host__ __device__ __forceinline__ int perm32(int rho) { const int n = rho >> 4, i = rho & 15; return 8 * (i >> 2) + 4 * n + (i & 3); }
struct Unit { int pm, pn, ko; };
struct Gemm { const bf16_t* A; const bf16_t* Bt; int M, N, K, ld; };
struct StaticOrder {
    int nM, nN, nwg, G, c;
    __host__ __device__ __forceinline__ void init(int M, int N, int G_, int c_) { nM = M / BM; nN = N / BM; nwg = nM * nN; G = G_; c = c_; }
    __host__ __device__ __forceinline__ bool next(int i, Unit& u) const {
        const long L = (long)i * G + c; if (L >= nwg) return false;
        int wgid = (int)L; { const int q = nwg / NXCD, r = nwg % NXCD, xcd = wgid % NXCD, off = wgid / NXCD; wgid = (xcd < r ? xcd * (q + 1) : r * (q + 1) + (xcd - r) * q) + off; }
        const int nig = WGM * nN, gid = wgid / nig, fm = gid * WGM, gsz = (nM - fm) < WGM ? (nM - fm) : WGM;
        u.pm = fm + ((wgid % nig) % gsz); u.pn = (wgid % nig) / gsz; u.ko = 0; return true;
    }
};
struct SplitOrder {
    int c, kslice;
    __host__ __device__ __forceinline__ bool next(int i, Unit& u) const { if (i > 0 || c >= 256) return false; u.pm = 64 + (c >> 6); u.pn = (c >> 3) & 7; u.ko = (c & 7) * kslice; return true; }
};
struct OneUnit {
    int pm, pn; bool on;
    __host__ __device__ __forceinline__ bool next(int i, Unit& u) const { if (i > 0 || !on) return false; u.pm = pm; u.pn = pn; u.ko = 0; return true; }
};
template <class Epi, class Sched, bool ALIGN_EPI = true, bool SP2 = true>
__device__ __forceinline__ void gemm_phase(PG8_LAS unsigned char* lds, const Gemm g, const Sched& S, const Epi& E, const int wave) {
    const int tid = opaque_tid(wave), wid = wave, lane = tid & 63, wr = wid >> 2, wc = wid & 3, fr = lane & 15, fq = lane >> 4;
    const int K = g.K, nt = K / BK;
    unsigned voffA[2], voffB[2];
#pragma unroll
    for (int i = 0; i < 2; ++i) { int R, C; stage_rc(tid * 16 + i * 8192, R, C); const int Rb = Epi::PERM ? ((R & ~31) + perm32(R & 31)) : R;
        voffA[i] = (unsigned)(R * g.ld + C) * 2u; voffB[i] = (unsigned)(Rb * g.ld + C) * 2u; }
    const size_t kstep = (size_t)(BK * 2);
    const size_t hstep = (size_t)HALF * g.ld * 2;
    const size_t tstep = 2 * hstep;
    const unsigned ldsw = (unsigned)wid * 1024u;
    const int aoff = lds_byte(wr * 64 + fr, fq * 8), boff = lds_byte(wc * 32 + fr, fq * 8);
#define PG8_SA(b, h) (((b) * 2 + (h)) * HTB)
#define PG8_SB(b, h) ((4 + (b) * 2 + (h)) * HTB)
#define PG8_STAGE(bufoff, gbase, voff) do { _Pragma("unroll") for (int _i = 0; _i < 2; ++_i) \
        __builtin_amdgcn_global_load_lds((const unsigned*)((const char*)(gbase) + (voff)[_i]), (PG8_LAS unsigned*)(lds + (bufoff) + ldsw + _i * 8192), 16, 0, 0); } while (0)
#define PG8_LDA(dst, b, h) do { _Pragma("unroll") for (int m = 0; m < 4; ++m) _Pragma("unroll") for (int k = 0; k < 2; ++k) dst[m][k] = *(const PG8_LAS bf16x8*)(lds + PG8_SA(b, h) + aoff + m * 2048 + k * 1024); } while (0)
#define PG8_LDB(dst, b, h) do { _Pragma("unroll") for (int n = 0; n < 2; ++n) _Pragma("unroll") for (int k = 0; k < 2; ++k) dst[n][k] = *(const PG8_LAS bf16x8*)(lds + PG8_SB(b, h) + boff + n * 2048 + k * 1024); } while (0)
#define PG8_MMA(ai, bj, At, Bt) do { __builtin_amdgcn_s_setprio(1); _Pragma("unroll") for (int m = 0; m < 4; ++m) _Pragma("unroll") for (int n = 0; n < 2; ++n) _Pragma("unroll") for (int k = 0; k < 2; ++k) \
        acc[ai][bj][m][n] = __builtin_amdgcn_mfma_f32_16x16x32_bf16(Bt[n][k], At[m][k], acc[ai][bj][m][n], 0, 0, 0); __builtin_amdgcn_s_setprio(0); } while (0)
#define PG8_WAIT_V(n) asm volatile("s_waitcnt vmcnt(" #n ")" ::: "memory")
#define PG8_WAIT_L(n) asm volatile("s_waitcnt lgkmcnt(" #n ")" ::: "memory")
#define PG8_BAR __builtin_amdgcn_s_barrier()
#define PG8_SCHED __builtin_amdgcn_sched_barrier(0)
    Unit cur, nxt; int ui = 0;
    if (!S.next(0, cur)) return;
    f32x4 acc[2][2][4][2];
#pragma unroll
    for (int a = 0; a < 2; ++a)
#pragma unroll
        for (int b = 0; b < 2; ++b)
#pragma unroll
            for (int m = 0; m < 4; ++m)
#pragma unroll
                for (int n = 0; n < 2; ++n) acc[a][b][m][n] = (f32x4){0.f, 0.f, 0.f, 0.f};
    bf16x8 At[4][2], B0[2][2], B1[2][2];
    const char* cA = (const char*)g.A + (size_t)cur.pm * tstep + (size_t)cur.ko * 2; const char* cB = (const char*)g.Bt + (size_t)cur.pn * tstep + (size_t)cur.ko * 2;
    {
        PG8_STAGE(PG8_SB(0, 0), cB, voffB); PG8_STAGE(PG8_SB(0, 1), cB + hstep, voffB); PG8_STAGE(PG8_SA(0, 0), cA, voffA); PG8_STAGE(PG8_SA(0, 1), cA + hstep, voffA);
        if (wr == 1) PG8_BAR;
        PG8_WAIT_V(2); PG8_BAR;
        PG8_STAGE(PG8_SB(1, 0), cB + kstep, voffB); PG8_STAGE(PG8_SA(1, 0), cA + kstep, voffA); PG8_STAGE(PG8_SB(1, 1), cB + hstep + kstep, voffB);
        PG8_WAIT_V(6); PG8_BAR;
    }
    for (;;) {
        const bool has_next = S.next(ui + 1, nxt);
        const char* nA = has_next ? (const char*)g.A + (size_t)nxt.pm * tstep + (size_t)nxt.ko * 2 : cA; const char* nB = has_next ? (const char*)g.Bt + (size_t)nxt.pn * tstep + (size_t)nxt.ko * 2 : cB;
        for (int t = 0; t < nt; t += 2) {
            const bool last = (t == nt - 2);
            const char* a1 = cA + (size_t)(t + 1) * kstep;
            const char* a2 = last ? nA : cA + (size_t)(t + 2) * kstep; const char* b2 = last ? nB : cB + (size_t)(t + 2) * kstep;
            const char* a3 = a2 + kstep; const char* b3 = b2 + kstep;
            if constexpr (Epi::HAS_MID) { if (t == (nt >> 1)) E.mid(acc, ui, wr, fr); }
            PG8_LDB(B0, 0, 0); PG8_LDB(B1, 0, 1); PG8_SCHED; PG8_LDA(At, 0, 0); PG8_STAGE(PG8_SA(1, 1), a1 + hstep, voffA);
            PG8_WAIT_V(8); PG8_WAIT_L(0); PG8_BAR; PG8_MMA(0, 0, At, B0); PG8_MMA(0, 1, At, B1); PG8_BAR; PG8_SCHED;
            PG8_LDA(At, 0, 1); PG8_STAGE(PG8_SB(0, 0), b2, voffB); PG8_STAGE(PG8_SB(0, 1), b2 + hstep, voffB); PG8_STAGE(PG8_SA(0, 0), a2, voffA);
            PG8_WAIT_V(8); PG8_WAIT_L(0); PG8_BAR; PG8_MMA(1, 0, At, B0); PG8_MMA(1, 1, At, B1); PG8_BAR; PG8_SCHED;
            PG8_LDB(B0, 1, 0); PG8_LDB(B1, 1, 1); PG8_SCHED; PG8_LDA(At, 1, 0); PG8_STAGE(PG8_SA(0, 1), a2 + hstep, voffA);
            PG8_WAIT_V(8); PG8_WAIT_L(0); PG8_BAR; PG8_MMA(0, 0, At, B0); PG8_MMA(0, 1, At, B1); PG8_BAR; PG8_SCHED;
            PG8_LDA(At, 1, 1); PG8_STAGE(PG8_SB(1, 0), b3, voffB); PG8_STAGE(PG8_SB(1, 1), b3 + hstep, voffB); PG8_STAGE(PG8_SA(1, 0), a3, voffA);
            PG8_WAIT_V(8); PG8_WAIT_L(0); PG8_BAR; PG8_MMA(1, 0, At, B0); PG8_MMA(1, 1, At, B1); PG8_BAR; PG8_SCHED;
        }
        if constexpr (ALIGN_EPI) { if (wr == 0) PG8_BAR; }
        E(acc, cur, ui, wr, wc, fr, fq);
        if (!has_next) break;
#pragma unroll
        for (int a = 0; a < 2; ++a)
#pragma unroll
            for (int b = 0; b < 2; ++b)
#pragma unroll
                for (int m = 0; m < 4; ++m)
#pragma unroll
                    for (int n = 0; n < 2; ++n) acc[a][b][m][n] = (f32x4){0.f, 0.f, 0.f, 0.f};
        cur = nxt; cA = nA; cB = nB; ++ui;
        if constexpr (ALIGN_EPI) { if (wr == 1) PG8_BAR; }
    }
    PG8_WAIT_V(0);
    if constexpr (!ALIGN_EPI) { if (wr == 0) PG8_BAR; }
    PG8_BAR;
#undef PG8_SA
#undef PG8_SB
#undef PG8_STAGE
#undef PG8_LDA
#undef PG8_LDB
#undef PG8_MMA
#undef PG8_WAIT_V
#undef PG8_WAIT_L
#undef PG8_BAR
#undef PG8_SCHED
}
}

struct Args {
    const float* in[27];
    float* out;
    unsigned char* ws;
};

__device__ __forceinline__ size_t headmajor_off_u(bool smp, int m, int h) {
    if (!smp) { const int b = m >> 13, t = m & 8191; return ((size_t)(b * NH + h) * SEQ + t) * HD; }
    const int ms = m - MP, n = ms >> 5, i = ms & 31; return (size_t)2 * NH * SEQ * HD + ((size_t)(n * NH + h) * DSEQ + i) * HD;
}
__device__ __forceinline__ size_t headmajor_off(int m, int h) {
    if (m < MP) { const int b = m >> 13, t = m & 8191; return ((size_t)(b * NH + h) * SEQ + t) * HD; }
    const int ms = m - MP, n = ms >> 5, i = ms & 31; return (size_t)2 * NH * SEQ * HD + ((size_t)(n * NH + h) * DSEQ + i) * HD;
}

struct EpiIn {
    static constexpr bool PERM = true, HAS_MID = false;
    const float* rs1; bf16* U; float* out; bf16* Qh; bf16* Kh; bf16* Vh; const float* gq; const float* gk; LAS float* RED;
    __device__ __forceinline__ void operator()(const f32x4 (&acc)[2][2][4][2], const pg8::Unit& u, int ui, int wr, int wc, int fr, int fq) const {
        asm volatile("" : "+v"(fr), "+v"(fq));
        const int row0 = u.pm * 256 + wr * 64 + fr, colb = u.pn * 256 + wc * 32 + 8 * fq;
        const bool smp = u.pm >= MP / 256;
        float* outv = out + (u.pm < MP / 256 ? (size_t)O_VP : (size_t)O_VS - (size_t)MP * 1024); float* outk = out + (u.pm < MP / 256 ? (size_t)O_KP : (size_t)O_KS - (size_t)MP * 1024);
        float rsv[2][4];
#pragma unroll
        for (int ai = 0; ai < 2; ++ai)
#pragma unroll
            for (int m = 0; m < 4; ++m) rsv[ai][m] = rs1[row0 + ai * 128 + m * 16];
        asm volatile("" : "+v"(rsv[0][0]), "+v"(rsv[0][1]), "+v"(rsv[0][2]), "+v"(rsv[0][3]), "+v"(rsv[1][0]), "+v"(rsv[1][1]), "+v"(rsv[1][2]), "+v"(rsv[1][3]));
        if (u.pn < 4 || u.pn >= 12) {
#pragma unroll
            for (int ai = 0; ai < 2; ++ai)
#pragma unroll
                for (int m = 0; m < 4; ++m) {
                    const int row = row0 + ai * 128 + m * 16; const float rs = rsv[ai][m];
#pragma unroll
                    for (int bj = 0; bj < 2; ++bj) {
                        const int col = colb + bj * 128; const f32x4 v0 = acc[ai][bj][m][0] * rs, v1 = acc[ai][bj][m][1] * rs;
                        if (u.pn < 4) { *(bf16x8*)(U + (size_t)row * DSSM + col) = pack8(v0, v1); }
                        else { const int c = col - 3072, h = c >> 7, d = c & 127;
                            float* p = outv + (size_t)row * 1024 + c; *(f32x4*)p = v0; *(f32x4*)(p + 4) = v1;
                            *(bf16x8*)(Vh + headmajor_off_u(smp, row, h) + d) = pack8(v0, v1); }
                    }
                }
        } else {
#pragma unroll
            for (int ai = 0; ai < 2; ++ai)
#pragma unroll
                for (int m = 0; m < 4; ++m)
#pragma unroll
                    for (int bj = 0; bj < 2; ++bj) { const f32x4 a = acc[ai][bj][m][0], b = acc[ai][bj][m][1];
                        float s = (a[0] * a[0] + a[1] * a[1]) + (a[2] * a[2] + a[3] * a[3]) + (b[0] * b[0] + b[1] * b[1]) + (b[2] * b[2] + b[3] * b[3]);
                        s += lane_xor<16>(s); s = half_swap_add(s);
                        if (fq == 0) RED[((ai * 128 + wr * 64 + m * 16 + fr) * 2 + bj) * 4 + wc] = s; }
            asm volatile("s_waitcnt lgkmcnt(0)" ::: "memory"); __builtin_amdgcn_s_barrier(); asm volatile("" ::: "memory");
            const bool isq = u.pn < 8; const float* g = isq ? gq : gk; const int hb = ((u.pn - (isq ? 4 : 8)) * 2);
            const f32x4 g0 = *(const f32x4*)(g + wc * 32 + 8 * fq), g1 = *(const f32x4*)(g + wc * 32 + 8 * fq + 4);
#pragma unroll
            for (int ai = 0; ai < 2; ++ai)
#pragma unroll
                for (int m = 0; m < 4; ++m) {
                    const int rl = ai * 128 + wr * 64 + m * 16 + fr, row = u.pm * 256 + rl; const float rs = rsv[ai][m];
#pragma unroll
                    for (int bj = 0; bj < 2; ++bj) {
                        const f32x4 t = *(const LAS f32x4*)(RED + (rl * 2 + bj) * 4); const float tot = ((t[0] + t[1]) + (t[2] + t[3])) * rs * rs;
                        const float rn = rs * __builtin_amdgcn_rsqf(tot * (1.0f / HD) + EPS);
                        const int h = hb + bj, d = wc * 32 + 8 * fq;
                        f32x4 v0 = acc[ai][bj][m][0] * rn * g0, v1 = acc[ai][bj][m][1] * rn * g1;
                        if (isq) { v0 = v0 * QSCALE; v1 = v1 * QSCALE; *(bf16x8*)(Qh + headmajor_off_u(smp, row, h) + d) = pack8(v0, v1); }
                        else { float* p = outk + (size_t)row * 1024 + h * HD + d; *(f32x4*)p = v0; *(f32x4*)(p + 4) = v1;
                            *(bf16x8*)(Kh + headmajor_off_u(smp, row, h) + d) = pack8(v0, v1); }
                    }
                }
        }
    }
};
struct EpiGlu {
    static constexpr bool PERM = true, HAS_MID = false;
    const bf16* GY; bf16* MIX; float* SSQ1;
    __device__ __forceinline__ void operator()(const f32x4 (&acc)[2][2][4][2], const pg8::Unit& u, int ui, int wr, int wc, int fr, int fq) const {
        asm volatile("" : "+v"(fr), "+v"(fq));
        const int row0 = u.pm * 256 + wr * 64 + fr, colb = u.pn * 256 + wc * 32 + 8 * fq;
        bf16x8 gvv[2][4][2];
#pragma unroll
        for (int ai = 0; ai < 2; ++ai)
#pragma unroll
            for (int m = 0; m < 4; ++m)
#pragma unroll
                for (int bj = 0; bj < 2; ++bj) gvv[ai][m][bj] = *(const bf16x8*)(GY + (size_t)(row0 + ai * 128 + m * 16) * DSSM + colb + bj * 128);
        asm volatile("" : "+v"(gvv[0][0][0]), "+v"(gvv[0][0][1]), "+v"(gvv[0][1][0]), "+v"(gvv[0][1][1]), "+v"(gvv[0][2][0]), "+v"(gvv[0][2][1]), "+v"(gvv[0][3][0]), "+v"(gvv[0][3][1]),
                          "+v"(gvv[1][0][0]), "+v"(gvv[1][0][1]), "+v"(gvv[1][1][0]), "+v"(gvv[1][1][1]), "+v"(gvv[1][2][0]), "+v"(gvv[1][2][1]), "+v"(gvv[1][3][0]), "+v"(gvv[1][3][1]));
#pragma unroll
        for (int ai = 0; ai < 2; ++ai)
#pragma unroll
            for (int m = 0; m < 4; ++m) {
                const int row = row0 + ai * 128 + m * 16; float ssq = 0.f;
#pragma unroll
                for (int bj = 0; bj < 2; ++bj) {
                    const int col = colb + bj * 128; const bf16x8 gv = gvv[ai][m][bj];
                    f32x4 o0, o1;
#pragma unroll
                    for (int e = 0; e < 4; ++e) { o0[e] = bf2f((unsigned short)gv[e]) * sigmoidf_(acc[ai][bj][m][0][e]); o1[e] = bf2f((unsigned short)gv[4 + e]) * sigmoidf_(acc[ai][bj][m][1][e]);
                        ssq += o0[e] * o0[e] + o1[e] * o1[e]; }
                    *(bf16x8*)(MIX + (size_t)row * DM + col) = pack8(o0, o1);
                }
                ssq += lane_xor<16>(ssq); ssq = half_swap_add(ssq);
                if (fq == 0) SSQ1[(size_t)row * 16 + u.pn * 4 + wc] = ssq;
            }
    }
};
struct EpiOut {
    static constexpr bool PERM = true, HAS_MID = true;
    const bf16* XBr; float* out; bf16* X1B; float* SSQ3; const LAS float* RT;
    __device__ __forceinline__ void mid(f32x4 (&acc)[2][2][4][2], int ui, int wr, int fr) const {
        asm volatile("" : "+v"(fr));
#pragma unroll
        for (int ai = 0; ai < 2; ++ai)
#pragma unroll
            for (int m = 0; m < 4; ++m) { const float r = RT[(ui * 256 + ai * 128 + wr * 64 + m * 16 + fr) * 2];
#pragma unroll
                for (int bj = 0; bj < 2; ++bj)
#pragma unroll
                    for (int n = 0; n < 2; ++n) acc[ai][bj][m][n] *= r; }
    }
    __device__ __forceinline__ void operator()(const f32x4 (&acc)[2][2][4][2], const pg8::Unit& u, int ui, int wr, int wc, int fr, int fq) const {
        asm volatile("" : "+v"(fr), "+v"(fq));
        const int col0 = u.pn * 256 + wc * 32 + 8 * fq;
        u32x4 xv[2][4][2];
#pragma unroll
        for (int ai = 0; ai < 2; ++ai)
#pragma unroll
            for (int m = 0; m < 4; ++m) { const bf16* xrow = XBr + (size_t)(u.pm * 256 + ai * 128 + wr * 64 + m * 16 + fr) * DM;
#pragma unroll
                for (int bj = 0; bj < 2; ++bj) xv[ai][m][bj] = *(const u32x4*)(xrow + col0 + bj * 128); }
        asm volatile("" : "+v"(xv[0][0][0]), "+v"(xv[0][0][1]), "+v"(xv[0][1][0]), "+v"(xv[0][1][1]), "+v"(xv[0][2][0]), "+v"(xv[0][2][1]), "+v"(xv[0][3][0]), "+v"(xv[0][3][1]),
                          "+v"(xv[1][0][0]), "+v"(xv[1][0][1]), "+v"(xv[1][1][0]), "+v"(xv[1][1][1]), "+v"(xv[1][2][0]), "+v"(xv[1][2][1]), "+v"(xv[1][3][0]), "+v"(xv[1][3][1]));
#pragma unroll
        for (int ai = 0; ai < 2; ++ai) { float ssel = 0.f;
#pragma unroll
            for (int m = 0; m < 4; ++m) {
                const int rl = ai * 128 + wr * 64 + m * 16 + fr, row = u.pm * 256 + rl; const float rB = RT[(ui * 256 + rl) * 2 + 1];
                float ssq = 0.f;
#pragma unroll
                for (int bj = 0; bj < 2; ++bj) { const u32x4 xw = xv[ai][m][bj]; u32x4 w;
#pragma unroll
                    for (int n = 0; n < 2; ++n) { const unsigned w0 = xw[2 * n], w1 = xw[2 * n + 1];
                        f32x4 xf; xf[0] = __builtin_bit_cast(float, w0 << 16); xf[1] = __builtin_bit_cast(float, w0 & 0xffff0000u); xf[2] = __builtin_bit_cast(float, w1 << 16); xf[3] = __builtin_bit_cast(float, w1 & 0xffff0000u);
                        const f32x4 x1 = xf + acc[ai][bj][m][n] * rB;
                        w[2 * n] = cvtpk(x1[0], x1[1]); w[2 * n + 1] = cvtpk(x1[2], x1[3]);
                        ssq += (x1[0] * x1[0] + x1[1] * x1[1]) + (x1[2] * x1[2] + x1[3] * x1[3]); }
                    *(u32x4*)(X1B + (size_t)row * DM + col0 + bj * 128) = w; }
                ssq += lane_xor<16>(ssq); ssq = half_swap_add(ssq);
                ssel = (fq == m) ? ssq : ssel;
            }
            SSQ3[(size_t)(u.pm * 256 + ai * 128 + wr * 64 + fq * 16 + fr) * 32 + u.pn * 4 + wc] = ssel; }
    }
};
struct EpiUp {
    static constexpr bool PERM = true, HAS_MID = false;
    bf16* H; const LAS float* RT;
    __device__ __forceinline__ void operator()(const f32x4 (&acc)[2][2][4][2], const pg8::Unit& u, int ui, int wr, int wc, int fr, int fq) const {
        asm volatile("" : "+v"(fr), "+v"(fq));
        const int colb = u.pn * 256 + wc * 32 + 8 * fq;
#pragma unroll
        for (int ai = 0; ai < 2; ++ai)
#pragma unroll
            for (int m = 0; m < 4; ++m) {
                const int rl = ai * 128 + wr * 64 + m * 16 + fr, row = u.pm * 256 + rl; const float rs = RT[ui * 256 + rl];
#pragma unroll
                for (int bj = 0; bj < 2; ++bj) { f32x4 v0 = acc[ai][bj][m][0] * rs, v1 = acc[ai][bj][m][1] * rs;
#pragma unroll
                    for (int e = 0; e < 4; ++e) { const float a = fmaxf(v0[e], 0.f), b = fmaxf(v1[e], 0.f); v0[e] = a * a; v1[e] = b * b; }
                    st16_wt(H + (size_t)row * DFF + colb + bj * 128, __builtin_bit_cast(u32x4, pack8(v0, v1))); }
            }
    }
};
struct EpiDown {
    static constexpr bool PERM = false, HAS_MID = false;
    float* out; const bf16* X1B;
    __device__ __forceinline__ void operator()(const f32x4 (&acc)[2][2][4][2], const pg8::Unit& u, int ui, int wr, int wc, int fr, int fq) const {
        asm volatile("" : "+v"(fr), "+v"(fq));
        const int row0 = u.pm * 256 + wr * 64 + fr, col0 = u.pn * 256 + wc * 32 + 4 * fq;
        u32x2 wv[2][4][2][2];
#pragma unroll
        for (int ai = 0; ai < 2; ++ai)
#pragma unroll
            for (int m = 0; m < 4; ++m)
#pragma unroll
                for (int bj = 0; bj < 2; ++bj)
#pragma unroll
                    for (int n = 0; n < 2; ++n) wv[ai][m][bj][n] = *(const u32x2*)(X1B + (size_t)(row0 + ai * 128 + m * 16) * DM + col0 + bj * 128 + n * 16);
#pragma unroll
        for (int ai = 0; ai < 2; ++ai)
            asm volatile("" : "+v"(wv[ai][0][0][0]), "+v"(wv[ai][0][0][1]), "+v"(wv[ai][0][1][0]), "+v"(wv[ai][0][1][1]), "+v"(wv[ai][1][0][0]), "+v"(wv[ai][1][0][1]), "+v"(wv[ai][1][1][0]), "+v"(wv[ai][1][1][1]),
                              "+v"(wv[ai][2][0][0]), "+v"(wv[ai][2][0][1]), "+v"(wv[ai][2][1][0]), "+v"(wv[ai][2][1][1]), "+v"(wv[ai][3][0][0]), "+v"(wv[ai][3][0][1]), "+v"(wv[ai][3][1][0]), "+v"(wv[ai][3][1][1]));
#pragma unroll
        for (int ai = 0; ai < 2; ++ai)
#pragma unroll
            for (int m = 0; m < 4; ++m) { const size_t ro = (size_t)(row0 + ai * 128 + m * 16) * DM + col0;
#pragma unroll
                for (int bj = 0; bj < 2; ++bj)
#pragma unroll
                    for (int n = 0; n < 2; ++n) { const size_t o = ro + bj * 128 + n * 16; const u32x2 w = wv[ai][m][bj][n];
                        f32x4 x1; x1[0] = __builtin_bit_cast(float, w.x << 16); x1[1] = __builtin_bit_cast(float, w.x & 0xffff0000u); x1[2] = __builtin_bit_cast(float, w.y << 16); x1[3] = __builtin_bit_cast(float, w.y & 0xffff0000u);
                        *(f32x4*)(out + O_Y + o) = x1 + acc[ai][bj][m][n]; } }
    }
};
struct EpiDownSlab {
    static constexpr bool PERM = false, HAS_MID = false;
    float* SL; int kslice;
    __device__ __forceinline__ void operator()(const f32x4 (&acc)[2][2][4][2], const pg8::Unit& u, int ui, int wr, int wc, int fr, int fq) const {
        asm volatile("" : "+v"(fr), "+v"(fq));
        const int row0 = (u.pm - 64) * 256 + wr * 64 + fr, col0 = u.pn * 256 + wc * 32 + 4 * fq;
        float* base = SL + (size_t)(u.ko / kslice) * (MS * DM);
#pragma unroll
        for (int ai = 0; ai < 2; ++ai)
#pragma unroll
            for (int m = 0; m < 4; ++m) { float* rowp = base + (size_t)(row0 + ai * 128 + m * 16) * DM + col0;
#pragma unroll
                for (int bj = 0; bj < 2; ++bj)
#pragma unroll
                    for (int n = 0; n < 2; ++n) *(f32x4*)(rowp + bj * 128 + n * 16) = acc[ai][bj][m][n]; }
    }
};
__device__ __forceinline__ void slab_done(unsigned* cnt) {
    if (threadIdx.x == 0) { __builtin_amdgcn_fence(__ATOMIC_RELEASE, "agent"); asm volatile("s_waitcnt vmcnt(0)" ::: "memory"); __hip_atomic_fetch_add(cnt, 1u, __ATOMIC_RELAXED, __HIP_MEMORY_SCOPE_AGENT); }
}
__device__ __forceinline__ void slab_wait(unsigned* cnt, unsigned need) {
    if (threadIdx.x == 0) { unsigned sp = 0; while (__hip_atomic_load(cnt, __ATOMIC_RELAXED, __HIP_MEMORY_SCOPE_AGENT) < need) { __builtin_amdgcn_s_sleep(2); if (++sp > (1u << 22)) break; }
        __builtin_amdgcn_fence(__ATOMIC_ACQUIRE, "agent"); asm volatile("s_waitcnt vmcnt(0)" ::: "memory"); }
    __syncthreads();
}
__device__ __forceinline__ void p0_transpose_item(const float* W, int ldw, int K, int nblk, const float* g0, const float* g1, bf16* WT, LAS float* scr, int item, int lane) {
    const int kb = item / nblk, nb = item % nblk, k0 = 64 * kb, n0 = 32 * nb;
    f32x4 v[8];
#pragma unroll
    for (int i = 0; i < 8; ++i) { const int k = k0 + 8 * i + (lane >> 3); v[i] = *(const f32x4*)(W + (size_t)k * ldw + n0 + (lane & 7) * 4); }
#pragma unroll
    for (int i = 0; i < 8; ++i) { const int kk = 8 * i + (lane >> 3), k = k0 + kk;
        float gv = 1.f; if (g0) gv = (g1 && k >= 1024) ? g1[k - 1024] : g0[k];
        LAS float* d = scr + kk * 33 + (lane & 7) * 4; d[0] = v[i][0] * gv; d[1] = v[i][1] * gv; d[2] = v[i][2] * gv; d[3] = v[i][3] * gv; }
    asm volatile("s_waitcnt lgkmcnt(0)" ::: "memory");
    const int c = lane & 7;
#pragma unroll
    for (int j = 0; j < 4; ++j) { const int n = (lane >> 3) + 8 * j; const LAS float* s = scr + (8 * c) * 33 + n;
        u32x4 o; o.x = pk2(s[0 * 33], s[1 * 33]); o.y = pk2(s[2 * 33], s[3 * 33]); o.z = pk2(s[4 * 33], s[5 * 33]); o.w = pk2(s[6 * 33], s[7 * 33]);
        *(u32x4*)(WT + (size_t)(n0 + n) * K + k0 + 8 * c) = o; }
    asm volatile("s_waitcnt lgkmcnt(0)" ::: "memory");
}

namespace fox {
constexpr int D = 128, NW = 8, QBLK = 32, KVBLK = 64, QB = 256;
constexpr int SHM_V = 16384, SHM_K = 16384, SHM_X = 2048;
constexpr int QROWB = 144, SHM_Q = 32 * QROWB;
constexpr int NVB = 3;
constexpr int OFF_V = 0, OFF_K = NVB * SHM_V, OFF_X = OFF_K + 2 * SHM_K, OFF_WS = OFF_X + 2 * SHM_X, OFF_Q = OFF_WS + NW * 64 * 4, OFF_QX = OFF_Q + NW * SHM_Q, LDSB = OFF_QX + NW * 1024;
#define KSWZ(row, colB) ((row) * 256 + ((colB) ^ (((row) & 15) << 4)))
#define SBAR() __builtin_amdgcn_sched_barrier(0)
__device__ __forceinline__ int v_st(int k, int c) { const int kk = (k & ~0xC) | ((k & 4) << 1) | ((k & 8) >> 1); return ((kk >> 3) * 4 + (c >> 5)) * 512 + ((kk & 7) * 32 + (c & 31)) * 2; }
__device__ __forceinline__ int v_rd_base(int lane) { return ((lane & 3) << 3) | (((lane >> 2) & 3) << 6) | (((lane >> 4) & 1) << 5) | (((lane >> 5) & 1) << 8); }
constexpr int v_rd_off(int d0, int ks, int half) { return d0 * 512 + ks * 4096 + half * 2048; }
__device__ __forceinline__ int crow(int r, int hi) { return (r & 3) + 8 * (r >> 2) + 4 * hi; }
__device__ __forceinline__ bf16x8 load8(const bf16* p) { return *reinterpret_cast<const bf16x8*>(p); }
__device__ __forceinline__ void mask_tile(f32x16& p0, f32x16& p1, int dq) {
#pragma unroll
    for (int r = 0; r < 16; ++r) { const int c = (r & 3) + 8 * (r >> 2);
        const unsigned m0 = (unsigned)((dq - c) >> 31), m1 = (unsigned)((dq - c - 32) >> 31);
        p0[r] = __uint_as_float((m0 & 0xff800000u) | (~m0 & __float_as_uint(p0[r])));
        p1[r] = __uint_as_float((m1 & 0xff800000u) | (~m1 & __float_as_uint(p1[r]))); }
}
__device__ __forceinline__ void partialSM(f32x16& p0) {
#pragma unroll
    for (int r = 0; r < 16; ++r) p0[r] = __builtin_amdgcn_exp2f(p0[r]);
}
__device__ __forceinline__ void finishSM(f32x16& p0, f32x16& p1, float& l_reg, bf16x8& pa0, bf16x8& pa1, bf16x8& pa2, bf16x8& pa3) {
#pragma unroll
    for (int r = 0; r < 16; ++r) p1[r] = __builtin_amdgcn_exp2f(p1[r]);
    float ps = 0;
#pragma unroll
    for (int r = 0; r < 16; ++r) ps += p0[r];
#pragma unroll
    for (int r = 0; r < 16; ++r) ps += p1[r];
    l_reg += ps;
#define PK4(P, B_, OUT) do { unsigned a0 = cvtpk(P[B_+0], P[B_+1]), a1 = cvtpk(P[B_+2], P[B_+3]);                          \
        unsigned b0 = cvtpk(P[B_+4], P[B_+5]), b1 = cvtpk(P[B_+6], P[B_+7]);                                             \
        auto r0 = __builtin_amdgcn_permlane32_swap(a0, b0, false, false); auto r1 = __builtin_amdgcn_permlane32_swap(a1, b1, false, false); \
        u32x4 w = {r0[0], r1[0], r0[1], r1[1]}; OUT = __builtin_bit_cast(bf16x8, w); } while (0)
    PK4(p0, 0, pa0); PK4(p0, 8, pa1); PK4(p1, 0, pa2); PK4(p1, 8, pa3);
#undef PK4
}
template <int VB>
__device__ __forceinline__ void pv_tile(f32x16* o, int vb0, bf16x8 pa0, bf16x8 pa1, bf16x8 pa2, bf16x8 pa3) {
#define TRRD(dst, off) asm volatile("ds_read_b64_tr_b16 %0, %1 offset:%2" : "=&v"(dst) : "v"(vb0), "i"(off) : "memory")
#define PV_D0(d0) do { s16x4 l0, l1, l2, l3, h0, h1, h2, h3; constexpr int b_ = VB * SHM_V + v_rd_off(d0, 0, 0); \
        TRRD(l0, b_); TRRD(h0, b_ + 2048); TRRD(l1, b_ + 4096); TRRD(h1, b_ + 6144); TRRD(l2, b_ + 8192); TRRD(h2, b_ + 10240); TRRD(l3, b_ + 12288); TRRD(h3, b_ + 14336); \
        asm volatile("s_waitcnt lgkmcnt(0)" ::: "memory"); SBAR();   \
        o[d0] = __builtin_amdgcn_mfma_f32_32x32x16_bf16(pa0, (bf16x8){l0[0], l0[1], l0[2], l0[3], h0[0], h0[1], h0[2], h0[3]}, o[d0], 0, 0, 0);   \
        o[d0] = __builtin_amdgcn_mfma_f32_32x32x16_bf16(pa1, (bf16x8){l1[0], l1[1], l1[2], l1[3], h1[0], h1[1], h1[2], h1[3]}, o[d0], 0, 0, 0);   \
        o[d0] = __builtin_amdgcn_mfma_f32_32x32x16_bf16(pa2, (bf16x8){l2[0], l2[1], l2[2], l2[3], h2[0], h2[1], h2[2], h2[3]}, o[d0], 0, 0, 0);   \
        o[d0] = __builtin_amdgcn_mfma_f32_32x32x16_bf16(pa3, (bf16x8){l3[0], l3[1], l3[2], l3[3], h3[0], h3[1], h3[2], h3[3]}, o[d0], 0, 0, 0); } while (0)
    PV_D0(0); PV_D0(1); PV_D0(2); PV_D0(3);
#undef PV_D0
#undef TRRD
}
typedef __amdgpu_buffer_rsrc_t srd_t;
__device__ __forceinline__ srd_t mksrd(const void* p, unsigned bytes) { return __builtin_amdgcn_make_buffer_rsrc((void*)p, 0, (int)bytes, 0x00020000); }
__device__ __forceinline__ bf16x8 bload8(srd_t r, unsigned voff, unsigned soff) { return __builtin_bit_cast(bf16x8, __builtin_amdgcn_raw_buffer_load_b128(r, (int)voff, (int)soff, 0)); }
struct Ctx { srd_t W; unsigned char* ws; };
struct Seam { bf16x8 qr[8]; bf16x8 qx; };
#define WAITBAR() asm volatile("s_waitcnt vmcnt(0) lgkmcnt(0)\n\ts_barrier" ::: "memory")
#define OKV(bh, t) ((unsigned)(bh) * (SEQ * HD * 2) + (unsigned)(t) * (KVBLK * D * 2))
#define DMA16(dst, voff, soff, imm) __builtin_amdgcn_raw_ptr_buffer_load_lds(C.W, (LAS void*)(dst), 16, (int)(voff), (int)(soff), (imm), 0)
#define DMA_TILE(bh, t, kb, vb) do { const unsigned so_ = OKV(bh, t); \
        DMA16(lds + OFF_K + (kb) * SHM_K + wid * 2048, vok0, (unsigned)WS_KH + so_, 0); DMA16(lds + OFF_K + (kb) * SHM_K + wid * 2048 + 1024, vok1, (unsigned)WS_KH + so_, 0); \
        DMA16(lds + OFF_V + (vb) * SHM_V + wid * 2048, vov, (unsigned)WS_VH + so_, 0);  DMA16(lds + OFF_V + (vb) * SHM_V + wid * 2048 + 1024, vov, (unsigned)WS_VH + so_ + 128u, 0);   \
        if (wid < 2) DMA16(lds + OFF_X + (kb) * SHM_X + wid * 1024, vox, (unsigned)WS_CLK + (unsigned)(bh) * (SEQ * 32) + (unsigned)(t) * (KVBLK * 32), 0); } while (0)
#define DMA_OFFS(tid_) const int lane_ = (tid_) & 63; \
        const int kr0_ = 8 * wid + (lane_ >> 4), kr1_ = kr0_ + 4;                                     \
        const unsigned vok0 = (unsigned)(kr0_ * 256 + (((lane_ & 15) ^ (kr0_ & 15)) << 4)), vok1 = (unsigned)(kr1_ * 256 + (((lane_ & 15) ^ (kr1_ & 15)) << 4)); \
        const int vkk_ = 8 * wid + ((lane_ >> 2) & 7), vk_ = (vkk_ & ~0xC) | ((vkk_ & 4) << 1) | ((vkk_ & 8) >> 1);     \
        const unsigned vov = (unsigned)(vk_ * 256 + ((lane_ >> 5) * 32 + (lane_ & 3) * 8) * 2), vox = (unsigned)(tid_) * 16u
#define QLOAD(bh, qb, R32, HI) do { const unsigned voq_ = (unsigned)(((wid * QBLK + (R32)) * D + (HI) * 8) * 2); const unsigned row0_ = (unsigned)(bh) * SEQ + (unsigned)(qb) * QB; \
    _Pragma("unroll") for (int d0 = 0; d0 < 8; ++d0) S.qr[d0] = bload8(C.W, voq_ + d0 * 32, (unsigned)WS_QH + row0_ * (HD * 2)); \
    S.qx = bload8(C.W, (unsigned)(((wid * QBLK + (R32)) * 16 + (HI) * 8) * 2), (unsigned)WS_CLQ + row0_ * 32); } while (0)
__device__ __forceinline__ int tile_lo(const Ctx& C, int bh, int qb, int lane) {
    const unsigned base = (unsigned)(WS_SMALL + SM_CLF) + (unsigned)bh * (SEQ * 4);
    const float thr = __builtin_bit_cast(float, __builtin_amdgcn_raw_buffer_load_b32(C.W, 0, (int)((unsigned)(WS_SMALL + SM_CLF) + 16u * SEQ * 4u), 0));
    const float cr0 = __builtin_bit_cast(float, __builtin_amdgcn_raw_buffer_load_b32(C.W, 0, (int)(base + (unsigned)qb * (QB * 4)), 0));
    const int NT = 4 * qb + 4; int first = NT - 4;
    for (int j = lane; j < NT - 4; j += 64) { const float ce = __builtin_bit_cast(float, __builtin_amdgcn_raw_buffer_load_b32(C.W, (int)((KVBLK * j + KVBLK - 1) * 4), (int)base, 0));
        if (cr0 - ce >= -thr) first = min(first, j); }
    first = __builtin_amdgcn_readfirstlane(wave_min_i(first));
    return first & ~1;
}
__device__ __forceinline__ void prime(const Ctx& C, int bh, int qb, int jlo, LAS char* lds, Seam& S, const int wave) {
    const int tid = opaque_tid(wave), wid = wave, r32 = tid & 31, hi = (tid >> 5) & 1;
    DMA_OFFS(tid);
    QLOAD(bh, qb, r32, hi);
    DMA_TILE(bh, jlo, 0, 0);
}
template <int KB>
__device__ __forceinline__ void qkt(f32x16& p0, f32x16& p1, LAS const char* lds, int r32, int hi, const bf16x8 (&q4)[4], LAS const char* qb, LAS const char* qxb) {
    p0 = f32x16{}; p1 = f32x16{};
    unsigned kb0 = (unsigned)(uintptr_t)(lds + OFF_K + KB * SHM_K) + (unsigned)KSWZ(r32, hi * 16);
    asm volatile("" : "+v"(kb0));
#pragma unroll
    for (int d0 = 0; d0 < 8; ++d0) { LAS const char* a = (LAS const char*)(uintptr_t)(kb0 ^ (unsigned)(d0 << 5));
        bf16x8 b0 = *reinterpret_cast<LAS const bf16x8*>(a);
        bf16x8 b1 = *reinterpret_cast<LAS const bf16x8*>(a + 32 * 256);
        bf16x8 qf; if (d0 < 4) qf = q4[d0]; else qf = *reinterpret_cast<LAS const bf16x8*>(qb + (d0 - 4) * 32);
        p0 = __builtin_amdgcn_mfma_f32_32x32x16_bf16(b0, qf, p0, 0, 0, 0);
        p1 = __builtin_amdgcn_mfma_f32_32x32x16_bf16(b1, qf, p1, 0, 0, 0); }
    { LAS const char* xa = lds + OFF_X + KB * SHM_X + r32 * 32 + hi * 16;
        bf16x8 x0 = *reinterpret_cast<LAS const bf16x8*>(xa); bf16x8 x1 = *reinterpret_cast<LAS const bf16x8*>(xa + 32 * 32);
        const bf16x8 qx = *reinterpret_cast<LAS const bf16x8*>(qxb);
        p0 = __builtin_amdgcn_mfma_f32_32x32x16_bf16(x0, qx, p0, 0, 0, 0);
        p1 = __builtin_amdgcn_mfma_f32_32x32x16_bf16(x1, qx, p1, 0, 0, 0); }
}
__device__ __forceinline__ void block(const Ctx& C, int bh, int qb_cur, int jlo, int qb_nxt, int jlo_nxt, LAS char* lds, Seam& S, const int wave) {
    const int tid = opaque_tid(wave), wid = wave, lane = tid & 63, r32 = lane & 31, hi = lane >> 5;
    const int P0 = qb_cur * QB;
    const int NT = (P0 + QB - 1) / KVBLK + 1 - jlo;
    const int qlo = P0 + wid * QBLK, qm = qlo + r32 - 4 * hi;
    float l_reg = 0; f32x16 o[4] = {};
    DMA_OFFS(tid);
    const int vb0 = (int)(unsigned)(uintptr_t)(lds + OFF_V) + v_rd_base(lane);
#define KBASE(t) ((jlo + (t)) * KVBLK)
#define MASKT(P0_, P1_, t) do { const int kb_ = KBASE(t); if (kb_ + KVBLK - 1 > qlo) mask_tile(P0_, P1_, qm - kb_); } while (0)
    f32x16 pA0, pA1, pB0, pB1; bf16x8 pa0, pa1, pa2, pa3;
    bf16x8 q4[4] = {S.qr[0], S.qr[1], S.qr[2], S.qr[3]};
    LAS char* qb = lds + OFF_Q + wid * SHM_Q + r32 * QROWB + hi * 16;
#pragma unroll
    for (int d0 = 4; d0 < 8; ++d0) *reinterpret_cast<LAS bf16x8*>(qb + (d0 - 4) * 32) = S.qr[d0];
    LAS char* qxb = lds + OFF_QX + wid * 1024 + r32 * 32 + hi * 16; *reinterpret_cast<LAS bf16x8*>(qxb) = S.qx;
    WAITBAR();
    SBAR(); qkt<0>(pA0, pA1, lds, r32, hi, q4, qb, qxb);
    DMA_TILE(bh, jlo + 1, 1, 1); SBAR();
    MASKT(pA0, pA1, 0); partialSM(pA0);
    WAITBAR();
    int vr = 0, vw = 2;
#define HALF_STEP(PX0, PX1, PY0, PY1, t, KB) do {                                                      \
        SBAR(); qkt<KB>(PX0, PX1, lds, r32, hi, q4, qb, qxb);                                             \
        finishSM(PY0, PY1, l_reg, pa0, pa1, pa2, pa3); SBAR();                                                           \
        if ((t) + 1 < NT) { DMA_TILE(bh, jlo + (t) + 1, (KB) ^ 1, vw); SBAR(); }                                         \
        pv_tile<0>(o, vb0 + vr * SHM_V, pa0, pa1, pa2, pa3); MASKT(PX0, PX1, (t)); partialSM(PX0);                         \
        WAITBAR();                                                                                                            \
        vr = (vr == NVB - 1) ? 0 : vr + 1; vw = (vw == NVB - 1) ? 0 : vw + 1; } while (0)
    for (int t = 1; t + 1 < NT; t += 2) {
        HALF_STEP(pB0, pB1, pA0, pA1, t, 1);
        HALF_STEP(pA0, pA1, pB0, pB1, t + 1, 0);
    }
    SBAR(); qkt<1>(pB0, pB1, lds, r32, hi, q4, qb, qxb); SBAR();
    finishSM(pA0, pA1, l_reg, pa0, pa1, pa2, pa3); SBAR();
    pv_tile<0>(o, vb0 + vr * SHM_V, pa0, pa1, pa2, pa3);
    vr = (vr == NVB - 1) ? 0 : vr + 1;
    MASKT(pB0, pB1, NT - 1); partialSM(pB0);
    finishSM(pB0, pB1, l_reg, pa0, pa1, pa2, pa3); SBAR(); pv_tile<0>(o, vb0 + vr * SHM_V, pa0, pa1, pa2, pa3);
    WAITBAR();
    { const int tid2 = opaque_tid(wave), r32b = tid2 & 31, hib = (tid2 >> 5) & 1;
      QLOAD(bh, qb_nxt, r32b, hib);
      DMA_TILE(bh, jlo_nxt, 0, 0); SBAR();
      l_reg = half_swap_add(l_reg);
      LAS float* li2 = (LAS float*)(lds + OFF_WS) + wid * 64;
      if (hib == 0) li2[r32b] = l_reg; asm volatile("s_waitcnt lgkmcnt(0)" ::: "memory");
      const unsigned tok0 = (unsigned)(bh >> 3) * SEQ + (unsigned)P0 + (unsigned)(wid * QBLK);
      bf16* Ow = (bf16*)(C.ws + WS_MIX) + (size_t)tok0 * DM + 1024 + (bh & 7) * HD; float* SSw = (float*)(C.ws + WS_SMALL + SM_SSQ2) + (size_t)tok0 * 8 + (bh & 7);
      const unsigned stg0 = (unsigned)(uintptr_t)lds + (unsigned)(wid < 4 ? 16384 + wid * 8192 : wid < 6 ? 65536 + (wid - 4) * 8192 : LDSB + (wid - 6) * 8192);
      unsigned swa = stg0 + (unsigned)hib * 1024u + (unsigned)r32b * 2u; asm volatile("" : "+v"(swa));
      LAS unsigned char* swp = (LAS unsigned char*)(uintptr_t)swa;
      const unsigned sbase = (unsigned)(4 * hib) * 8; float sqk = 0.f;
#pragma unroll
      for (int r = 0; r < 16; ++r) { const unsigned ro = (unsigned)((r & 3) + 8 * (r >> 2)); const float rli = __builtin_amdgcn_rcpf(li2[ro + 4 * hib]); float sq = 0.f;
#pragma unroll
          for (int d0 = 0; d0 < 4; ++d0) { const float v = o[d0][r] * rli; sq += v * v;
              const float vn = lane_xor<1>(v);
              if ((r32b & 1) == 0) *(LAS unsigned*)(swp + ro * 256 + d0 * 64) = cvtpk(v, vn); }
          sq = sum32(sq);
          sqk = (r32b == r) ? sq : sqk; }
      if (r32b < 16) SSw[sbase + ((r32b & 3) + 8 * (r32b >> 2)) * 8] = sqk;
      asm volatile("s_waitcnt lgkmcnt(0)" ::: "memory");
      { const int ln = r32b + 32 * hib; unsigned sra = stg0 + (unsigned)(ln >> 4) * 256u + (unsigned)(ln & 15) * 16u; asm volatile("" : "+v"(sra));
        const LAS unsigned char* srp = (const LAS unsigned char*)(uintptr_t)sra;
        bf16* Or = Ow + (size_t)(ln >> 4) * DM + (ln & 15) * 8;
#pragma unroll
        for (int hb = 0; hb < 2; ++hb) { u32x4 vq[4];
#pragma unroll
          for (int it = 0; it < 4; ++it) vq[it] = *(const LAS u32x4*)(srp + (16 * hb + 4 * it) * 256);
#pragma unroll
          for (int it = 0; it < 4; ++it) *(u32x4*)(Or + (size_t)(16 * hb + 4 * it) * DM) = vq[it]; } } }
#undef KBASE
#undef MASKT
#undef HALF_STEP
}
__device__ __forceinline__ void finish(Seam& S) { asm volatile("" :: "v"(S.qx)); asm volatile("s_waitcnt vmcnt(0) lgkmcnt(0)" ::: "memory"); __syncthreads(); }
#undef WAITBAR
#undef OKV
#undef DMA16
#undef DMA_TILE
#undef DMA_OFFS
#undef QLOAD
}


struct S5Frag { bf16x8 ua, uf0, uf1; };
template <bool READOUT>
__device__ __forceinline__ S5Frag s5_load(const bf16* U, int tok0, int g, int lane) {
    S5Frag f; const int r32 = lane & 31, hi = lane >> 5;
    f.ua = *(const bf16x8*)(U + (size_t)(tok0 + r32) * DSSM + g * 16 + 8 * hi);
    if (READOUT) { f.uf0 = *(const bf16x8*)(U + (size_t)(tok0 + (lane & 15)) * DSSM + g * 16 + 8 * ((lane >> 4) & 1));
                   f.uf1 = *(const bf16x8*)(U + (size_t)(tok0 + 16 + (lane & 15)) * DSSM + g * 16 + 8 * ((lane >> 4) & 1)); }
    else { f.uf0 = f.ua; f.uf1 = f.ua; }
    return f;
}
#ifndef PSTAGE
#define PSTAGE true
#endif
#ifndef SSTAGE
#define SSTAGE true
#endif
template <bool READOUT, bool STAGE = true>
__device__ __forceinline__ void s5_scan32(const S5Frag& F, bf16* GYD, LAS unsigned char* ST, int srow, int tok0, int g, float a_re, float a_im, const bf16x8 (&bm)[4], const bf16x8 (&cm)[4], const bf16x8 dfrag,
                                          LAS unsigned char* Hs, float& h_re, float& h_im, int lane) {
    const int r32 = lane & 31, hi = lane >> 5, p = r32 + 32 * hi;
    f32x16 D0 = __builtin_amdgcn_mfma_f32_32x32x16_bf16(F.ua, bm[0], f32x16{}, 0, 0, 0);
    f32x16 D1 = __builtin_amdgcn_mfma_f32_32x32x16_bf16(F.ua, bm[1], f32x16{}, 0, 0, 0);
    f32x16 D2 = __builtin_amdgcn_mfma_f32_32x32x16_bf16(F.ua, bm[2], f32x16{}, 0, 0, 0);
    f32x16 D3 = __builtin_amdgcn_mfma_f32_32x32x16_bf16(F.ua, bm[3], f32x16{}, 0, 0, 0);
#pragma unroll
    for (int r = 0; r < 16; ++r) {
        auto s0 = __builtin_amdgcn_permlane32_swap(__float_as_uint(D0[r]), __float_as_uint(D1[r]), false, false); D0[r] = __uint_as_float(s0[0]); D1[r] = __uint_as_float(s0[1]);
        auto s1 = __builtin_amdgcn_permlane32_swap(__float_as_uint(D2[r]), __float_as_uint(D3[r]), false, false); D2[r] = __uint_as_float(s1[0]); D3[r] = __uint_as_float(s1[1]);
    }
#pragma unroll
    for (int s = 0; s < 32; ++s) {
        const int hs = (s >> 2) & 1, rs_ = (s & 3) + 4 * (s >> 3);
        const float bre = hs ? D1[rs_] : D0[rs_], bim = hs ? D3[rs_] : D2[rs_];
        const float nre = fmaf(a_re, h_re, fmaf(-a_im, h_im, bre)), nim = fmaf(a_re, h_im, fmaf(a_im, h_re, bim));
        h_re = nre; h_im = nim;
        if (READOUT) *(LAS unsigned*)(Hs + s * 272 + p * 4) = cvtpk_nv(h_re, h_im);
    }
    if (READOUT) {
        asm volatile("s_waitcnt lgkmcnt(0)" ::: "memory");
#pragma unroll
        for (int tb = 0; tb < 2; ++tb) {
            f32x4 y = __builtin_amdgcn_mfma_f32_16x16x32_bf16(tb == 0 ? F.uf0 : F.uf1, dfrag, (f32x4){0.f, 0.f, 0.f, 0.f}, 0, 0, 0);
#pragma unroll
            for (int kk = 0; kk < 4; ++kk) { const bf16x8 ha = *(const LAS bf16x8*)(Hs + (16 * tb + (lane & 15)) * 272 + kk * 64 + (lane >> 4) * 16);
                y = __builtin_amdgcn_mfma_f32_16x16x32_bf16(ha, cm[kk], y, 0, 0, 0); }
#pragma unroll
            for (int r = 0; r < 4; ++r) { const int t = 16 * tb + 4 * (lane >> 4) + r; const size_t tok = (size_t)(tok0 + t);
                if (STAGE) *(LAS unsigned short*)(ST + (srow + t) * 32 + (lane & 15) * 2) = (unsigned short)f2bf(gelu_tanh(y[r]));
                else GYD[tok * DSSM + g * 16 + (lane & 15)] = f2bf(gelu_tanh(y[r])); }
        }
        asm volatile("s_waitcnt lgkmcnt(0)" ::: "memory");
    }
}
__device__ __forceinline__ void s5_flush(LAS const unsigned char* ST, bf16* GY, int tok0, int nrow, int g, int lane) {
    asm volatile("s_waitcnt lgkmcnt(0)" ::: "memory");
    for (int r = lane >> 1; r < nrow; r += 32) { const u32x4 v = *(const LAS u32x4*)(ST + r * 32 + (lane & 1) * 16);
        *(u32x4*)(GY + (size_t)(tok0 + r) * DSSM + g * 16 + (lane & 1) * 8) = v; }
    asm volatile("s_waitcnt lgkmcnt(0)" ::: "memory");
}
__device__ __forceinline__ bf16x8 s5_dfrag(float dsk, int lane) {
    const int i = lane & 15, kq = lane >> 4; bf16x8 d = {0, 0, 0, 0, 0, 0, 0, 0};
    const short dv = (short)f2bf(dsk);
#pragma unroll
    for (int jj = 0; jj < 8; ++jj) d[jj] = (8 * kq + jj == i) ? dv : (short)0;
    return d;
}

#define XB_TMO      128
#define XB_XCNT(j)  (256  + 64 * (j))
#define XB_XSUB(j)  (1280 + 64 * (j))
#define XB_XGEN(j)  (2304 + 64 * (j))
#define XB_TOP      3328
#define XB_TOPGEN   3392
#define XCD_BAR_WORDS 3456
#define XB_SPIN_CAP (1u << 18)
__device__ __forceinline__ unsigned xb_ld(unsigned* p)              { return __hip_atomic_load(p, __ATOMIC_RELAXED, __HIP_MEMORY_SCOPE_AGENT); }
__device__ __forceinline__ unsigned xb_add(unsigned* p, unsigned v) { return __hip_atomic_fetch_add(p, v, __ATOMIC_RELAXED, __HIP_MEMORY_SCOPE_AGENT); }
__device__ __forceinline__ unsigned xb_xcc_id() { return (unsigned)__builtin_amdgcn_s_getreg((3 << 11) | 20) & 0xFu; }
#define XB_SPIN(cond, bar) do { unsigned _sp = 0; while (cond) { __builtin_amdgcn_s_sleep(1); \
    if ((++_sp & 255u) == 0u) { if (xb_ld(&(bar)[XB_TMO])) break; if (_sp > XB_SPIN_CAP) { atomicAdd(&(bar)[XB_TMO], 1u); break; } } } } while (0)
struct XcdBarrier { unsigned* bar; unsigned x; volatile LAS unsigned* st; };
__device__ __forceinline__ XcdBarrier xcd_barrier_post(unsigned* bar, volatile LAS unsigned* st) {
    XcdBarrier b; b.bar = bar; b.x = xb_xcc_id(); b.st = st;
    if (threadIdx.x == 0) (void)xb_add(&bar[XB_XCNT(b.x)], 1u);
    return b;
}
__device__ __forceinline__ void xcd_barrier_complete(unsigned* bar, unsigned x, unsigned& nloc, unsigned& nx) {
    const unsigned G = gridDim.x * gridDim.y * gridDim.z;
    unsigned sum, cnt, mine, sp = 0u;
    for (;;) {
        sum = 0u; cnt = 0u; mine = 0u;
#pragma unroll
        for (unsigned j = 0; j < 16; ++j) { const unsigned c = xb_ld(&bar[XB_XCNT(j)]); sum += c; cnt += (c > 0u) ? 1u : 0u; mine = (j == x) ? c : mine; }
        if (sum == G) break;
        __builtin_amdgcn_s_sleep(1);
        if ((++sp & 255u) == 0u) { if (xb_ld(&bar[XB_TMO])) break; if (sp > XB_SPIN_CAP) { atomicAdd(&bar[XB_TMO], 1u); break; } }
    }
    nloc = mine > 0u ? mine : 1u; nx = cnt > 0u ? cnt : 1u;
}
__device__ __forceinline__ void xcd_barrier(const XcdBarrier& b) {
    asm volatile("s_waitcnt vmcnt(0)" ::: "memory");
    __syncthreads();
    if (threadIdx.x == 0) {
        unsigned* bar = b.bar;
        __builtin_amdgcn_s_waitcnt(0);
        unsigned nloc = b.st[0], nx = b.st[1];
        if (nloc == 0u) { xcd_barrier_complete(bar, b.x, nloc, nx); b.st[0] = nloc; b.st[1] = nx; }
        const unsigned old = xb_add(&bar[XB_XSUB(b.x)], 1u);
        const unsigned gen = old / nloc;
        if (old + 1u == (gen + 1u) * nloc) {
            __builtin_amdgcn_fence(__ATOMIC_RELEASE, "agent");
            asm volatile("s_waitcnt vmcnt(0)" ::: "memory");
            const unsigned og = xb_add(&bar[XB_TOP], 1u);
            const unsigned tg = og / nx;
            if (og + 1u == (tg + 1u) * nx) xb_add(&bar[XB_TOPGEN], 1u);
            else XB_SPIN(xb_ld(&bar[XB_TOPGEN]) == tg, bar);
            xb_add(&bar[XB_XGEN(b.x)], 1u);
            __builtin_amdgcn_fence(__ATOMIC_ACQUIRE, "agent");
            asm volatile("s_waitcnt vmcnt(0)" ::: "memory");
        } else {
            XB_SPIN(xb_ld(&bar[XB_XGEN(b.x)]) == gen, bar);
            __builtin_amdgcn_fence(__ATOMIC_ACQUIRE, "agent");
            asm volatile("s_waitcnt vmcnt(0)" ::: "memory");
        }
    }
    __syncthreads();
}

__device__ __forceinline__ void split3(float x, unsigned short& h, unsigned short& m, unsigned short& l) {
    h = (unsigned short)f2bf(x); const float r1 = x - bf2f(h); m = (unsigned short)f2bf(r1); const float r2 = r1 - bf2f(m); l = (unsigned short)f2bf(r2);
}

__global__ void __launch_bounds__(512, 2) hymba_fwd(Args args) {
    extern __shared__ __attribute__((aligned(16))) unsigned char lds_raw[];
    cg::grid_group grid = cg::this_grid();
    LAS unsigned char* lds = (LAS unsigned char*)lds_raw;
    const int wave = __builtin_amdgcn_readfirstlane(threadIdx.x >> 6);
    const int G = gridDim.x, bx = blockIdx.x;
    volatile LAS unsigned* xst = (volatile LAS unsigned*)(lds + LDS_BYTES - 16);
    if (threadIdx.x < 4) xst[threadIdx.x] = 0u;
    __syncthreads();
    const XcdBarrier xbar = xcd_barrier_post((unsigned*)((const __attribute__((address_space(4))) Args*)__builtin_amdgcn_kernarg_segment_ptr())->ws, xst);
    if (gridDim.y == 0x7fffffffu) grid.sync();
#define GRID_SYNC() xcd_barrier(xbar)
    const int gw = bx * 8 + wave, NGW = G * 8;
#define PHASE_PTRS \
    const __attribute__((address_space(4))) Args* A_ = (const __attribute__((address_space(4))) Args*)__builtin_amdgcn_kernarg_segment_ptr(); asm volatile("" : "+s"(A_)); \
    unsigned char* const ws = A_->ws; float* const out = A_->out; (void)ws; (void)out;
#define IN(i) (A_->in[i])
#define x_prompt IN(0)
#define x_sample IN(1)
#define cache_k IN(2)
#define cache_v IN(3)
#define cache_logf IN(4)
#define st_re IN(5)
#define st_im IN(6)
#define Win_t ((bf16*)(ws + WS_WIN))
#define Wglu_t ((bf16*)(ws + WS_WGLU))
#define Wout_t ((bf16*)(ws + WS_WOUT))
#define Wup_t ((bf16*)(ws + WS_WUP))
#define Wdn_t ((bf16*)(ws + WS_WDN))
#define RS1 ((float*)(ws + WS_SMALL + SM_RS1))
#define ABAR ((float*)(ws + WS_SMALL + SM_ABAR))
#define APOW ((float*)(ws + WS_SMALL + SM_APOW))
#define BMT ((bf16*)(ws + WS_SMALL + SM_BMT))
#define CMT ((bf16*)(ws + WS_SMALL + SM_CMT))
#define SSQ1 ((float*)(ws + WS_SMALL + SM_SSQ1))
#define SSQ2 ((float*)(ws + WS_SMALL + SM_SSQ2))
#define SSQ3 ((float*)(ws + WS_SSQ3))
#define XB ((bf16*)(ws + WS_XB))
#define U ((bf16*)(ws + WS_U))
#define QKraw ((float*)(ws + WS_QKRAW))
#define Qh ((bf16*)(ws + WS_QH))
#define Kh ((bf16*)(ws + WS_KH))
#define Vh ((bf16*)(ws + WS_VH))
#define GY ((bf16*)(ws + WS_GY))
#define MIX ((bf16*)(ws + WS_MIX))
#define X1B ((bf16*)(ws + WS_X1B))
#define Hb ((bf16*)(ws + WS_H))
#define CLK ((bf16*)(ws + WS_CLK))
#define CLQ ((bf16*)(ws + WS_CLQ))

    for (int rep_ = 0; rep_ < REPS(1); ++rep_) { if (rep_) GRID_SYNC();
        PHASE_PTRS
        const int tid = opaque_tid(wave), lane = tid & 63;
        LAS float* scr = (LAS float*)(lds + wave * 16384);
        constexpr int I_IN = 32 * 128;
        for (int it = gw; it < I_IN; it += NGW) p0_transpose_item(IN(8), NINW, DM, 128, IN(7), nullptr, Win_t, scr, it, lane);
        __syncthreads();
        LAS float* wfT = (LAS float*)lds;
        { f32x4 fw[4][2]; float fg[4];
#pragma unroll
          for (int i = 0; i < 4; ++i) { const int k = tid + 512 * i; const float* wr_ = IN(8) + (size_t)k * NINW + 4096; fw[i][0] = *(const f32x4*)wr_; fw[i][1] = *(const f32x4*)(wr_ + 4); fg[i] = IN(7)[k]; }
#pragma unroll
          for (int i = 0; i < 4; ++i) { const int k = tid + 512 * i;
#pragma unroll
              for (int h = 0; h < 8; ++h) wfT[h * DM + k] = fw[i][h >> 2][h & 3] * fg[i]; } }
        __syncthreads();
        f32x4 vn[8];
        { const int m0 = gw < MT ? gw : 0; const float* xr0 = m0 < MP ? x_prompt + (size_t)m0 * DM : x_sample + (size_t)(m0 - MP) * DM;
#pragma unroll
          for (int j = 0; j < 8; ++j) vn[j] = *(const f32x4*)(xr0 + 4 * lane + 256 * j); }
        for (int m = gw; m < MT; m += NGW) {
            f32x4 v[8]; float s = 0.f; float dt[8];
#pragma unroll
            for (int h = 0; h < 8; ++h) dt[h] = 0.f;
#pragma unroll
            for (int j = 0; j < 8; ++j) { v[j] = vn[j]; s += (v[j][0] * v[j][0] + v[j][1] * v[j][1]) + (v[j][2] * v[j][2] + v[j][3] * v[j][3]); }
#pragma unroll
            for (int j = 0; j < 8; ++j) { u32x2 w; w.x = cvtpk(v[j][0], v[j][1]); w.y = cvtpk(v[j][2], v[j][3]); *(u32x2*)(XB + (size_t)m * DM + 4 * lane + 256 * j) = w; }
            { const int mn = m + NGW < MT ? m + NGW : m; const float* xrn = mn < MP ? x_prompt + (size_t)mn * DM : x_sample + (size_t)(mn - MP) * DM;
#pragma unroll
              for (int j = 0; j < 8; ++j) vn[j] = *(const f32x4*)(xrn + 4 * lane + 256 * j); }
#pragma unroll
            for (int j = 0; j < 8; ++j)
#pragma unroll
                for (int h = 0; h < 8; ++h) { const f32x4 w = *(const LAS f32x4*)(wfT + h * DM + 4 * lane + 256 * j); dt[h] += (v[j][0] * w[0] + v[j][1] * w[1]) + (v[j][2] * w[2] + v[j][3] * w[3]); }
            s = wave_sum(s); const float rs = 1.0f / sqrtf(s * (1.0f / DM) + EPS);
#pragma unroll
            for (int h = 0; h < 8; ++h) dt[h] = wave_sum(dt[h]);
            if (lane == 0) RS1[m] = rs;
            if (lane < 8) { float z = 0.f;
#pragma unroll
                for (int h = 0; h < 8; ++h) z = (lane == h) ? dt[h] : z;
                z = z * rs + IN(9)[lane];
                const float lf = log_sigmoidf_(z);
                out[(m < MP ? O_LFP + (size_t)m * 8 : O_LFS + (size_t)(m - MP) * 8) + lane] = lf; }
        }
    }
    GRID_SYNC();

    for (int rep_ = 0; rep_ < REPS(2); ++rep_) { if (rep_) GRID_SYNC();
        PHASE_PTRS
        pg8::Gemm g{XB, Win_t, MT, 4096, DM, DM}; pg8::StaticOrder S; S.init(MT, 4096, G, bx);
        EpiIn E{RS1, U, out, Qh, Kh, Vh, IN(19), IN(20), (LAS float*)(lds + AUX_OFF)};
        pg8::gemm_phase<EpiIn, pg8::StaticOrder>(lds, g, S, E, wave);
        { const int busy = S.nwg % G, nfree = busy ? G - busy : G, fi = busy ? bx - busy : bx;
          if (fi >= 0 && rep_ == 0) { const int tq_ = opaque_tid(wave);
            if (tq_ < 32) for (int gt = fi * 32 + tq_; gt < NG * NP; gt += nfree * 32) {
            const int g = gt >> 6, p = gt & 63;
            const float a_re = IN(10)[gt], a_im = IN(11)[gt], step = expf(IN(12)[g]);
            const float mag = expf(a_re * step); float sn, cs; sincosf(a_im * step, &sn, &cs);
            const float ab_re = mag * cs, ab_im = mag * sn;
            const float den = a_re * a_re + a_im * a_im, nr = ab_re - 1.0f, ni = ab_im;
            const float fr_ = (nr * a_re + ni * a_im) / den, fi_ = (ni * a_re - nr * a_im) / den;
            ABAR[gt * 2] = ab_re; ABAR[gt * 2 + 1] = ab_im;
            float pr = ab_re, pi = ab_im;
#pragma unroll 1
            for (int q = 0; q < 9; ++q) { const float nr2 = pr * pr - pi * pi, ni2 = 2.f * pr * pi; pr = nr2; pi = ni2; }
            APOW[gt * 2] = pr; APOW[gt * 2 + 1] = pi;
            const float* bre = IN(13) + (size_t)gt * 16; const float* bim = IN(14) + (size_t)gt * 16;
#pragma unroll
            for (int j = 0; j < 16; ++j) { const float br = bre[j], bi = bim[j];
                BMT[((size_t)g * 128 + p) * 16 + j] = (bf16)f2bf(fr_ * br - fi_ * bi);
                BMT[((size_t)g * 128 + 64 + p) * 16 + j] = (bf16)f2bf(fr_ * bi + fi_ * br); }
#pragma unroll
            for (int i = 0; i < 16; ++i) { const float cr = IN(15)[((size_t)g * 16 + i) * 64 + p], ci = IN(16)[((size_t)g * 16 + i) * 64 + p];
                CMT[((size_t)g * 16 + i) * 128 + 2 * p] = (bf16)f2bf(cr); CMT[((size_t)g * 16 + i) * 128 + 2 * p + 1] = (bf16)f2bf(-ci); }
            } }
          if (fi >= 0 && fi < 16 && rep_ == 0) {
            const int tid = opaque_tid(wave), lane = tid & 63;
            const int bh = fi, b = bh >> 3, h = bh & 7;
            LAS float* red = (LAS float*)(lds + AUX_OFF);
            float gm = 0.f; if (tid < 128) gm = fabsf(IN(19)[tid] * IN(20)[tid]);
            gm = wave_max(gm);
            if (lane == 0) red[16 + wave] = gm;
            const float* lf = out + O_LFP + (size_t)b * SEQ * 8 + h;
            float loc[16]; float s = 0.f;
#pragma unroll
            for (int i = 0; i < 16; ++i) { loc[i] = lf[(size_t)(tid * 16 + i) * 8]; s += loc[i]; }
            const float inc = wave_incl_scan(s);
            if (lane == 63) red[wave] = inc;
            __syncthreads();
            float base = inc - s; for (int w2 = 0; w2 < wave; ++w2) base += red[w2];
            const float MB = fmaxf(red[16], red[17]) * 11.313708498984761f * LOG2E;
            float run = base;
#pragma unroll
            for (int i = 0; i < 16; ++i) { run += loc[i]; const int t = tid * 16 + i; const float cl = run * LOG2E;
                unsigned short a, bb, c; split3(-cl, a, bb, c);
                u32x4 w0 = {(unsigned)a | ((unsigned)bb << 16), (unsigned)c | (0x3F80u << 16), 0x3F803F80u, 0u}; const u32x4 z = {0u, 0u, 0u, 0u};
                u32x4* kx = (u32x4*)(CLK + ((size_t)bh * SEQ + t) * 16); kx[0] = w0; kx[1] = z;
                split3(cl - MB, a, bb, c);
                u32x4 w1 = {0x3F803F80u, 0x3F80u | ((unsigned)a << 16), (unsigned)bb | ((unsigned)c << 16), 0u};
                u32x4* qx = (u32x4*)(CLQ + ((size_t)bh * SEQ + t) * 16); qx[0] = w1; qx[1] = z;
                ((float*)(ws + WS_SMALL + SM_CLF))[(size_t)bh * SEQ + t] = cl; }
            if (tid == 0) ((float*)(ws + WS_SMALL + SM_CLF))[16 * SEQ] = 2.f * MB + 37.f;
            __syncthreads();
          }
          if (fi >= 0) { const int lane = opaque_tid(wave) & 63; LAS float* scr = (LAS float*)(lds + wave * 16384);
              constexpr int I_GLU = 16 * 32, I_OUT = 32 * 64, I_UP = 32 * 256;
              for (int it = fi * 8 + wave; it < I_GLU + I_OUT + I_UP; it += nfree * 8) { int r = it;
                  if (r < I_GLU) { p0_transpose_item(IN(18), 1024, 1024, 32, nullptr, nullptr, Wglu_t, scr, r, lane); continue; } r -= I_GLU;
                  if (r < I_OUT) { p0_transpose_item(IN(23), DM, DM, 64, IN(21), IN(22), Wout_t, scr, r, lane); continue; } r -= I_OUT;
                  p0_transpose_item(IN(25), DFF, DM, 256, IN(24), nullptr, Wup_t, scr, r, lane); } } }
    }
    GRID_SYNC();

    for (int rep_ = 0; rep_ < REPS(4); ++rep_) { if (rep_) GRID_SYNC();
        PHASE_PTRS
        const int tid = opaque_tid(wave), lane = tid & 63;
        {
            const int nb = bx >> 7, oc = (bx >> 4) & 7, seg = bx & 15, g = oc * 8 + wave, ng = nb * 64 + g;
            const int r32 = lane & 31, hi = lane >> 5, p = r32 + 32 * hi;
            const float a_re = ABAR[(g * 64 + p) * 2], a_im = ABAR[(g * 64 + p) * 2 + 1];
            bf16x8 bm[4], cm[4];
#pragma unroll
            for (int b = 0; b < 4; ++b) bm[b] = *(const bf16x8*)(BMT + ((size_t)g * 128 + 32 * b + r32) * 16 + 8 * hi);
#pragma unroll
            for (int kk = 0; kk < 4; ++kk) cm[kk] = *(const bf16x8*)(CMT + ((size_t)g * 16 + (lane & 15)) * 128 + 32 * kk + 8 * (lane >> 4));
            const float dsk = IN(17)[g * 16 + (lane & 15)];
            LAS unsigned char* Hs = lds + wave * 8704;
            LAS unsigned char* STG = lds + 8 * 8704 + wave * 4096;
            float* EX = (float*)(ws + WS_SMALL + SM_S5EX) + (size_t)ng * (16 * 128); unsigned* xcnt = (unsigned*)(ws + 40960) + (nb * 8 + oc);
            const int tokb = nb * SEQ + seg * 512;
            const bf16x8 dfrag = s5_dfrag(dsk, lane);
            float h_re = 0.f, h_im = 0.f;
            { S5Frag F = s5_load<false>(U, tokb, g, lane);
#pragma unroll 1
              for (int blk = 0; blk < 16; ++blk) { const S5Frag Fn = s5_load<false>(U, tokb + 32 * (blk < 15 ? blk + 1 : blk), g, lane);
                  s5_scan32<false>(F, nullptr, Hs, 0, tokb + 32 * blk, g, a_re, a_im, bm, cm, dfrag, Hs, h_re, h_im, lane); F = Fn; } }
            __hip_atomic_store(EX + (seg * 64 + p) * 2, h_re, __ATOMIC_RELAXED, __HIP_MEMORY_SCOPE_AGENT); __hip_atomic_store(EX + (seg * 64 + p) * 2 + 1, h_im, __ATOMIC_RELAXED, __HIP_MEMORY_SCOPE_AGENT);
            asm volatile("s_waitcnt vmcnt(0)" ::: "memory");
            __syncthreads();
            if (tid == 0) { __builtin_amdgcn_fence(__ATOMIC_RELEASE, "agent"); asm volatile("s_waitcnt vmcnt(0)" ::: "memory"); __hip_atomic_fetch_add(xcnt, 1u, __ATOMIC_RELAXED, __HIP_MEMORY_SCOPE_AGENT); }
            { const int n = nb * 16 + seg;
              float s_re = st_re[((size_t)n * 64 + g) * 64 + p], s_im = st_im[((size_t)n * 64 + g) * 64 + p];
              const S5Frag F = s5_load<true>(U, MP + n * 32, g, lane);
              s5_scan32<true, true>(F, GY, STG, 0, MP + n * 32, g, a_re, a_im, bm, cm, dfrag, Hs, s_re, s_im, lane);
              out[O_HRS + ((size_t)n * 64 + g) * 64 + p] = s_re; out[O_HIS + ((size_t)n * 64 + g) * 64 + p] = s_im;
              s5_flush(STG, GY, MP + n * 32, 32, g, lane); }
            if (tid == 0) { unsigned sp = 0; while (__hip_atomic_load(xcnt, __ATOMIC_RELAXED, __HIP_MEMORY_SCOPE_AGENT) < 16u) { __builtin_amdgcn_s_sleep(2); if (++sp > (1u << 22)) break; }
                __builtin_amdgcn_fence(__ATOMIC_ACQUIRE, "agent"); asm volatile("s_waitcnt vmcnt(0)" ::: "memory"); }
            __syncthreads();
            const float pw_re = APOW[(g * 64 + p) * 2], pw_im = APOW[(g * 64 + p) * 2 + 1];
            h_re = 0.f; h_im = 0.f;
            { float er[15], ei[15];
#pragma unroll
              for (int s2 = 0; s2 < 15; ++s2) { er[s2] = 0.f; ei[s2] = 0.f;
                  if (s2 < seg) { er[s2] = __hip_atomic_load(EX + (s2 * 64 + p) * 2, __ATOMIC_RELAXED, __HIP_MEMORY_SCOPE_AGENT); ei[s2] = __hip_atomic_load(EX + (s2 * 64 + p) * 2 + 1, __ATOMIC_RELAXED, __HIP_MEMORY_SCOPE_AGENT); } }
#pragma unroll
              for (int s2 = 0; s2 < 15; ++s2) if (s2 < seg) { const float nre = pw_re * h_re - pw_im * h_im + er[s2], nim = pw_re * h_im + pw_im * h_re + ei[s2]; h_re = nre; h_im = nim; } }
            { S5Frag F = s5_load<true>(U, tokb, g, lane);
#pragma unroll 1
              for (int ob = 0; ob < 4; ++ob) {
#pragma unroll 1
                for (int ib = 0; ib < 4; ++ib) { const int blk = ob * 4 + ib; const S5Frag Fn = s5_load<true>(U, tokb + 32 * (blk < 15 ? blk + 1 : blk), g, lane);
                  s5_scan32<true, PSTAGE>(F, GY, STG, ib * 32, tokb + 32 * blk, g, a_re, a_im, bm, cm, dfrag, Hs, h_re, h_im, lane); F = Fn; }
                if (PSTAGE) s5_flush(STG, GY, tokb + 128 * ob, 128, g, lane); } }
            if (seg == 15) { out[O_HRP + (size_t)(nb * 64 + g) * 64 + p] = h_re; out[O_HIP + (size_t)(nb * 64 + g) * 64 + p] = h_im; }
        }
    }
    GRID_SYNC();

    if (PHMASK & 8) {
        PHASE_PTRS
        const int tid = opaque_tid(wave), lane = tid & 63;
        for (int rep_ = 0; rep_ < REPS(256); ++rep_) { if (rep_) GRID_SYNC(); pg8::Gemm g{GY, Wglu_t, MT, 1024, 1024, 1024}; pg8::StaticOrder S; S.init(MT, 1024, G, bx);
          EpiGlu E{GY, MIX, SSQ1};
          pg8::gemm_phase<EpiGlu, pg8::StaticOrder>(lds, g, S, E, wave); }
        __syncthreads();
#pragma unroll 1
        for (int st_ = 0; st_ < 3; ++st_) {
        const int role_ = (bx & 1) ? (st_ == 0 ? 1 : st_ == 1 ? 0 : 2) : st_;
        if (role_ == 0) {
        for (int rep_ = 0; rep_ < REPS(512); ++rep_) for (int item = bx; item < DB * NH; item += G) {
            const int n = item >> 3, h = item & 7;
            const int tid = opaque_tid(wave), lane = tid & 63;
            const int r32 = lane & 31, hi = lane >> 5;
            LAS float* CLs = (LAS float*)(lds + AUX_OFF);
            LAS float* red = CLs + 2096;
            { const float* lfc = cache_logf + ((size_t)n * PAST) * 8 + h;
              float loc[4]; float s = 0.f;
#pragma unroll
              for (int i = 0; i < 4; ++i) { loc[i] = lfc[(size_t)(tid * 4 + i) * 8]; s += loc[i]; }
              const float inc = wave_incl_scan(s);
              float gm = 0.f; if (tid < 128) gm = fabsf(IN(19)[tid] * IN(20)[tid]);
              gm = wave_max(gm);
              if (lane == 63) red[wave] = inc;
              if (lane == 0) red[16 + wave] = gm;
              __syncthreads();
              float base = inc - s; float tot = 0.f;
              for (int w2 = 0; w2 < 8; ++w2) { const float rv = red[w2]; if (w2 < wave) base += rv; tot += rv; }
              float run = base;
#pragma unroll
              for (int i = 0; i < 4; ++i) { run += loc[i]; CLs[tid * 4 + i] = run * LOG2E; }
              if (wave == 0) { float v = (lane < 32) ? out[O_LFS + (size_t)(n * 32 + lane) * 8 + h] : 0.f;
                  v = wave_incl_scan(v);
                  if (lane < 32) CLs[2048 + lane] = (tot + v) * LOG2E; }
              __syncthreads(); }
            const float MB = fmaxf(red[16], red[17]) * 11.313708498984761f * LOG2E;
            int kb_lo;
            { const float thr = 2.f * MB + 37.f; const float ce = CLs[lane * 32 + 31];
              kb_lo = __builtin_amdgcn_readfirstlane(wave_min_i((CLs[2048] - ce >= -thr) ? lane : 64)); }
            const fox::srd_t sK = fox::mksrd(cache_k, (unsigned)DB * PAST * NH * HD * 4u), sV = fox::mksrd(cache_v, (unsigned)DB * PAST * NH * HD * 4u);
            const fox::srd_t sQh = fox::mksrd(Qh, 34u * 1048576u), sKh = fox::mksrd(Kh, 34u * 1048576u), sVh = fox::mksrd(Vh, 34u * 1048576u);
            const unsigned onew = (unsigned)(2 * NH * SEQ * HD + (n * NH + h) * DSEQ * HD) * 2u;
            bf16x8 qf[8];
#pragma unroll
            for (int d0 = 0; d0 < 8; ++d0) qf[d0] = fox::bload8(sQh, (unsigned)((r32 * HD + 64 * hi + 8 * d0) * 2), onew);
            bf16x8 qx;
            { unsigned short a, bb, c; split3(CLs[2048 + r32] - MB, a, bb, c);
              u32x4 w = {0x3F803F80u, 0x3F80u | ((unsigned)a << 16), (unsigned)bb | ((unsigned)c << 16), 0u}; if (hi) w = (u32x4){0u, 0u, 0u, 0u};
              qx = __builtin_bit_cast(bf16x8, w); }
            f32x16 o[4] = {}; float l_reg = 0.f;
            const unsigned vok = (unsigned)(r32 * (NH * HD * 4) + hi * 256), vov = (unsigned)(hi * 4 * (NH * HD * 4) + r32 * 4);
            const unsigned vokn = (unsigned)((r32 * HD + 64 * hi) * 2), vovn = (unsigned)((hi * 4 * HD + r32) * 2);
#pragma unroll 1
            for (int kb = kb_lo + wave; kb < 65; kb += 8) {
                unsigned vok_ = vok, vokn_ = vokn, vovn_ = vovn, vqv = (unsigned)hi * (NH * HD * 4) + (unsigned)r32 * 16u;
                asm volatile("" : "+v"(vok_), "+v"(vokn_), "+v"(vovn_), "+v"(vqv));
                f32x16 sc = {};
                bf16x8 kx;
                { unsigned short a, bb, c; const float clk = CLs[kb * 32 + r32]; split3(-clk, a, bb, c);
                  u32x4 w = {(unsigned)a | ((unsigned)bb << 16), (unsigned)c | (0x3F80u << 16), 0x3F803F80u, 0u}; if (hi) w = (u32x4){0u, 0u, 0u, 0u};
                  kx = __builtin_bit_cast(bf16x8, w); }
                const unsigned sob = (unsigned)(((n * PAST + kb * 32) * NH + h) * HD) * 4u;
                if (kb < 64) {
                    bf16x8 kf8[8];
                    { f32x4 kr[8][2];
#pragma unroll
                      for (int d0 = 0; d0 < 8; ++d0) {
                          kr[d0][0] = __builtin_bit_cast(f32x4, __builtin_amdgcn_raw_buffer_load_b128(sK, (int)(vok_ + d0 * 32), (int)sob, 0));
                          kr[d0][1] = __builtin_bit_cast(f32x4, __builtin_amdgcn_raw_buffer_load_b128(sK, (int)(vok_ + d0 * 32 + 16), (int)sob, 0)); }
                      asm volatile("" : "+v"(kr[0][0]), "+v"(kr[0][1]), "+v"(kr[1][0]), "+v"(kr[1][1]), "+v"(kr[2][0]), "+v"(kr[2][1]), "+v"(kr[3][0]), "+v"(kr[3][1]),
                                        "+v"(kr[4][0]), "+v"(kr[4][1]), "+v"(kr[5][0]), "+v"(kr[5][1]), "+v"(kr[6][0]), "+v"(kr[6][1]), "+v"(kr[7][0]), "+v"(kr[7][1]));
#pragma unroll
                      for (int d0 = 0; d0 < 8; ++d0) kf8[d0] = pack8(kr[d0][0], kr[d0][1]); }
#pragma unroll
                    for (int d0 = 0; d0 < 8; ++d0) sc = __builtin_amdgcn_mfma_f32_32x32x16_bf16(kf8[d0], qf[d0], sc, 0, 0, 0);
                    asm volatile("s_nop 15\n\ts_nop 15" :: "v"(kf8[0]), "v"(kf8[1]), "v"(kf8[2]), "v"(kf8[3]), "v"(kf8[4]), "v"(kf8[5]), "v"(kf8[6]), "v"(kf8[7]));
                } else {
                    { bf16x8 kn8[8];
#pragma unroll
                      for (int d0 = 0; d0 < 8; ++d0) kn8[d0] = fox::bload8(sKh, vokn_ + d0 * 16, onew);
                      asm volatile("" : "+v"(kn8[0]), "+v"(kn8[1]), "+v"(kn8[2]), "+v"(kn8[3]), "+v"(kn8[4]), "+v"(kn8[5]), "+v"(kn8[6]), "+v"(kn8[7]));
#pragma unroll
                      for (int d0 = 0; d0 < 8; ++d0) sc = __builtin_amdgcn_mfma_f32_32x32x16_bf16(kn8[d0], qf[d0], sc, 0, 0, 0);
                      asm volatile("s_nop 15\n\ts_nop 15" :: "v"(kn8[0]), "v"(kn8[1]), "v"(kn8[2]), "v"(kn8[3]), "v"(kn8[4]), "v"(kn8[5]), "v"(kn8[6]), "v"(kn8[7])); }
                }
                sc = __builtin_amdgcn_mfma_f32_32x32x16_bf16(kx, qx, sc, 0, 0, 0);
                if (kb == 64) {
#pragma unroll
                    for (int r = 0; r < 16; ++r) if (fox::crow(r, hi) > r32) sc[r] = -__builtin_inff();
                }
                float ps = 0.f;
#pragma unroll
                for (int r = 0; r < 16; ++r) { sc[r] = __builtin_amdgcn_exp2f(sc[r]); ps += sc[r]; }
                l_reg += ps;
                bf16x8 pa[2];
#pragma unroll
                for (int ks = 0; ks < 2; ++ks) { u32x4 w = {cvtpk(sc[8 * ks + 0], sc[8 * ks + 1]), cvtpk(sc[8 * ks + 2], sc[8 * ks + 3]), cvtpk(sc[8 * ks + 4], sc[8 * ks + 5]), cvtpk(sc[8 * ks + 6], sc[8 * ks + 7])};
                    pa[ks] = __builtin_bit_cast(bf16x8, w); }
                if (kb < 64) {
                    unsigned vta = (unsigned)(uintptr_t)lds + (unsigned)wave * 4224u + (unsigned)hi * 264u + (unsigned)r32 * 8u; asm volatile("" : "+v"(vta));
                    unsigned vra = (unsigned)(uintptr_t)lds + (unsigned)wave * 4224u + (unsigned)hi * (4u * 264u) + (unsigned)r32 * 2u; asm volatile("" : "+v"(vra));
                    LAS unsigned char* vtp = (LAS unsigned char*)(uintptr_t)vta; const LAS unsigned char* vrp = (const LAS unsigned char*)(uintptr_t)vra;
#pragma unroll
                    for (int ks = 0; ks < 2; ++ks) {
                        asm volatile("s_waitcnt lgkmcnt(0)" ::: "memory");
#pragma unroll
                        for (int qv = 0; qv < 2; ++qv) { f32x4 va[4];
#pragma unroll
                            for (int i = 0; i < 4; ++i) va[i] = __builtin_bit_cast(f32x4, __builtin_amdgcn_raw_buffer_load_b128(sV, (int)vqv, (int)(sob + (16 * ks + 8 * qv + 2 * i) * (NH * HD * 4)), 0));
                            asm volatile("" : "+v"(va[0]), "+v"(va[1]), "+v"(va[2]), "+v"(va[3]));
#pragma unroll
                            for (int i = 0; i < 4; ++i) { u32x2 w2; w2.x = cvtpk(va[i][0], va[i][1]); w2.y = cvtpk(va[i][2], va[i][3]); *(LAS u32x2*)(vtp + (8 * qv + 2 * i) * 264) = w2; } }
                        asm volatile("s_waitcnt lgkmcnt(0)" ::: "memory");
                        bf16x8 vw[4];
#pragma unroll
                        for (int d0 = 0; d0 < 4; ++d0) { u32x4 w;
#pragma unroll
                            for (int jj = 0; jj < 4; ++jj) { const int klo = 8 * (jj >> 1) + 2 * (jj & 1);
                                const unsigned lo16 = *(const LAS unsigned short*)(vrp + klo * 264 + d0 * 64), hi16 = *(const LAS unsigned short*)(vrp + (klo + 1) * 264 + d0 * 64);
                                w[jj] = lo16 | (hi16 << 16); }
                            vw[d0] = __builtin_bit_cast(bf16x8, w); }
                        asm volatile("" : "+v"(vw[0]), "+v"(vw[1]), "+v"(vw[2]), "+v"(vw[3]));
#pragma unroll
                        for (int d0 = 0; d0 < 4; ++d0) o[d0] = __builtin_amdgcn_mfma_f32_32x32x16_bf16(pa[ks], vw[d0], o[d0], 0, 0, 0);
                        asm volatile("s_nop 15\n\ts_nop 15" : "+v"(o[3]) : "v"(vw[0]), "v"(vw[1]), "v"(vw[2]), "v"(vw[3]), "v"(pa[ks]));
                    }
                } else {
                    unsigned vna = (unsigned)(uintptr_t)lds + (unsigned)wave * 4224u + (unsigned)(lane >> 4) * 264u + (unsigned)(lane & 15) * 16u; asm volatile("" : "+v"(vna));
                    unsigned vra = (unsigned)(uintptr_t)lds + (unsigned)wave * 4224u + (unsigned)hi * (4u * 264u) + (unsigned)r32 * 2u; asm volatile("" : "+v"(vra));
                    unsigned vnq = (unsigned)(lane >> 4) * 256u + (unsigned)(lane & 15) * 16u; asm volatile("" : "+v"(vnq));
                    LAS unsigned char* vnp = (LAS unsigned char*)(uintptr_t)vna; const LAS unsigned char* vrp = (const LAS unsigned char*)(uintptr_t)vra;
#pragma unroll
                    for (int ks = 0; ks < 2; ++ks) {
                        u32x4 vn4[4];
#pragma unroll
                        for (int i = 0; i < 4; ++i) vn4[i] = __builtin_amdgcn_raw_buffer_load_b128(sVh, (int)vnq, (int)(onew + (16 * ks + 4 * i) * (HD * 2)), 0);
                        asm volatile("" : "+v"(vn4[0]), "+v"(vn4[1]), "+v"(vn4[2]), "+v"(vn4[3]));
                        asm volatile("s_waitcnt lgkmcnt(0)" ::: "memory");
#pragma unroll
                        for (int i = 0; i < 4; ++i) { *(LAS u32x2*)(vnp + (4 * i) * 264) = (u32x2){vn4[i][0], vn4[i][1]}; *(LAS u32x2*)(vnp + (4 * i) * 264 + 8) = (u32x2){vn4[i][2], vn4[i][3]}; }
                        asm volatile("s_waitcnt lgkmcnt(0)" ::: "memory");
                        bf16x8 vw[4];
#pragma unroll
                        for (int d0 = 0; d0 < 4; ++d0) { u32x4 w;
#pragma unroll
                            for (int jj = 0; jj < 4; ++jj) { const int klo = 8 * (jj >> 1) + 2 * (jj & 1);
                                const unsigned lo16 = *(const LAS unsigned short*)(vrp + klo * 264 + d0 * 64), hi16 = *(const LAS unsigned short*)(vrp + (klo + 1) * 264 + d0 * 64);
                                w[jj] = lo16 | (hi16 << 16); }
                            vw[d0] = __builtin_bit_cast(bf16x8, w); }
                        asm volatile("" : "+v"(vw[0]), "+v"(vw[1]), "+v"(vw[2]), "+v"(vw[3]));
#pragma unroll
                        for (int d0 = 0; d0 < 4; ++d0) o[d0] = __builtin_amdgcn_mfma_f32_32x32x16_bf16(pa[ks], vw[d0], o[d0], 0, 0, 0);
                        asm volatile("s_nop 15\n\ts_nop 15" : "+v"(o[3]) : "v"(vw[0]), "v"(vw[1]), "v"(vw[2]), "v"(vw[3]), "v"(pa[ks]));
                    }
                }
                asm volatile("s_nop 15\n\ts_nop 15" : "+v"(o[3]));
            }
            __syncthreads();
            { const int tid = opaque_tid(wave), lane = tid & 63, r32 = lane & 31, hi = lane >> 5;
            LAS float* R = (LAS float*)lds;
#pragma unroll
            for (int d0 = 0; d0 < 4; ++d0)
#pragma unroll
                for (int r = 0; r < 16; ++r) R[(wave * 64 + d0 * 16 + r) * 64 + lane] = o[d0][r];
            red[32 + wave * 64 + lane] = l_reg;
            __syncthreads();
            float lt = 0.f;
#pragma unroll
            for (int w2 = 0; w2 < 8; ++w2) lt += red[32 + w2 * 64 + lane];
            { auto rr = __builtin_amdgcn_permlane32_swap(__float_as_uint(lt), __float_as_uint(lt), false, false); lt = __uint_as_float(rr[0]) + __uint_as_float(rr[1]); }
            float acc8[8];
#pragma unroll
            for (int k = 0; k < 8; ++k) { float a = 0.f;
#pragma unroll
                for (int w2 = 0; w2 < 8; ++w2) a += R[(w2 * 64 + wave * 8 + k) * 64 + lane];
                acc8[k] = a; }
            __syncthreads();
            LAS float* Of = (LAS float*)lds; LAS float* Lq = Of + 32 * 128;
            if (wave == 0 && hi == 0) Lq[r32] = lt;
            __syncthreads();
#pragma unroll
            for (int k = 0; k < 8; ++k) { const int r = 8 * (wave & 1) + k, q = fox::crow(r, hi); Of[q * 128 + (wave >> 1) * 32 + r32] = acc8[k] * __builtin_amdgcn_rcpf(Lq[q]); }
            __syncthreads();
            { const int q = wave * 4 + (lane >> 4), c8 = (lane & 15) * 8; const f32x4 a0 = *(const LAS f32x4*)(Of + q * 128 + c8), a1 = *(const LAS f32x4*)(Of + q * 128 + c8 + 4);
              float sq = (a0[0] * a0[0] + a0[1] * a0[1]) + (a0[2] * a0[2] + a0[3] * a0[3]) + (a1[0] * a1[0] + a1[1] * a1[1]) + (a1[2] * a1[2] + a1[3] * a1[3]);
              sq += lane_xor<1>(sq); sq += lane_xor<2>(sq); sq += lane_xor<4>(sq); sq += lane_xor<8>(sq);
              const size_t tok = (size_t)MP + n * 32 + q;
              *(bf16x8*)(MIX + tok * DM + 1024 + h * HD + c8) = pack8(a0, a1);
              if ((lane & 15) == 0) SSQ2[tok * 8 + h] = sq; }
            }
            __syncthreads();
        }
        } else {
        for (int rep_ = 0; rep_ < REPS(1024); ++rep_) for (int Lw = bx; Lw < 256; Lw += G) {
            const int L = (Lw & 7) * 32 + (Lw >> 3); const int bh = L >> 4, x = L & 15, qb_ = role_ == 1 ? x : 31 - x;
            const fox::Ctx FC{fox::mksrd(ws, (unsigned)WS_TOTAL), ws};
            fox::Seam Sm;
            const int lane_p = opaque_tid(wave) & 63; const int jl_ = fox::tile_lo(FC, bh, qb_, lane_p);
            fox::prime(FC, bh, qb_, jl_, (LAS char*)lds, Sm, wave);
            fox::block(FC, bh, qb_, jl_, qb_, jl_, (LAS char*)lds, Sm, wave);
            fox::finish(Sm);
        }
        }
        }
    }
    GRID_SYNC();

    for (int rep_ = 0; rep_ < REPS(16); ++rep_) { if (rep_) GRID_SYNC();
        PHASE_PTRS
        const int tid = opaque_tid(wave), lane = tid & 63;
        const bool tailfill = (G == 256);
        unsigned* cntS = (unsigned*)(ws + 32768 + 512);
        LAS float* RT = (LAS float*)(lds + AUX_OFF);
#define P4_RT(i_, pm_) do { if (tid < 256) { const int row = (pm_) * 256 + tid; float a = 0.f, c = 0.f; \
              _Pragma("unroll") for (int k = 0; k < 16; ++k) a += SSQ1[(size_t)row * 16 + k]; \
              _Pragma("unroll") for (int k = 0; k < 8; ++k) c += SSQ2[(size_t)row * 8 + k]; \
              const float rA = 1.0f / sqrtf(a * (1.0f / 1024.f) + EPS), rB = 1.0f / sqrtf(c * (1.0f / 1024.f) + EPS); \
              RT[((i_) * 256 + tid) * 2] = rA / rB; RT[((i_) * 256 + tid) * 2 + 1] = rB; } } while (0)
        const pg8::Gemm g{MIX, Wout_t, MT, DM, DM, DM};
        if (tailfill) {
            const pg8::OneUnit S1{64 + (bx >> 3), bx & 7, bx < 32};
            if (bx < 32) { P4_RT(0, S1.pm); }
            __syncthreads();
            { EpiOut E{XB, out, X1B, SSQ3, RT}; pg8::gemm_phase<EpiOut, pg8::OneUnit>(lds, g, S1, E, wave); }
            if (bx < 32) slab_done(cntS);
            __syncthreads();
        }
        { pg8::StaticOrder S; S.init(tailfill ? MP : MT, DM, G, bx);
          { pg8::Unit u; for (int i = 0; S.next(i, u); ++i) P4_RT(i, u.pm); }
          __syncthreads();
          EpiOut E{XB, out, X1B, SSQ3, RT};
          pg8::gemm_phase<EpiOut, pg8::StaticOrder>(lds, g, S, E, wave); }
#undef P4_RT
        if (tailfill && bx >= 32 && bx < 160) {
            slab_wait(cntS, 32u);
            const int j = bx - 32; const pg8::OneUnit S2{64 + (j >> 5), j & 31, true};
            LAS float* RT2 = (LAS float*)(lds + AUX_OFF);
            if (tid < 256) { const int row = S2.pm * 256 + tid; float a = 0.f;
#pragma unroll
                for (int k = 0; k < 32; ++k) a += SSQ3[(size_t)row * 32 + k];
                RT2[tid] = 1.0f / sqrtf(a * (1.0f / DM) + EPS); }
            __syncthreads();
            const pg8::Gemm g2{X1B, Wup_t, MT, DFF, DM, DM}; EpiUp E2{Hb, RT2};
            pg8::gemm_phase<EpiUp, pg8::OneUnit>(lds, g2, S2, E2, wave);
        }
        { const int fi = tailfill ? bx - 160 : bx, nfree = tailfill ? 96 : G;
          if (fi >= 0) { const int lane2 = opaque_tid(wave) & 63; LAS float* scr = (LAS float*)(lds + wave * 16384);
              for (int it = fi * 8 + wave; it < 128 * 64; it += nfree * 8) p0_transpose_item(IN(26), DM, DFF, 64, nullptr, nullptr, Wdn_t, scr, it, lane2); } }
    }
    GRID_SYNC();

    for (int rep_ = 0; rep_ < REPS(32); ++rep_) { if (rep_) GRID_SYNC();
        PHASE_PTRS
        const int tid = opaque_tid(wave), lane = tid & 63;
        pg8::StaticOrder S; S.init(G == 256 ? MP : MT, DFF, G, bx);
        LAS float* RT = (LAS float*)(lds + AUX_OFF);
        if (G == 256) {
            const int rowl = tid & 255, hf = wave >> 2; pg8::Unit u; f32x4 sv[4][8];
#pragma unroll
            for (int j = 0; j < 4; ++j) { S.next(2 * j + hf, u); const float* p = SSQ3 + (size_t)(u.pm * 256 + rowl) * 32;
#pragma unroll
                for (int q = 0; q < 8; ++q) sv[j][q] = *(const f32x4*)(p + 4 * q); }
#pragma unroll
            for (int j = 0; j < 4; ++j) asm volatile("" : "+v"(sv[j][0]), "+v"(sv[j][1]), "+v"(sv[j][2]), "+v"(sv[j][3]), "+v"(sv[j][4]), "+v"(sv[j][5]), "+v"(sv[j][6]), "+v"(sv[j][7]));
#pragma unroll
            for (int j = 0; j < 4; ++j) { f32x4 t = sv[j][0];
#pragma unroll
                for (int q = 1; q < 8; ++q) t += sv[j][q];
                RT[(2 * j + hf) * 256 + rowl] = 1.0f / sqrtf(((t[0] + t[1]) + (t[2] + t[3])) * (1.0f / DM) + EPS); }
        } else { pg8::Unit u;
          for (int i = 0; S.next(i, u); ++i) if (tid < 256) { const int row = u.pm * 256 + tid; float a = 0.f;
#pragma unroll
              for (int k = 0; k < 32; ++k) a += SSQ3[(size_t)row * 32 + k];
              RT[i * 256 + tid] = 1.0f / sqrtf(a * (1.0f / DM) + EPS); } }
        __syncthreads();
        pg8::Gemm g{X1B, Wup_t, MT, DFF, DM, DM};
        EpiUp E{Hb, RT};
        pg8::gemm_phase<EpiUp, pg8::StaticOrder>(lds, g, S, E, wave);
    }
    GRID_SYNC();

    if (PHMASK & 64) {
        PHASE_PTRS
        float* SL = (float*)(ws + WS_QKRAW); unsigned* slab_cnt = (unsigned*)(ws + 32768);
        const bool split = (G == 256);
        if (split) { pg8::Gemm g{Hb, Wdn_t, MT, DM, DFF / 8, DFF}; pg8::SplitOrder S{bx, DFF / 8}; EpiDownSlab E{SL, DFF / 8};
            pg8::gemm_phase<EpiDownSlab, pg8::SplitOrder>(lds, g, S, E, wave);
            if (threadIdx.x == 0) { __builtin_amdgcn_fence(__ATOMIC_RELEASE, "agent"); asm volatile("s_waitcnt vmcnt(0)" ::: "memory");
                __hip_atomic_fetch_add(slab_cnt, 1u, __ATOMIC_RELAXED, __HIP_MEMORY_SCOPE_AGENT); } }
        { pg8::Gemm g{Hb, Wdn_t, MT, DM, DFF, DFF}; pg8::StaticOrder S; S.init(split ? MP : MT, DM, G, bx);
          EpiDown E{out, X1B};
          pg8::gemm_phase<EpiDown, pg8::StaticOrder>(lds, g, S, E, wave); }
        if (split) {
            if (threadIdx.x == 0) { unsigned sp = 0; while (__hip_atomic_load(slab_cnt, __ATOMIC_RELAXED, __HIP_MEMORY_SCOPE_AGENT) < 256u) { __builtin_amdgcn_s_sleep(2); if (++sp > (1u << 22)) break; }
                __builtin_amdgcn_fence(__ATOMIC_ACQUIRE, "agent"); asm volatile("s_waitcnt vmcnt(0)" ::: "memory"); }
            __syncthreads();
            const int tid = opaque_tid(wave); const int r = 4 * bx + (tid >> 7);
            u32x2 xw[4]; f32x4 sv[4][8];
#pragma unroll
            for (int j = 0; j < 4; ++j) { const int c = (tid & 127) * 4 + 512 * j; xw[j] = *(const u32x2*)(X1B + (size_t)(MP + r) * DM + c);
#pragma unroll
                for (int s = 0; s < 8; ++s) sv[j][s] = *(const f32x4*)(SL + (size_t)s * (MS * DM) + (size_t)r * DM + c); }
#pragma unroll
            for (int j = 0; j < 4; ++j)
                asm volatile("" : "+v"(xw[j]), "+v"(sv[j][0]), "+v"(sv[j][1]), "+v"(sv[j][2]), "+v"(sv[j][3]), "+v"(sv[j][4]), "+v"(sv[j][5]), "+v"(sv[j][6]), "+v"(sv[j][7]));
#pragma unroll
            for (int j = 0; j < 4; ++j) { const int c = (tid & 127) * 4 + 512 * j; float* yp = out + O_Y + (size_t)(MP + r) * DM + c;
                f32x4 y; y[0] = __builtin_bit_cast(float, xw[j].x << 16); y[1] = __builtin_bit_cast(float, xw[j].x & 0xffff0000u); y[2] = __builtin_bit_cast(float, xw[j].y << 16); y[3] = __builtin_bit_cast(float, xw[j].y & 0xffff0000u);
#pragma unroll
                for (int s = 0; s < 8; ++s) y += sv[j][s];
                *(f32x4*)yp = y; }
        }
    }
}

extern "C" void kernel_launch(void* const* d_in, const int* in_sizes, int n_in, void* d_out, int out_size, void* d_ws, size_t ws_size, hipStream_t stream) {
    static int grid = 0;
    if (grid == 0) {
        if (n_in != 27 || ws_size < WS_TOTAL) { fprintf(stderr, "kernel_launch: unexpected n_in %d / ws_size %zu (need %zu)\n", n_in, ws_size, (size_t)WS_TOTAL); grid = -1; return; }
        int dev = 0, cus = 0, per_cu = 0;
        hipGetDevice(&dev);
        hipDeviceGetAttribute(&cus, hipDeviceAttributeMultiprocessorCount, dev);
        hipFuncSetAttribute((const void*)hymba_fwd, hipFuncAttributeMaxDynamicSharedMemorySize, LDS_BYTES);
        hipOccupancyMaxActiveBlocksPerMultiprocessor(&per_cu, (const void*)hymba_fwd, 512, LDS_BYTES);
        if (per_cu < 1) { fprintf(stderr, "kernel_launch: occupancy query says %d blocks per CU\n", per_cu); per_cu = 1; }
        if (per_cu > 1) per_cu = 1;
        grid = cus * per_cu;
        if (grid != 256) { fprintf(stderr, "kernel_launch: this kernel's work decomposition is written for 256 workgroups (one per CU of a 256-CU device); got %d; nothing launched\n", grid); grid = -1; return; }
        fprintf(stderr, "kernel_launch: grid %d (cus %d), ws %zu\n", grid, cus, ws_size);
    }
    if (grid < 0) return;
    if (hipMemsetAsync(d_ws, 0, 65536, stream) != hipSuccess) { fprintf(stderr, "kernel_launch: hipMemsetAsync failed\n"); return; }
    Args a{};
    for (int i = 0; i < 27; ++i) a.in[i] = (const float*)d_in[i];
    a.out = (float*)d_out; a.ws = (unsigned char*)d_ws;
    void* kargs[] = {&a};
    hipError_t e = hipLaunchCooperativeKernel((const void*)hymba_fwd, dim3(grid), dim3(512), kargs, LDS_BYTES, stream);
    if (e != hipSuccess) fprintf(stderr, "kernel_launch: cooperative launch failed: %s (grid %d)\n", hipGetErrorString(e), grid);
}
```

```cpp
#include <hip/hip_runtime.h>
#include <hip/hip_cooperative_groups.h>
#include <cstdio>
#include <cstdint>
namespace cg = cooperative_groups;
#ifndef PHMASK
#define PHMASK 2047
#endif
#ifndef DBL
#define DBL 0
#endif
#define REPS(bit) (((DBL) & (bit)) ? 2 : 1)

#define LAS __attribute__((address_space(3)))
typedef unsigned short bf16;
typedef short bf16x8 __attribute__((ext_vector_type(8)));
typedef short s16x4 __attribute__((ext_vector_type(4)));
typedef float f32x4 __attribute__((ext_vector_type(4)));
typedef float f32x16 __attribute__((ext_vector_type(16)));
typedef unsigned u32x4 __attribute__((ext_vector_type(4)));
typedef unsigned u32x2 __attribute__((ext_vector_type(2)));

constexpr int DM = 2048, MP = 16384, MS = 1024, MT = MP + MS, SEQ = 8192, NH = 8, HD = 128, DSSM = 1024, DATT = 1024, DFF = 8192;
constexpr int NINW = 4104, PAST = 2048, DSEQ = 32, DB = 32, NG = 64, NP = 64;
constexpr float EPS = 1e-6f;
constexpr float LOG2E = 1.4426950408889634f;
constexpr float QSCALE = 0.08838834764831845f * 1.4426950408889634f;

constexpr size_t O_Y = 0, O_KP = 35651584, O_VP = 52428800, O_LFP = 69206016, O_HRP = 69337088, O_HIP = 69345280,
                 O_KS = 69353472, O_VS = 70402048, O_LFS = 71450624, O_HRS = 71458816, O_HIS = 71589888;

constexpr size_t MiB = 1u << 20;
constexpr size_t WS_WIN = 1 * MiB;
constexpr size_t WS_WGLU = 17 * MiB;
constexpr size_t WS_WOUT = 19 * MiB;
constexpr size_t WS_WUP = 27 * MiB;
constexpr size_t WS_WDN = 59 * MiB;
constexpr size_t WS_SMALL = 91 * MiB;
constexpr size_t WS_XB = 96 * MiB;
constexpr size_t WS_U = 164 * MiB;
constexpr size_t WS_QKRAW = 198 * MiB;
constexpr size_t WS_QH = 334 * MiB;
constexpr size_t WS_KH = 368 * MiB;
constexpr size_t WS_VH = 402 * MiB;
constexpr size_t WS_GY = 436 * MiB;
constexpr size_t WS_MIX = 470 * MiB;
constexpr size_t WS_X1B = 538 * MiB;
constexpr size_t WS_H = 606 * MiB;
constexpr size_t WS_END = 878 * MiB;
constexpr size_t SM_RS1 = 0;
constexpr size_t SM_ABAR = 128 * 1024;
constexpr size_t SM_APOW = 192 * 1024;
constexpr size_t SM_CLF = 4 * MiB;
constexpr size_t SM_S5EX = 3 * MiB;
constexpr size_t SM_BMT = 256 * 1024;
constexpr size_t SM_CMT = 512 * 1024;
constexpr size_t SM_SSQ1 = 1 * MiB;
constexpr size_t SM_SSQ2 = 2 * MiB + 256 * 1024;
constexpr size_t SM_SSQ3 = 3 * MiB;
constexpr size_t WS_CLK = 878 * MiB;
constexpr size_t WS_CLQ = 882 * MiB;
constexpr size_t WS_SSQ3 = 886 * MiB;
constexpr size_t WS_TOTAL = 890 * MiB;

constexpr int RING_BYTES = 131072, AUX_OFF = 131072, AUX_BYTES = 32768, LDS_BYTES = 163840;

__device__ __forceinline__ int opaque_tid(int wave) { int t = (wave << 6) | (int)__builtin_amdgcn_mbcnt_hi(~0u, __builtin_amdgcn_mbcnt_lo(~0u, 0u)); asm volatile("" : "+v"(t)); return t; }
__device__ __forceinline__ unsigned f2bf(float f) { unsigned u = __builtin_bit_cast(unsigned, f); return (u + 0x7fffu + ((u >> 16) & 1u)) >> 16; }
__device__ __forceinline__ float bf2f(unsigned short b) { return __builtin_bit_cast(float, (unsigned)b << 16); }
__device__ __forceinline__ unsigned pk2(float lo, float hi) { return f2bf(lo) | (f2bf(hi) << 16); }
__device__ __forceinline__ unsigned cvtpk(float lo, float hi) { unsigned r; asm volatile("v_cvt_pk_bf16_f32 %0, %1, %2" : "=v"(r) : "v"(lo), "v"(hi)); return r; }
__device__ __forceinline__ unsigned cvtpk_nv(float lo, float hi) { unsigned r; asm("v_cvt_pk_bf16_f32 %0, %1, %2" : "=v"(r) : "v"(lo), "v"(hi)); return r; }
__device__ __forceinline__ bf16x8 pack8(f32x4 a, f32x4 b) { u32x4 w = {cvtpk(a[0], a[1]), cvtpk(a[2], a[3]), cvtpk(b[0], b[1]), cvtpk(b[2], b[3])}; return __builtin_bit_cast(bf16x8, w); }
__device__ __forceinline__ void st16_wt(void* p, u32x4 v) { asm volatile("global_store_dwordx4 %0, %1, off sc1\n\ts_nop 1" :: "v"(p), "v"(v) : "memory"); }
template <int K> __device__ __forceinline__ float lane_xor(float v) {
    return __builtin_bit_cast(float, __builtin_amdgcn_ds_swizzle(__builtin_bit_cast(int, v), (K << 10) | 0x1f));
}
__device__ __forceinline__ float half_swap_add(float v) { auto rr = __builtin_amdgcn_permlane32_swap(__float_as_uint(v), __float_as_uint(v), false, false); return __uint_as_float(rr[0]) + __uint_as_float(rr[1]); }
__device__ __forceinline__ float half_swap_max(float v) { auto rr = __builtin_amdgcn_permlane32_swap(__float_as_uint(v), __float_as_uint(v), false, false); return fmaxf(__uint_as_float(rr[0]), __uint_as_float(rr[1])); }
__device__ __forceinline__ float sum32(float v) { v += lane_xor<1>(v); v += lane_xor<2>(v); v += lane_xor<4>(v); v += lane_xor<8>(v); v += lane_xor<16>(v); return v; }
__device__ __forceinline__ float max32(float v) { v = fmaxf(v, lane_xor<1>(v)); v = fmaxf(v, lane_xor<2>(v)); v = fmaxf(v, lane_xor<4>(v)); v = fmaxf(v, lane_xor<8>(v)); v = fmaxf(v, lane_xor<16>(v)); return v; }
__device__ __forceinline__ float wave_sum(float v) { return half_swap_add(sum32(v)); }
__device__ __forceinline__ float wave_max(float v) { return half_swap_max(max32(v)); }
__device__ __forceinline__ int wave_min_i(int v) {
#define SWZI(K) v = min(v, __builtin_amdgcn_ds_swizzle(v, ((K) << 10) | 0x1f))
    SWZI(1); SWZI(2); SWZI(4); SWZI(8); SWZI(16);
#undef SWZI
    auto rr = __builtin_amdgcn_permlane32_swap((unsigned)v, (unsigned)v, false, false); return min((int)rr[0], (int)rr[1]);
}
__device__ __forceinline__ float wave_incl_scan(float v) {
#define DPPADD(ctrl, rmask) v += __builtin_bit_cast(float, __builtin_amdgcn_update_dpp(0, __builtin_bit_cast(int, v), ctrl, rmask, 0xf, false))
    DPPADD(0x111, 0xf); DPPADD(0x112, 0xf); DPPADD(0x114, 0xf); DPPADD(0x118, 0xf); DPPADD(0x142, 0xa); DPPADD(0x143, 0xc);
#undef DPPADD
    return v;
}
__device__ __forceinline__ float gelu_tanh(float y) {
    const float t = 0.7978845608028654f * (y + 0.044715f * y * y * y);
    const float e = __builtin_amdgcn_exp2f(-2.0f * LOG2E * fabsf(t));
    float th = (1.0f - e) * __builtin_amdgcn_rcpf(1.0f + e); th = t < 0.f ? -th : th;
    return 0.5f * y * (1.0f + th);
}
__device__ __forceinline__ float sigmoidf_(float x) { return __builtin_amdgcn_rcpf(1.0f + __builtin_amdgcn_exp2f(-LOG2E * x)); }
__device__ __forceinline__ float log_sigmoidf_(float z) { return fminf(z, 0.f) - log1pf(expf(-fabsf(z))); }

namespace pg8 {
#define PG8_LAS __attribute__((address_space(3)))
typedef unsigned short bf16_t;
constexpr int BM = 256, BK = 64, HALF = 128, HTB = HALF * BK * 2, STAGE_BYTES = 8 * HTB, NXCD = 8, WGM = 4;
__host__ __device__ __forceinline__ int lds_byte(int r, int c) { const int st = (r >> 4) * 2 + (c >> 5), rr = r & 15, cc = c & 31, ob = rr * 64 + cc * 2; return st * 1024 + (ob ^ (((ob >> 9) & 1) << 5)); }
__host__ __device__ __forceinline__ void stage_rc(int b, int& R, int& C) { const int st = b / 1024, sb = b % 1024, swz = sb ^ (((sb >> 9) & 1) << 5); R = (st >> 1) * 16 + swz / 64; C = (st & 1) * 32 + (swz % 64) / 2; }
__host__ __device__ __forceinline__ int perm32(int rho) { const int n = rho >> 4, i = rho & 15; return 8 * (i >> 2) + 4 * n + (i & 3); }
struct Unit { int pm, pn, ko; };
struct Gemm { const bf16_t* A; const bf16_t* Bt; int M, N, K, ld; };
struct StaticOrder {
    int nM, nN, nwg, G, c;
    __host__ __device__ __forceinline__ void init(int M, int N, int G_, int c_) { nM = M / BM; nN = N / BM; nwg = nM * nN; G = G_; c = c_; }
    __host__ __device__ __forceinline__ bool next(int i, Unit& u) const {
        const long L = (long)i * G + c; if (L >= nwg) return false;
        int wgid = (int)L; { const int q = nwg / NXCD, r = nwg % NXCD, xcd = wgid % NXCD, off = wgid / NXCD; wgid = (xcd < r ? xcd * (q + 1) : r * (q + 1) + (xcd - r) * q) + off; }
        const int nig = WGM * nN, gid = wgid / nig, fm = gid * WGM, gsz = (nM - fm) < WGM ? (nM - fm) : WGM;
        u.pm = fm + ((wgid % nig) % gsz); u.pn = (wgid % nig) / gsz; u.ko = 0; return true;
    }
};
struct SplitOrder {
    int c, kslice;
    __host__ __device__ __forceinline__ bool next(int i, Unit& u) const { if (i > 0 || c >= 256) return false; u.pm = 64 + (c >> 6); u.pn = (c >> 3) & 7; u.ko = (c & 7) * kslice; return true; }
};
struct OneUnit {
    int pm, pn; bool on;
    __host__ __device__ __forceinline__ bool next(int i, Unit& u) const { if (i > 0 || !on) return false; u.pm = pm; u.pn = pn; u.ko = 0; return true; }
};
template <class Epi, class Sched, bool ALIGN_EPI = true, bool SP2 = true>
__device__ __forceinline__ void gemm_phase(PG8_LAS unsigned char* lds, const Gemm g, const Sched& S, const Epi& E, const int wave) {
    const int tid = opaque_tid(wave), wid = wave, lane = tid & 63, wr = wid >> 2, wc = wid & 3, fr = lane & 15, fq = lane >> 4;
    const int K = g.K, nt = K / BK;
    unsigned voffA[2], voffB[2];
#pragma unroll
    for (int i = 0; i < 2; ++i) { int R, C; stage_rc(tid * 16 + i * 8192, R, C); const int Rb = Epi::PERM ? ((R & ~31) + perm32(R & 31)) : R;
        voffA[i] = (unsigned)(R * g.ld + C) * 2u; voffB[i] = (unsigned)(Rb * g.ld + C) * 2u; }
    const size_t kstep = (size_t)(BK * 2);
    const size_t hstep = (size_t)HALF * g.ld * 2;
    const size_t tstep = 2 * hstep;
    const unsigned ldsw = (unsigned)wid * 1024u;
    const int aoff = lds_byte(wr * 64 + fr, fq * 8), boff = lds_byte(wc * 32 + fr, fq * 8);
#define PG8_SA(b, h) (((b) * 2 + (h)) * HTB)
#define PG8_SB(b, h) ((4 + (b) * 2 + (h)) * HTB)
#define PG8_STAGE(bufoff, gbase, voff) do { _Pragma("unroll") for (int _i = 0; _i < 2; ++_i) \
        __builtin_amdgcn_global_load_lds((const unsigned*)((const char*)(gbase) + (voff)[_i]), (PG8_LAS unsigned*)(lds + (bufoff) + ldsw + _i * 8192), 16, 0, 0); } while (0)
#define PG8_LDA(dst, b, h) do { _Pragma("unroll") for (int m = 0; m < 4; ++m) _Pragma("unroll") for (int k = 0; k < 2; ++k) dst[m][k] = *(const PG8_LAS bf16x8*)(lds + PG8_SA(b, h) + aoff + m * 2048 + k * 1024); } while (0)
#define PG8_LDB(dst, b, h) do { _Pragma("unroll") for (int n = 0; n < 2; ++n) _Pragma("unroll") for (int k = 0; k < 2; ++k) dst[n][k] = *(const PG8_LAS bf16x8*)(lds + PG8_SB(b, h) + boff + n * 2048 + k * 1024); } while (0)
#define PG8_MMA(ai, bj, At, Bt) do { __builtin_amdgcn_s_setprio(1); _Pragma("unroll") for (int m = 0; m < 4; ++m) _Pragma("unroll") for (int n = 0; n < 2; ++n) _Pragma("unroll") for (int k = 0; k < 2; ++k) \
        acc[ai][bj][m][n] = __builtin_amdgcn_mfma_f32_16x16x32_bf16(Bt[n][k], At[m][k], acc[ai][bj][m][n], 0, 0, 0); __builtin_amdgcn_s_setprio(0); } while (0)
#define PG8_WAIT_V(n) asm volatile("s_waitcnt vmcnt(" #n ")" ::: "memory")
#define PG8_WAIT_L(n) asm volatile("s_waitcnt lgkmcnt(" #n ")" ::: "memory")
#define PG8_BAR __builtin_amdgcn_s_barrier()
#define PG8_SCHED __builtin_amdgcn_sched_barrier(0)
    Unit cur, nxt; int ui = 0;
    if (!S.next(0, cur)) return;
    f32x4 acc[2][2][4][2];
#pragma unroll
    for (int a = 0; a < 2; ++a)
#pragma unroll
        for (int b = 0; b < 2; ++b)
#pragma unroll
            for (int m = 0; m < 4; ++m)
#pragma unroll
                for (int n = 0; n < 2; ++n) acc[a][b][m][n] = (f32x4){0.f, 0.f, 0.f, 0.f};
    bf16x8 At[4][2], B0[2][2], B1[2][2];
    const char* cA = (const char*)g.A + (size_t)cur.pm * tstep + (size_t)cur.ko * 2; const char* cB = (const char*)g.Bt + (size_t)cur.pn * tstep + (size_t)cur.ko * 2;
    {
        PG8_STAGE(PG8_SB(0, 0), cB, voffB); PG8_STAGE(PG8_SB(0, 1), cB + hstep, voffB); PG8_STAGE(PG8_SA(0, 0), cA, voffA); PG8_STAGE(PG8_SA(0, 1), cA + hstep, voffA);
        if (wr == 1) PG8_BAR;
        PG8_WAIT_V(2); PG8_BAR;
        PG8_STAGE(PG8_SB(1, 0), cB + kstep, voffB); PG8_STAGE(PG8_SA(1, 0), cA + kstep, voffA); PG8_STAGE(PG8_SB(1, 1), cB + hstep + kstep, voffB);
        PG8_WAIT_V(6); PG8_BAR;
    }
    for (;;) {
        const bool has_next = S.next(ui + 1, nxt);
        const char* nA = has_next ? (const char*)g.A + (size_t)nxt.pm * tstep + (size_t)nxt.ko * 2 : cA; const char* nB = has_next ? (const char*)g.Bt + (size_t)nxt.pn * tstep + (size_t)nxt.ko * 2 : cB;
        for (int t = 0; t < nt; t += 2) {
            const bool last = (t == nt - 2);
            const char* a1 = cA + (size_t)(t + 1) * kstep;
            const char* a2 = last ? nA : cA + (size_t)(t + 2) * kstep; const char* b2 = last ? nB : cB + (size_t)(t + 2) * kstep;
            const char* a3 = a2 + kstep; const char* b3 = b2 + kstep;
            if constexpr (Epi::HAS_MID) { if (t == (nt >> 1)) E.mid(acc, ui, wr, fr); }
            PG8_LDB(B0, 0, 0); PG8_LDB(B1, 0, 1); PG8_SCHED; PG8_LDA(At, 0, 0); PG8_STAGE(PG8_SA(1, 1), a1 + hstep, voffA);
            PG8_WAIT_V(8); PG8_WAIT_L(0); PG8_BAR; PG8_MMA(0, 0, At, B0); PG8_MMA(0, 1, At, B1); PG8_BAR; PG8_SCHED;
            PG8_LDA(At, 0, 1); PG8_STAGE(PG8_SB(0, 0), b2, voffB); PG8_STAGE(PG8_SB(0, 1), b2 + hstep, voffB); PG8_STAGE(PG8_SA(0, 0), a2, voffA);
            PG8_WAIT_V(8); PG8_WAIT_L(0); PG8_BAR; PG8_MMA(1, 0, At, B0); PG8_MMA(1, 1, At, B1); PG8_BAR; PG8_SCHED;
            PG8_LDB(B0, 1, 0); PG8_LDB(B1, 1, 1); PG8_SCHED; PG8_LDA(At, 1, 0); PG8_STAGE(PG8_SA(0, 1), a2 + hstep, voffA);
            PG8_WAIT_V(8); PG8_WAIT_L(0); PG8_BAR; PG8_MMA(0, 0, At, B0); PG8_MMA(0, 1, At, B1); PG8_BAR; PG8_SCHED;
            PG8_LDA(At, 1, 1); PG8_STAGE(PG8_SB(1, 0), b3, voffB); PG8_STAGE(PG8_SB(1, 1), b3 + hstep, voffB); PG8_STAGE(PG8_SA(1, 0), a3, voffA);
            PG8_WAIT_V(8); PG8_WAIT_L(0); PG8_BAR; PG8_MMA(1, 0, At, B0); PG8_MMA(1, 1, At, B1); PG8_BAR; PG8_SCHED;
        }
        if constexpr (ALIGN_EPI) { if (wr == 0) PG8_BAR; }
        E(acc, cur, ui, wr, wc, fr, fq);
        if (!has_next) break;
#pragma unroll
        for (int a = 0; a < 2; ++a)
#pragma unroll
            for (int b = 0; b < 2; ++b)
#pragma unroll
                for (int m = 0; m < 4; ++m)
#pragma unroll
                    for (int n = 0; n < 2; ++n) acc[a][b][m][n] = (f32x4){0.f, 0.f, 0.f, 0.f};
        cur = nxt; cA = nA; cB = nB; ++ui;
        if constexpr (ALIGN_EPI) { if (wr == 1) PG8_BAR; }
    }
    PG8_WAIT_V(0);
    if constexpr (!ALIGN_EPI) { if (wr == 0) PG8_BAR; }
    PG8_BAR;
#undef PG8_SA
#undef PG8_SB
#undef PG8_STAGE
#undef PG8_LDA
#undef PG8_LDB
#undef PG8_MMA
#undef PG8_WAIT_V
#undef PG8_WAIT_L
#undef PG8_BAR
#undef PG8_SCHED
}
}

struct Args {
    const float* in[27];
    float* out;
    unsigned char* ws;
};

__device__ __forceinline__ size_t headmajor_off_u(bool smp, int m, int h) {
    if (!smp) { const int b = m >> 13, t = m & 8191; return ((size_t)(b * NH + h) * SEQ + t) * HD; }
    const int ms = m - MP, n = ms >> 5, i = ms & 31; return (size_t)2 * NH * SEQ * HD + ((size_t)(n * NH + h) * DSEQ + i) * HD;
}
__device__ __forceinline__ size_t headmajor_off(int m, int h) {
    if (m < MP) { const int b = m >> 13, t = m & 8191; return ((size_t)(b * NH + h) * SEQ + t) * HD; }
    const int ms = m - MP, n = ms >> 5, i = ms & 31; return (size_t)2 * NH * SEQ * HD + ((size_t)(n * NH + h) * DSEQ + i) * HD;
}

struct EpiIn {
    static constexpr bool PERM = true, HAS_MID = false;
    const float* rs1; bf16* U; float* out; bf16* Qh; bf16* Kh; bf16* Vh; const float* gq; const float* gk; LAS float* RED;
    __device__ __forceinline__ void operator()(const f32x4 (&acc)[2][2][4][2], const pg8::Unit& u, int ui, int wr, int wc, int fr, int fq) const {
        asm volatile("" : "+v"(fr), "+v"(fq));
        const int row0 = u.pm * 256 + wr * 64 + fr, colb = u.pn * 256 + wc * 32 + 8 * fq;
        const bool smp = u.pm >= MP / 256;
        float* outv = out + (u.pm < MP / 256 ? (size_t)O_VP : (size_t)O_VS - (size_t)MP * 1024); float* outk = out + (u.pm < MP / 256 ? (size_t)O_KP : (size_t)O_KS - (size_t)MP * 1024);
        float rsv[2][4];
#pragma unroll
        for (int ai = 0; ai < 2; ++ai)
#pragma unroll
            for (int m = 0; m < 4; ++m) rsv[ai][m] = rs1[row0 + ai * 128 + m * 16];
        asm volatile("" : "+v"(rsv[0][0]), "+v"(rsv[0][1]), "+v"(rsv[0][2]), "+v"(rsv[0][3]), "+v"(rsv[1][0]), "+v"(rsv[1][1]), "+v"(rsv[1][2]), "+v"(rsv[1][3]));
        if (u.pn < 4 || u.pn >= 12) {
#pragma unroll
            for (int ai = 0; ai < 2; ++ai)
#pragma unroll
                for (int m = 0; m < 4; ++m) {
                    const int row = row0 + ai * 128 + m * 16; const float rs = rsv[ai][m];
#pragma unroll
                    for (int bj = 0; bj < 2; ++bj) {
                        const int col = colb + bj * 128; const f32x4 v0 = acc[ai][bj][m][0] * rs, v1 = acc[ai][bj][m][1] * rs;
                        if (u.pn < 4) { *(bf16x8*)(U + (size_t)row * DSSM + col) = pack8(v0, v1); }
                        else { const int c = col - 3072, h = c >> 7, d = c & 127;
                            float* p = outv + (size_t)row * 1024 + c; *(f32x4*)p = v0; *(f32x4*)(p + 4) = v1;
                            *(bf16x8*)(Vh + headmajor_off_u(smp, row, h) + d) = pack8(v0, v1); }
                    }
                }
        } else {
#pragma unroll
            for (int ai = 0; ai < 2; ++ai)
#pragma unroll
                for (int m = 0; m < 4; ++m)
#pragma unroll
                    for (int bj = 0; bj < 2; ++bj) { const f32x4 a = acc[ai][bj][m][0], b = acc[ai][bj][m][1];
                        float s = (a[0] * a[0] + a[1] * a[1]) + (a[2] * a[2] + a[3] * a[3]) + (b[0] * b[0] + b[1] * b[1]) + (b[2] * b[2] + b[3] * b[3]);
                        s += lane_xor<16>(s); s = half_swap_add(s);
                        if (fq == 0) RED[((ai * 128 + wr * 64 + m * 16 + fr) * 2 + bj) * 4 + wc] = s; }
            asm volatile("s_waitcnt lgkmcnt(0)" ::: "memory"); __builtin_amdgcn_s_barrier(); asm volatile("" ::: "memory");
            const bool isq = u.pn < 8; const float* g = isq ? gq : gk; const int hb = ((u.pn - (isq ? 4 : 8)) * 2);
            const f32x4 g0 = *(const f32x4*)(g + wc * 32 + 8 * fq), g1 = *(const f32x4*)(g + wc * 32 + 8 * fq + 4);
#pragma unroll
            for (int ai = 0; ai < 2; ++ai)
#pragma unroll
                for (int m = 0; m < 4; ++m) {
                    const int rl = ai * 128 + wr * 64 + m * 16 + fr, row = u.pm * 256 + rl; const float rs = rsv[ai][m];
#pragma unroll
                    for (int bj = 0; bj < 2; ++bj) {
                        const f32x4 t = *(const LAS f32x4*)(RED + (rl * 2 + bj) * 4); const float tot = ((t[0] + t[1]) + (t[2] + t[3])) * rs * rs;
                        const float rn = rs * __builtin_amdgcn_rsqf(tot * (1.0f / HD) + EPS);
                        const int h = hb + bj, d = wc * 32 + 8 * fq;
                        f32x4 v0 = acc[ai][bj][m][0] * rn * g0, v1 = acc[ai][bj][m][1] * rn * g1;
                        if (isq) { v0 = v0 * QSCALE; v1 = v1 * QSCALE; *(bf16x8*)(Qh + headmajor_off_u(smp, row, h) + d) = pack8(v0, v1); }
                        else { float* p = outk + (size_t)row * 1024 + h * HD + d; *(f32x4*)p = v0; *(f32x4*)(p + 4) = v1;
                            *(bf16x8*)(Kh + headmajor_off_u(smp, row, h) + d) = pack8(v0, v1); }
                    }
                }
        }
    }
};
struct EpiGlu {
    static constexpr bool PERM = true, HAS_MID = false;
    const bf16* GY; bf16* MIX; float* SSQ1;
    __device__ __forceinline__ void operator()(const f32x4 (&acc)[2][2][4][2], const pg8::Unit& u, int ui, int wr, int wc, int fr, int fq) const {
        asm volatile("" : "+v"(fr), "+v"(fq));
        const int row0 = u.pm * 256 + wr * 64 + fr, colb = u.pn * 256 + wc * 32 + 8 * fq;
        bf16x8 gvv[2][4][2];
#pragma unroll
        for (int ai = 0; ai < 2; ++ai)
#pragma unroll
            for (int m = 0; m < 4; ++m)
#pragma unroll
                for (int bj = 0; bj < 2; ++bj) gvv[ai][m][bj] = *(const bf16x8*)(GY + (size_t)(row0 + ai * 128 + m * 16) * DSSM + colb + bj * 128);
        asm volatile("" : "+v"(gvv[0][0][0]), "+v"(gvv[0][0][1]), "+v"(gvv[0][1][0]), "+v"(gvv[0][1][1]), "+v"(gvv[0][2][0]), "+v"(gvv[0][2][1]), "+v"(gvv[0][3][0]), "+v"(gvv[0][3][1]),
                          "+v"(gvv[1][0][0]), "+v"(gvv[1][0][1]), "+v"(gvv[1][1][0]), "+v"(gvv[1][1][1]), "+v"(gvv[1][2][0]), "+v"(gvv[1][2][1]), "+v"(gvv[1][3][0]), "+v"(gvv[1][3][1]));
#pragma unroll
        for (int ai = 0; ai < 2; ++ai)
#pragma unroll
            for (int m = 0; m < 4; ++m) {
                const int row = row0 + ai * 128 + m * 16; float ssq = 0.f;
#pragma unroll
                for (int bj = 0; bj < 2; ++bj) {
                    const int col = colb + bj * 128; const bf16x8 gv = gvv[ai][m][bj];
                    f32x4 o0, o1;
#pragma unroll
                    for (int e = 0; e < 4; ++e) { o0[e] = bf2f((unsigned short)gv[e]) * sigmoidf_(acc[ai][bj][m][0][e]); o1[e] = bf2f((unsigned short)gv[4 + e]) * sigmoidf_(acc[ai][bj][m][1][e]);
                        ssq += o0[e] * o0[e] + o1[e] * o1[e]; }
                    *(bf16x8*)(MIX + (size_t)row * DM + col) = pack8(o0, o1);
                }
                ssq += lane_xor<16>(ssq); ssq = half_swap_add(ssq);
                if (fq == 0) SSQ1[(size_t)row * 16 + u.pn * 4 + wc] = ssq;
            }
    }
};
struct EpiOut {
    static constexpr bool PERM = true, HAS_MID = true;
    const bf16* XBr; float* out; bf16* X1B; float* SSQ3; const LAS float* RT;
    __device__ __forceinline__ void mid(f32x4 (&acc)[2][2][4][2], int ui, int wr, int fr) const {
        asm volatile("" : "+v"(fr));
#pragma unroll
        for (int ai = 0; ai < 2; ++ai)
#pragma unroll
            for (int m = 0; m < 4; ++m) { const float r = RT[(ui * 256 + ai * 128 + wr * 64 + m * 16 + fr) * 2];
#pragma unroll
                for (int bj = 0; bj < 2; ++bj)
#pragma unroll
                    for (int n = 0; n < 2; ++n) acc[ai][bj][m][n] *= r; }
    }
    __device__ __forceinline__ void operator()(const f32x4 (&acc)[2][2][4][2], const pg8::Unit& u, int ui, int wr, int wc, int fr, int fq) const {
        asm volatile("" : "+v"(fr), "+v"(fq));
        const int col0 = u.pn * 256 + wc * 32 + 8 * fq;
        u32x4 xv[2][4][2];
#pragma unroll
        for (int ai = 0; ai < 2; ++ai)
#pragma unroll
            for (int m = 0; m < 4; ++m) { const bf16* xrow = XBr + (size_t)(u.pm * 256 + ai * 128 + wr * 64 + m * 16 + fr) * DM;
#pragma unroll
                for (int bj = 0; bj < 2; ++bj) xv[ai][m][bj] = *(const u32x4*)(xrow + col0 + bj * 128); }
        asm volatile("" : "+v"(xv[0][0][0]), "+v"(xv[0][0][1]), "+v"(xv[0][1][0]), "+v"(xv[0][1][1]), "+v"(xv[0][2][0]), "+v"(xv[0][2][1]), "+v"(xv[0][3][0]), "+v"(xv[0][3][1]),
                          "+v"(xv[1][0][0]), "+v"(xv[1][0][1]), "+v"(xv[1][1][0]), "+v"(xv[1][1][1]), "+v"(xv[1][2][0]), "+v"(xv[1][2][1]), "+v"(xv[1][3][0]), "+v"(xv[1][3][1]));
#pragma unroll
        for (int ai = 0; ai < 2; ++ai) { float ssel = 0.f;
#pragma unroll
            for (int m = 0; m < 4; ++m) {
                const int rl = ai * 128 + wr * 64 + m * 16 + fr, row = u.pm * 256 + rl; const float rB = RT[(ui * 256 + rl) * 2 + 1];
                float ssq = 0.f;
#pragma unroll
                for (int bj = 0; bj < 2; ++bj) { const u32x4 xw = xv[ai][m][bj]; u32x4 w;
#pragma unroll
                    for (int n = 0; n < 2; ++n) { const unsigned w0 = xw[2 * n], w1 = xw[2 * n + 1];
                        f32x4 xf; xf[0] = __builtin_bit_cast(float, w0 << 16); xf[1] = __builtin_bit_cast(float, w0 & 0xffff0000u); xf[2] = __builtin_bit_cast(float, w1 << 16); xf[3] = __builtin_bit_cast(float, w1 & 0xffff0000u);
                        const f32x4 x1 = xf + acc[ai][bj][m][n] * rB;
                        w[2 * n] = cvtpk(x1[0], x1[1]); w[2 * n + 1] = cvtpk(x1[2], x1[3]);
                        ssq += (x1[0] * x1[0] + x1[1] * x1[1]) + (x1[2] * x1[2] + x1[3] * x1[3]); }
                    *(u32x4*)(X1B + (size_t)row * DM + col0 + bj * 128) = w; }
                ssq += lane_xor<16>(ssq); ssq = half_swap_add(ssq);
                ssel = (fq == m) ? ssq : ssel;
            }
            SSQ3[(size_t)(u.pm * 256 + ai * 128 + wr * 64 + fq * 16 + fr) * 32 + u.pn * 4 + wc] = ssel; }
    }
};
struct EpiUp {
    static constexpr bool PERM = true, HAS_MID = false;
    bf16* H; const LAS float* RT;
    __device__ __forceinline__ void operator()(const f32x4 (&acc)[2][2][4][2], const pg8::Unit& u, int ui, int wr, int wc, int fr, int fq) const {
        asm volatile("" : "+v"(fr), "+v"(fq));
        const int colb = u.pn * 256 + wc * 32 + 8 * fq;
#pragma unroll
        for (int ai = 0; ai < 2; ++ai)
#pragma unroll
            for (int m = 0; m < 4; ++m) {
                const int rl = ai * 128 + wr * 64 + m * 16 + fr, row = u.pm * 256 + rl; const float rs = RT[ui * 256 + rl];
#pragma unroll
                for (int bj = 0; bj < 2; ++bj) { f32x4 v0 = acc[ai][bj][m][0] * rs, v1 = acc[ai][bj][m][1] * rs;
#pragma unroll
                    for (int e = 0; e < 4; ++e) { const float a = fmaxf(v0[e], 0.f), b = fmaxf(v1[e], 0.f); v0[e] = a * a; v1[e] = b * b; }
                    st16_wt(H + (size_t)row * DFF + colb + bj * 128, __builtin_bit_cast(u32x4, pack8(v0, v1))); }
            }
    }
};
struct EpiDown {
    static constexpr bool PERM = false, HAS_MID = false;
    float* out; const bf16* X1B;
    __device__ __forceinline__ void operator()(const f32x4 (&acc)[2][2][4][2], const pg8::Unit& u, int ui, int wr, int wc, int fr, int fq) const {
        asm volatile("" : "+v"(fr), "+v"(fq));
        const int row0 = u.pm * 256 + wr * 64 + fr, col0 = u.pn * 256 + wc * 32 + 4 * fq;
        u32x2 wv[2][4][2][2];
#pragma unroll
        for (int ai = 0; ai < 2; ++ai)
#pragma unroll
            for (int m = 0; m < 4; ++m)
#pragma unroll
                for (int bj = 0; bj < 2; ++bj)
#pragma unroll
                    for (int n = 0; n < 2; ++n) wv[ai][m][bj][n] = *(const u32x2*)(X1B + (size_t)(row0 + ai * 128 + m * 16) * DM + col0 + bj * 128 + n * 16);
#pragma unroll
        for (int ai = 0; ai < 2; ++ai)
            asm volatile("" : "+v"(wv[ai][0][0][0]), "+v"(wv[ai][0][0][1]), "+v"(wv[ai][0][1][0]), "+v"(wv[ai][0][1][1]), "+v"(wv[ai][1][0][0]), "+v"(wv[ai][1][0][1]), "+v"(wv[ai][1][1][0]), "+v"(wv[ai][1][1][1]),
                              "+v"(wv[ai][2][0][0]), "+v"(wv[ai][2][0][1]), "+v"(wv[ai][2][1][0]), "+v"(wv[ai][2][1][1]), "+v"(wv[ai][3][0][0]), "+v"(wv[ai][3][0][1]), "+v"(wv[ai][3][1][0]), "+v"(wv[ai][3][1][1]));
#pragma unroll
        for (int ai = 0; ai < 2; ++ai)
#pragma unroll
            for (int m = 0; m < 4; ++m) { const size_t ro = (size_t)(row0 + ai * 128 + m * 16) * DM + col0;
#pragma unroll
                for (int bj = 0; bj < 2; ++bj)
#pragma unroll
                    for (int n = 0; n < 2; ++n) { const size_t o = ro + bj * 128 + n * 16; const u32x2 w = wv[ai][m][bj][n];
                        f32x4 x1; x1[0] = __builtin_bit_cast(float, w.x << 16); x1[1] = __builtin_bit_cast(float, w.x & 0xffff0000u); x1[2] = __builtin_bit_cast(float, w.y << 16); x1[3] = __builtin_bit_cast(float, w.y & 0xffff0000u);
                        *(f32x4*)(out + O_Y + o) = x1 + acc[ai][bj][m][n]; } }
    }
};
struct EpiDownSlab {
    static constexpr bool PERM = false, HAS_MID = false;
    float* SL; int kslice;
    __device__ __forceinline__ void operator()(const f32x4 (&acc)[2][2][4][2], const pg8::Unit& u, int ui, int wr, int wc, int fr, int fq) const {
        asm volatile("" : "+v"(fr), "+v"(fq));
        const int row0 = (u.pm - 64) * 256 + wr * 64 + fr, col0 = u.pn * 256 + wc * 32 + 4 * fq;
        float* base = SL + (size_t)(u.ko / kslice) * (MS * DM);
#pragma unroll
        for (int ai = 0; ai < 2; ++ai)
#pragma unroll
            for (int m = 0; m < 4; ++m) { float* rowp = base + (size_t)(row0 + ai * 128 + m * 16) * DM + col0;
#pragma unroll
                for (int bj = 0; bj < 2; ++bj)
#pragma unroll
                    for (int n = 0; n < 2; ++n) *(f32x4*)(rowp + bj * 128 + n * 16) = acc[ai][bj][m][n]; }
    }
};
__device__ __forceinline__ void slab_done(unsigned* cnt) {
    if (threadIdx.x == 0) { __builtin_amdgcn_fence(__ATOMIC_RELEASE, "agent"); asm volatile("s_waitcnt vmcnt(0)" ::: "memory"); __hip_atomic_fetch_add(cnt, 1u, __ATOMIC_RELAXED, __HIP_MEMORY_SCOPE_AGENT); }
}
__device__ __forceinline__ void slab_wait(unsigned* cnt, unsigned need) {
    if (threadIdx.x == 0) { unsigned sp = 0; while (__hip_atomic_load(cnt, __ATOMIC_RELAXED, __HIP_MEMORY_SCOPE_AGENT) < need) { __builtin_amdgcn_s_sleep(2); if (++sp > (1u << 22)) break; }
        __builtin_amdgcn_fence(__ATOMIC_ACQUIRE, "agent"); asm volatile("s_waitcnt vmcnt(0)" ::: "memory"); }
    __syncthreads();
}
__device__ __forceinline__ void p0_transpose_item(const float* W, int ldw, int K, int nblk, const float* g0, const float* g1, bf16* WT, LAS float* scr, int item, int lane) {
    const int kb = item / nblk, nb = item % nblk, k0 = 64 * kb, n0 = 32 * nb;
    f32x4 v[8];
#pragma unroll
    for (int i = 0; i < 8; ++i) { const int k = k0 + 8 * i + (lane >> 3); v[i] = *(const f32x4*)(W + (size_t)k * ldw + n0 + (lane & 7) * 4); }
#pragma unroll
    for (int i = 0; i < 8; ++i) { const int kk = 8 * i + (lane >> 3), k = k0 + kk;
        float gv = 1.f; if (g0) gv = (g1 && k >= 1024) ? g1[k - 1024] : g0[k];
        LAS float* d = scr + kk * 33 + (lane & 7) * 4; d[0] = v[i][0] * gv; d[1] = v[i][1] * gv; d[2] = v[i][2] * gv; d[3] = v[i][3] * gv; }
    asm volatile("s_waitcnt lgkmcnt(0)" ::: "memory");
    const int c = lane & 7;
#pragma unroll
    for (int j = 0; j < 4; ++j) { const int n = (lane >> 3) + 8 * j; const LAS float* s = scr + (8 * c) * 33 + n;
        u32x4 o; o.x = pk2(s[0 * 33], s[1 * 33]); o.y = pk2(s[2 * 33], s[3 * 33]); o.z = pk2(s[4 * 33], s[5 * 33]); o.w = pk2(s[6 * 33], s[7 * 33]);
        *(u32x4*)(WT + (size_t)(n0 + n) * K + k0 + 8 * c) = o; }
    asm volatile("s_waitcnt lgkmcnt(0)" ::: "memory");
}

namespace fox {
constexpr int D = 128, NW = 8, QBLK = 32, KVBLK = 64, QB = 256;
constexpr int SHM_V = 16384, SHM_K = 16384, SHM_X = 2048;
constexpr int QROWB = 144, SHM_Q = 32 * QROWB;
constexpr int NVB = 3;
constexpr int OFF_V = 0, OFF_K = NVB * SHM_V, OFF_X = OFF_K + 2 * SHM_K, OFF_WS = OFF_X + 2 * SHM_X, OFF_Q = OFF_WS + NW * 64 * 4, OFF_QX = OFF_Q + NW * SHM_Q, LDSB = OFF_QX + NW * 1024;
#define KSWZ(row, colB) ((row) * 256 + ((colB) ^ (((row) & 15) << 4)))
#define SBAR() __builtin_amdgcn_sched_barrier(0)
__device__ __forceinline__ int v_st(int k, int c) { const int kk = (k & ~0xC) | ((k & 4) << 1) | ((k & 8) >> 1); return ((kk >> 3) * 4 + (c >> 5)) * 512 + ((kk & 7) * 32 + (c & 31)) * 2; }
__device__ __forceinline__ int v_rd_base(int lane) { return ((lane & 3) << 3) | (((lane >> 2) & 3) << 6) | (((lane >> 4) & 1) << 5) | (((lane >> 5) & 1) << 8); }
constexpr int v_rd_off(int d0, int ks, int half) { return d0 * 512 + ks * 4096 + half * 2048; }
__device__ __forceinline__ int crow(int r, int hi) { return (r & 3) + 8 * (r >> 2) + 4 * hi; }
__device__ __forceinline__ bf16x8 load8(const bf16* p) { return *reinterpret_cast<const bf16x8*>(p); }
__device__ __forceinline__ void mask_tile(f32x16& p0, f32x16& p1, int dq) {
#pragma unroll
    for (int r = 0; r < 16; ++r) { const int c = (r & 3) + 8 * (r >> 2);
        const unsigned m0 = (unsigned)((dq - c) >> 31), m1 = (unsigned)((dq - c - 32) >> 31);
        p0[r] = __uint_as_float((m0 & 0xff800000u) | (~m0 & __float_as_uint(p0[r])));
        p1[r] = __uint_as_float((m1 & 0xff800000u) | (~m1 & __float_as_uint(p1[r]))); }
}
__device__ __forceinline__ void partialSM(f32x16& p0) {
#pragma unroll
    for (int r = 0; r < 16; ++r) p0[r] = __builtin_amdgcn_exp2f(p0[r]);
}
__device__ __forceinline__ void finishSM(f32x16& p0, f32x16& p1, float& l_reg, bf16x8& pa0, bf16x8& pa1, bf16x8& pa2, bf16x8& pa3) {
#pragma unroll
    for (int r = 0; r < 16; ++r) p1[r] = __builtin_amdgcn_exp2f(p1[r]);
    float ps = 0;
#pragma unroll
    for (int r = 0; r < 16; ++r) ps += p0[r];
#pragma unroll
    for (int r = 0; r < 16; ++r) ps += p1[r];
    l_reg += ps;
#define PK4(P, B_, OUT) do { unsigned a0 = cvtpk(P[B_+0], P[B_+1]), a1 = cvtpk(P[B_+2], P[B_+3]);                          \
        unsigned b0 = cvtpk(P[B_+4], P[B_+5]), b1 = cvtpk(P[B_+6], P[B_+7]);                                             \
        auto r0 = __builtin_amdgcn_permlane32_swap(a0, b0, false, false); auto r1 = __builtin_amdgcn_permlane32_swap(a1, b1, false, false); \
        u32x4 w = {r0[0], r1[0], r0[1], r1[1]}; OUT = __builtin_bit_cast(bf16x8, w); } while (0)
    PK4(p0, 0, pa0); PK4(p0, 8, pa1); PK4(p1, 0, pa2); PK4(p1, 8, pa3);
#undef PK4
}
template <int VB>
__device__ __forceinline__ void pv_tile(f32x16* o, int vb0, bf16x8 pa0, bf16x8 pa1, bf16x8 pa2, bf16x8 pa3) {
#define TRRD(dst, off) asm volatile("ds_read_b64_tr_b16 %0, %1 offset:%2" : "=&v"(dst) : "v"(vb0), "i"(off) : "memory")
#define PV_D0(d0) do { s16x4 l0, l1, l2, l3, h0, h1, h2, h3; constexpr int b_ = VB * SHM_V + v_rd_off(d0, 0, 0); \
        TRRD(l0, b_); TRRD(h0, b_ + 2048); TRRD(l1, b_ + 4096); TRRD(h1, b_ + 6144); TRRD(l2, b_ + 8192); TRRD(h2, b_ + 10240); TRRD(l3, b_ + 12288); TRRD(h3, b_ + 14336); \
        asm volatile("s_waitcnt lgkmcnt(0)" ::: "memory"); SBAR();   \
        o[d0] = __builtin_amdgcn_mfma_f32_32x32x16_bf16(pa0, (bf16x8){l0[0], l0[1], l0[2], l0[3], h0[0], h0[1], h0[2], h0[3]}, o[d0], 0, 0, 0);   \
        o[d0] = __builtin_amdgcn_mfma_f32_32x32x16_bf16(pa1, (bf16x8){l1[0], l1[1], l1[2], l1[3], h1[0], h1[1], h1[2], h1[3]}, o[d0], 0, 0, 0);   \
        o[d0] = __builtin_amdgcn_mfma_f32_32x32x16_bf16(pa2, (bf16x8){l2[0], l2[1], l2[2], l2[3], h2[0], h2[1], h2[2], h2[3]}, o[d0], 0, 0, 0);   \
        o[d0] = __builtin_amdgcn_mfma_f32_32x32x16_bf16(pa3, (bf16x8){l3[0], l3[1], l3[2], l3[3], h3[0], h3[1], h3[2], h3[3]}, o[d0], 0, 0, 0); } while (0)
    PV_D0(0); PV_D0(1); PV_D0(2); PV_D0(3);
#undef PV_D0
#undef TRRD
}
typedef __amdgpu_buffer_rsrc_t srd_t;
__device__ __forceinline__ srd_t mksrd(const void* p, unsigned bytes) { return __builtin_amdgcn_make_buffer_rsrc((void*)p, 0, (int)bytes, 0x00020000); }
__device__ __forceinline__ bf16x8 bload8(srd_t r, unsigned voff, unsigned soff) { return __builtin_bit_cast(bf16x8, __builtin_amdgcn_raw_buffer_load_b128(r, (int)voff, (int)soff, 0)); }
struct Ctx { srd_t W; unsigned char* ws; };
struct Seam { bf16x8 qr[8]; bf16x8 qx; };
#define WAITBAR() asm volatile("s_waitcnt vmcnt(0) lgkmcnt(0)\n\ts_barrier" ::: "memory")
#define OKV(bh, t) ((unsigned)(bh) * (SEQ * HD * 2) + (unsigned)(t) * (KVBLK * D * 2))
#define DMA16(dst, voff, soff, imm) __builtin_amdgcn_raw_ptr_buffer_load_lds(C.W, (LAS void*)(dst), 16, (int)(voff), (int)(soff), (imm), 0)
#define DMA_TILE(bh, t, kb, vb) do { const unsigned so_ = OKV(bh, t); \
        DMA16(lds + OFF_K + (kb) * SHM_K + wid * 2048, vok0, (unsigned)WS_KH + so_, 0); DMA16(lds + OFF_K + (kb) * SHM_K + wid * 2048 + 1024, vok1, (unsigned)WS_KH + so_, 0); \
        DMA16(lds + OFF_V + (vb) * SHM_V + wid * 2048, vov, (unsigned)WS_VH + so_, 0);  DMA16(lds + OFF_V + (vb) * SHM_V + wid * 2048 + 1024, vov, (unsigned)WS_VH + so_ + 128u, 0);   \
        if (wid < 2) DMA16(lds + OFF_X + (kb) * SHM_X + wid * 1024, vox, (unsigned)WS_CLK + (unsigned)(bh) * (SEQ * 32) + (unsigned)(t) * (KVBLK * 32), 0); } while (0)
#define DMA_OFFS(tid_) const int lane_ = (tid_) & 63; \
        const int kr0_ = 8 * wid + (lane_ >> 4), kr1_ = kr0_ + 4;                                     \
        const unsigned vok0 = (unsigned)(kr0_ * 256 + (((lane_ & 15) ^ (kr0_ & 15)) << 4)), vok1 = (unsigned)(kr1_ * 256 + (((lane_ & 15) ^ (kr1_ & 15)) << 4)); \
        const int vkk_ = 8 * wid + ((lane_ >> 2) & 7), vk_ = (vkk_ & ~0xC) | ((vkk_ & 4) << 1) | ((vkk_ & 8) >> 1);     \
        const unsigned vov = (unsigned)(vk_ * 256 + ((lane_ >> 5) * 32 + (lane_ & 3) * 8) * 2), vox = (unsigned)(tid_) * 16u
#define QLOAD(bh, qb, R32, HI) do { const unsigned voq_ = (unsigned)(((wid * QBLK + (R32)) * D + (HI) * 8) * 2); const unsigned row0_ = (unsigned)(bh) * SEQ + (unsigned)(qb) * QB; \
    _Pragma("unroll") for (int d0 = 0; d0 < 8; ++d0) S.qr[d0] = bload8(C.W, voq_ + d0 * 32, (unsigned)WS_QH + row0_ * (HD * 2)); \
    S.qx = bload8(C.W, (unsigned)(((wid * QBLK + (R32)) * 16 + (HI) * 8) * 2), (unsigned)WS_CLQ + row0_ * 32); } while (0)
__device__ __forceinline__ int tile_lo(const Ctx& C, int bh, int qb, int lane) {
    const unsigned base = (unsigned)(WS_SMALL + SM_CLF) + (unsigned)bh * (SEQ * 4);
    const float thr = __builtin_bit_cast(float, __builtin_amdgcn_raw_buffer_load_b32(C.W, 0, (int)((unsigned)(WS_SMALL + SM_CLF) + 16u * SEQ * 4u), 0));
    const float cr0 = __builtin_bit_cast(float, __builtin_amdgcn_raw_buffer_load_b32(C.W, 0, (int)(base + (unsigned)qb * (QB * 4)), 0));
    const int NT = 4 * qb + 4; int first = NT - 4;
    for (int j = lane; j < NT - 4; j += 64) { const float ce = __builtin_bit_cast(float, __builtin_amdgcn_raw_buffer_load_b32(C.W, (int)((KVBLK * j + KVBLK - 1) * 4), (int)base, 0));
        if (cr0 - ce >= -thr) first = min(first, j); }
    first = __builtin_amdgcn_readfirstlane(wave_min_i(first));
    return first & ~1;
}
__device__ __forceinline__ void prime(const Ctx& C, int bh, int qb, int jlo, LAS char* lds, Seam& S, const int wave) {
    const int tid = opaque_tid(wave), wid = wave, r32 = tid & 31, hi = (tid >> 5) & 1;
    DMA_OFFS(tid);
    QLOAD(bh, qb, r32, hi);
    DMA_TILE(bh, jlo, 0, 0);
}
template <int KB>
__device__ __forceinline__ void qkt(f32x16& p0, f32x16& p1, LAS const char* lds, int r32, int hi, const bf16x8 (&q4)[4], LAS const char* qb, LAS const char* qxb) {
    p0 = f32x16{}; p1 = f32x16{};
    unsigned kb0 = (unsigned)(uintptr_t)(lds + OFF_K + KB * SHM_K) + (unsigned)KSWZ(r32, hi * 16);
    asm volatile("" : "+v"(kb0));
#pragma unroll
    for (int d0 = 0; d0 < 8; ++d0) { LAS const char* a = (LAS const char*)(uintptr_t)(kb0 ^ (unsigned)(d0 << 5));
        bf16x8 b0 = *reinterpret_cast<LAS const bf16x8*>(a);
        bf16x8 b1 = *reinterpret_cast<LAS const bf16x8*>(a + 32 * 256);
        bf16x8 qf; if (d0 < 4) qf = q4[d0]; else qf = *reinterpret_cast<LAS const bf16x8*>(qb + (d0 - 4) * 32);
        p0 = __builtin_amdgcn_mfma_f32_32x32x16_bf16(b0, qf, p0, 0, 0, 0);
        p1 = __builtin_amdgcn_mfma_f32_32x32x16_bf16(b1, qf, p1, 0, 0, 0); }
    { LAS const char* xa = lds + OFF_X + KB * SHM_X + r32 * 32 + hi * 16;
        bf16x8 x0 = *reinterpret_cast<LAS const bf16x8*>(xa); bf16x8 x1 = *reinterpret_cast<LAS const bf16x8*>(xa + 32 * 32);
        const bf16x8 qx = *reinterpret_cast<LAS const bf16x8*>(qxb);
        p0 = __builtin_amdgcn_mfma_f32_32x32x16_bf16(x0, qx, p0, 0, 0, 0);
        p1 = __builtin_amdgcn_mfma_f32_32x32x16_bf16(x1, qx, p1, 0, 0, 0); }
}
__device__ __forceinline__ void block(const Ctx& C, int bh, int qb_cur, int jlo, int qb_nxt, int jlo_nxt, LAS char* lds, Seam& S, const int wave) {
    const int tid = opaque_tid(wave), wid = wave, lane = tid & 63, r32 = lane & 31, hi = lane >> 5;
    const int P0 = qb_cur * QB;
    const int NT = (P0 + QB - 1) / KVBLK + 1 - jlo;
    const int qlo = P0 + wid * QBLK, qm = qlo + r32 - 4 * hi;
    float l_reg = 0; f32x16 o[4] = {};
    DMA_OFFS(tid);
    const int vb0 = (int)(unsigned)(uintptr_t)(lds + OFF_V) + v_rd_base(lane);
#define KBASE(t) ((jlo + (t)) * KVBLK)
#define MASKT(P0_, P1_, t) do { const int kb_ = KBASE(t); if (kb_ + KVBLK - 1 > qlo) mask_tile(P0_, P1_, qm - kb_); } while (0)
    f32x16 pA0, pA1, pB0, pB1; bf16x8 pa0, pa1, pa2, pa3;
    bf16x8 q4[4] = {S.qr[0], S.qr[1], S.qr[2], S.qr[3]};
    LAS char* qb = lds + OFF_Q + wid * SHM_Q + r32 * QROWB + hi * 16;
#pragma unroll
    for (int d0 = 4; d0 < 8; ++d0) *reinterpret_cast<LAS bf16x8*>(qb + (d0 - 4) * 32) = S.qr[d0];
    LAS char* qxb = lds + OFF_QX + wid * 1024 + r32 * 32 + hi * 16; *reinterpret_cast<LAS bf16x8*>(qxb) = S.qx;
    WAITBAR();
    SBAR(); qkt<0>(pA0, pA1, lds, r32, hi, q4, qb, qxb);
    DMA_TILE(bh, jlo + 1, 1, 1); SBAR();
    MASKT(pA0, pA1, 0); partialSM(pA0);
    WAITBAR();
    int vr = 0, vw = 2;
#define HALF_STEP(PX0, PX1, PY0, PY1, t, KB) do {                                                      \
        SBAR(); qkt<KB>(PX0, PX1, lds, r32, hi, q4, qb, qxb);                                             \
        finishSM(PY0, PY1, l_reg, pa0, pa1, pa2, pa3); SBAR();                                                           \
        if ((t) + 1 < NT) { DMA_TILE(bh, jlo + (t) + 1, (KB) ^ 1, vw); SBAR(); }                                         \
        pv_tile<0>(o, vb0 + vr * SHM_V, pa0, pa1, pa2, pa3); MASKT(PX0, PX1, (t)); partialSM(PX0);                         \
        WAITBAR();                                                                                                            \
        vr = (vr == NVB - 1) ? 0 : vr + 1; vw = (vw == NVB - 1) ? 0 : vw + 1; } while (0)
    for (int t = 1; t + 1 < NT; t += 2) {
        HALF_STEP(pB0, pB1, pA0, pA1, t, 1);
        HALF_STEP(pA0, pA1, pB0, pB1, t + 1, 0);
    }
    SBAR(); qkt<1>(pB0, pB1, lds, r32, hi, q4, qb, qxb); SBAR();
    finishSM(pA0, pA1, l_reg, pa0, pa1, pa2, pa3); SBAR();
    pv_tile<0>(o, vb0 + vr * SHM_V, pa0, pa1, pa2, pa3);
    vr = (vr == NVB - 1) ? 0 : vr + 1;
    MASKT(pB0, pB1, NT - 1); partialSM(pB0);
    finishSM(pB0, pB1, l_reg, pa0, pa1, pa2, pa3); SBAR(); pv_tile<0>(o, vb0 + vr * SHM_V, pa0, pa1, pa2, pa3);
    WAITBAR();
    { const int tid2 = opaque_tid(wave), r32b = tid2 & 31, hib = (tid2 >> 5) & 1;
      QLOAD(bh, qb_nxt, r32b, hib);
      DMA_TILE(bh, jlo_nxt, 0, 0); SBAR();
      l_reg = half_swap_add(l_reg);
      LAS float* li2 = (LAS float*)(lds + OFF_WS) + wid * 64;
      if (hib == 0) li2[r32b] = l_reg; asm volatile("s_waitcnt lgkmcnt(0)" ::: "memory");
      const unsigned tok0 = (unsigned)(bh >> 3) * SEQ + (unsigned)P0 + (unsigned)(wid * QBLK);
      bf16* Ow = (bf16*)(C.ws + WS_MIX) + (size_t)tok0 * DM + 1024 + (bh & 7) * HD; float* SSw = (float*)(C.ws + WS_SMALL + SM_SSQ2) + (size_t)tok0 * 8 + (bh & 7);
      const unsigned stg0 = (unsigned)(uintptr_t)lds + (unsigned)(wid < 4 ? 16384 + wid * 8192 : wid < 6 ? 65536 + (wid - 4) * 8192 : LDSB + (wid - 6) * 8192);
      unsigned swa = stg0 + (unsigned)hib * 1024u + (unsigned)r32b * 2u; asm volatile("" : "+v"(swa));
      LAS unsigned char* swp = (LAS unsigned char*)(uintptr_t)swa;
      const unsigned sbase = (unsigned)(4 * hib) * 8; float sqk = 0.f;
#pragma unroll
      for (int r = 0; r < 16; ++r) { const unsigned ro = (unsigned)((r & 3) + 8 * (r >> 2)); const float rli = __builtin_amdgcn_rcpf(li2[ro + 4 * hib]); float sq = 0.f;
#pragma unroll
          for (int d0 = 0; d0 < 4; ++d0) { const float v = o[d0][r] * rli; sq += v * v;
              const float vn = lane_xor<1>(v);
              if ((r32b & 1) == 0) *(LAS unsigned*)(swp + ro * 256 + d0 * 64) = cvtpk(v, vn); }
          sq = sum32(sq);
          sqk = (r32b == r) ? sq : sqk; }
      if (r32b < 16) SSw[sbase + ((r32b & 3) + 8 * (r32b >> 2)) * 8] = sqk;
      asm volatile("s_waitcnt lgkmcnt(0)" ::: "memory");
      { const int ln = r32b + 32 * hib; unsigned sra = stg0 + (unsigned)(ln >> 4) * 256u + (unsigned)(ln & 15) * 16u; asm volatile("" : "+v"(sra));
        const LAS unsigned char* srp = (const LAS unsigned char*)(uintptr_t)sra;
        bf16* Or = Ow + (size_t)(ln >> 4) * DM + (ln & 15) * 8;
#pragma unroll
        for (int hb = 0; hb < 2; ++hb) { u32x4 vq[4];
#pragma unroll
          for (int it = 0; it < 4; ++it) vq[it] = *(const LAS u32x4*)(srp + (16 * hb + 4 * it) * 256);
#pragma unroll
          for (int it = 0; it < 4; ++it) *(u32x4*)(Or + (size_t)(16 * hb + 4 * it) * DM) = vq[it]; } } }
#undef KBASE
#undef MASKT
#undef HALF_STEP
}
__device__ __forceinline__ void finish(Seam& S) { asm volatile("" :: "v"(S.qx)); asm volatile("s_waitcnt vmcnt(0) lgkmcnt(0)" ::: "memory"); __syncthreads(); }
#undef WAITBAR
#undef OKV
#undef DMA16
#undef DMA_TILE
#undef DMA_OFFS
#undef QLOAD
}


struct S5Frag { bf16x8 ua, uf0, uf1; };
template <bool READOUT>
__device__ __forceinline__ S5Frag s5_load(const bf16* U, int tok0, int g, int lane) {
    S5Frag f; const int r32 = lane & 31, hi = lane >> 5;
    f.ua = *(const bf16x8*)(U + (size_t)(tok0 + r32) * DSSM + g * 16 + 8 * hi);
    if (READOUT) { f.uf0 = *(const bf16x8*)(U + (size_t)(tok0 + (lane & 15)) * DSSM + g * 16 + 8 * ((lane >> 4) & 1));
                   f.uf1 = *(const bf16x8*)(U + (size_t)(tok0 + 16 + (lane & 15)) * DSSM + g * 16 + 8 * ((lane >> 4) & 1)); }
    else { f.uf0 = f.ua; f.uf1 = f.ua; }
    return f;
}
#ifndef PSTAGE
#define PSTAGE true
#endif
#ifndef SSTAGE
#define SSTAGE true
#endif
template <bool READOUT, bool STAGE = true>
__device__ __forceinline__ void s5_scan32(const S5Frag& F, bf16* GYD, LAS unsigned char* ST, int srow, int tok0, int g, float a_re, float a_im, const bf16x8 (&bm)[4], const bf16x8 (&cm)[4], const bf16x8 dfrag,
                                          LAS unsigned char* Hs, float& h_re, float& h_im, int lane) {
    const int r32 = lane & 31, hi = lane >> 5, p = r32 + 32 * hi;
    f32x16 D0 = __builtin_amdgcn_mfma_f32_32x32x16_bf16(F.ua, bm[0], f32x16{}, 0, 0, 0);
    f32x16 D1 = __builtin_amdgcn_mfma_f32_32x32x16_bf16(F.ua, bm[1], f32x16{}, 0, 0, 0);
    f32x16 D2 = __builtin_amdgcn_mfma_f32_32x32x16_bf16(F.ua, bm[2], f32x16{}, 0, 0, 0);
    f32x16 D3 = __builtin_amdgcn_mfma_f32_32x32x16_bf16(F.ua, bm[3], f32x16{}, 0, 0, 0);
#pragma unroll
    for (int r = 0; r < 16; ++r) {
        auto s0 = __builtin_amdgcn_permlane32_swap(__float_as_uint(D0[r]), __float_as_uint(D1[r]), false, false); D0[r] = __uint_as_float(s0[0]); D1[r] = __uint_as_float(s0[1]);
        auto s1 = __builtin_amdgcn_permlane32_swap(__float_as_uint(D2[r]), __float_as_uint(D3[r]), false, false); D2[r] = __uint_as_float(s1[0]); D3[r] = __uint_as_float(s1[1]);
    }
#pragma unroll
    for (int s = 0; s < 32; ++s) {
        const int hs = (s >> 2) & 1, rs_ = (s & 3) + 4 * (s >> 3);
        const float bre = hs ? D1[rs_] : D0[rs_], bim = hs ? D3[rs_] : D2[rs_];
        const float nre = fmaf(a_re, h_re, fmaf(-a_im, h_im, bre)), nim = fmaf(a_re, h_im, fmaf(a_im, h_re, bim));
        h_re = nre; h_im = nim;
        if (READOUT) *(LAS unsigned*)(Hs + s * 272 + p * 4) = cvtpk_nv(h_re, h_im);
    }
    if (READOUT) {
        asm volatile("s_waitcnt lgkmcnt(0)" ::: "memory");
#pragma unroll
        for (int tb = 0; tb < 2; ++tb) {
            f32x4 y = __builtin_amdgcn_mfma_f32_16x16x32_bf16(tb == 0 ? F.uf0 : F.uf1, dfrag, (f32x4){0.f, 0.f, 0.f, 0.f}, 0, 0, 0);
#pragma unroll
            for (int kk = 0; kk < 4; ++kk) { const bf16x8 ha = *(const LAS bf16x8*)(Hs + (16 * tb + (lane & 15)) * 272 + kk * 64 + (lane >> 4) * 16);
                y = __builtin_amdgcn_mfma_f32_16x16x32_bf16(ha, cm[kk], y, 0, 0, 0); }
#pragma unroll
            for (int r = 0; r < 4; ++r) { const int t = 16 * tb + 4 * (lane >> 4) + r; const size_t tok = (size_t)(tok0 + t);
                if (STAGE) *(LAS unsigned short*)(ST + (srow + t) * 32 + (lane & 15) * 2) = (unsigned short)f2bf(gelu_tanh(y[r]));
                else GYD[tok * DSSM + g * 16 + (lane & 15)] = f2bf(gelu_tanh(y[r])); }
        }
        asm volatile("s_waitcnt lgkmcnt(0)" ::: "memory");
    }
}
__device__ __forceinline__ void s5_flush(LAS const unsigned char* ST, bf16* GY, int tok0, int nrow, int g, int lane) {
    asm volatile("s_waitcnt lgkmcnt(0)" ::: "memory");
    for (int r = lane >> 1; r < nrow; r += 32) { const u32x4 v = *(const LAS u32x4*)(ST + r * 32 + (lane & 1) * 16);
        *(u32x4*)(GY + (size_t)(tok0 + r) * DSSM + g * 16 + (lane & 1) * 8) = v; }
    asm volatile("s_waitcnt lgkmcnt(0)" ::: "memory");
}
__device__ __forceinline__ bf16x8 s5_dfrag(float dsk, int lane) {
    const int i = lane & 15, kq = lane >> 4; bf16x8 d = {0, 0, 0, 0, 0, 0, 0, 0};
    const short dv = (short)f2bf(dsk);
#pragma unroll
    for (int jj = 0; jj < 8; ++jj) d[jj] = (8 * kq + jj == i) ? dv : (short)0;
    return d;
}

#define XB_TMO      128
#define XB_XCNT(j)  (256  + 64 * (j))
#define XB_XSUB(j)  (1280 + 64 * (j))
#define XB_XGEN(j)  (2304 + 64 * (j))
#define XB_TOP      3328
#define XB_TOPGEN   3392
#define XCD_BAR_WORDS 3456
#define XB_SPIN_CAP (1u << 18)
__device__ __forceinline__ unsigned xb_ld(unsigned* p)              { return __hip_atomic_load(p, __ATOMIC_RELAXED, __HIP_MEMORY_SCOPE_AGENT); }
__device__ __forceinline__ unsigned xb_add(unsigned* p, unsigned v) { return __hip_atomic_fetch_add(p, v, __ATOMIC_RELAXED, __HIP_MEMORY_SCOPE_AGENT); }
__device__ __forceinline__ unsigned xb_xcc_id() { return (unsigned)__builtin_amdgcn_s_getreg((3 << 11) | 20) & 0xFu; }
#define XB_SPIN(cond, bar) do { unsigned _sp = 0; while (cond) { __builtin_amdgcn_s_sleep(1); \
    if ((++_sp & 255u) == 0u) { if (xb_ld(&(bar)[XB_TMO])) break; if (_sp > XB_SPIN_CAP) { atomicAdd(&(bar)[XB_TMO], 1u); break; } } } } while (0)
struct XcdBarrier { unsigned* bar; unsigned x; volatile LAS unsigned* st; };
__device__ __forceinline__ XcdBarrier xcd_barrier_post(unsigned* bar, volatile LAS unsigned* st) {
    XcdBarrier b; b.bar = bar; b.x = xb_xcc_id(); b.st = st;
    if (threadIdx.x == 0) (void)xb_add(&bar[XB_XCNT(b.x)], 1u);
    return b;
}
__device__ __forceinline__ void xcd_barrier_complete(unsigned* bar, unsigned x, unsigned& nloc, unsigned& nx) {
    const unsigned G = gridDim.x * gridDim.y * gridDim.z;
    unsigned sum, cnt, mine, sp = 0u;
    for (;;) {
        sum = 0u; cnt = 0u; mine = 0u;
#pragma unroll
        for (unsigned j = 0; j < 16; ++j) { const unsigned c = xb_ld(&bar[XB_XCNT(j)]); sum += c; cnt += (c > 0u) ? 1u : 0u; mine = (j == x) ? c : mine; }
        if (sum == G) break;
        __builtin_amdgcn_s_sleep(1);
        if ((++sp & 255u) == 0u) { if (xb_ld(&bar[XB_TMO])) break; if (sp > XB_SPIN_CAP) { atomicAdd(&bar[XB_TMO], 1u); break; } }
    }
    nloc = mine > 0u ? mine : 1u; nx = cnt > 0u ? cnt : 1u;
}
__device__ __forceinline__ void xcd_barrier(const XcdBarrier& b) {
    asm volatile("s_waitcnt vmcnt(0)" ::: "memory");
    __syncthreads();
    if (threadIdx.x == 0) {
        unsigned* bar = b.bar;
        __builtin_amdgcn_s_waitcnt(0);
        unsigned nloc = b.st[0], nx = b.st[1];
        if (nloc == 0u) { xcd_barrier_complete(bar, b.x, nloc, nx); b.st[0] = nloc; b.st[1] = nx; }
        const unsigned old = xb_add(&bar[XB_XSUB(b.x)], 1u);
        const unsigned gen = old / nloc;
        if (old + 1u == (gen + 1u) * nloc) {
            __builtin_amdgcn_fence(__ATOMIC_RELEASE, "agent");
            asm volatile("s_waitcnt vmcnt(0)" ::: "memory");
            const unsigned og = xb_add(&bar[XB_TOP], 1u);
            const unsigned tg = og / nx;
            if (og + 1u == (tg + 1u) * nx) xb_add(&bar[XB_TOPGEN], 1u);
            else XB_SPIN(xb_ld(&bar[XB_TOPGEN]) == tg, bar);
            xb_add(&bar[XB_XGEN(b.x)], 1u);
            __builtin_amdgcn_fence(__ATOMIC_ACQUIRE, "agent");
            asm volatile("s_waitcnt vmcnt(0)" ::: "memory");
        } else {
            XB_SPIN(xb_ld(&bar[XB_XGEN(b.x)]) == gen, bar);
            __builtin_amdgcn_fence(__ATOMIC_ACQUIRE, "agent");
            asm volatile("s_waitcnt vmcnt(0)" ::: "memory");
        }
    }
    __syncthreads();
}

__device__ __forceinline__ void split3(float x, unsigned short& h, unsigned short& m, unsigned short& l) {
    h = (unsigned short)f2bf(x); const float r1 = x - bf2f(h); m = (unsigned short)f2bf(r1); const float r2 = r1 - bf2f(m); l = (unsigned short)f2bf(r2);
}

__global__ void __launch_bounds__(512, 2) hymba_fwd(Args args) {
    extern __shared__ __attribute__((aligned(16))) unsigned char lds_raw[];
    cg::grid_group grid = cg::this_grid();
    LAS unsigned char* lds = (LAS unsigned char*)lds_raw;
    const int wave = __builtin_amdgcn_readfirstlane(threadIdx.x >> 6);
    const int G = gridDim.x, bx = blockIdx.x;
    volatile LAS unsigned* xst = (volatile LAS unsigned*)(lds + LDS_BYTES - 16);
    if (threadIdx.x < 4) xst[threadIdx.x] = 0u;
    __syncthreads();
    const XcdBarrier xbar = xcd_barrier_post((unsigned*)((const __attribute__((address_space(4))) Args*)__builtin_amdgcn_kernarg_segment_ptr())->ws, xst);
    if (gridDim.y == 0x7fffffffu) grid.sync();
#define GRID_SYNC() xcd_barrier(xbar)
    const int gw = bx * 8 + wave, NGW = G * 8;
#define PHASE_PTRS \
    const __attribute__((address_space(4))) Args* A_ = (const __attribute__((address_space(4))) Args*)__builtin_amdgcn_kernarg_segment_ptr(); asm volatile("" : "+s"(A_)); \
    unsigned char* const ws = A_->ws; float* const out = A_->out; (void)ws; (void)out;
#define IN(i) (A_->in[i])
#define x_prompt IN(0)
#define x_sample IN(1)
#define cache_k IN(2)
#define cache_v IN(3)
#define cache_logf IN(4)
#define st_re IN(5)
#define st_im IN(6)
#define Win_t ((bf16*)(ws + WS_WIN))
#define Wglu_t ((bf16*)(ws + WS_WGLU))
#define Wout_t ((bf16*)(ws + WS_WOUT))
#define Wup_t ((bf16*)(ws + WS_WUP))
#define Wdn_t ((bf16*)(ws + WS_WDN))
#define RS1 ((float*)(ws + WS_SMALL + SM_RS1))
#define ABAR ((float*)(ws + WS_SMALL + SM_ABAR))
#define APOW ((float*)(ws + WS_SMALL + SM_APOW))
#define BMT ((bf16*)(ws + WS_SMALL + SM_BMT))
#define CMT ((bf16*)(ws + WS_SMALL + SM_CMT))
#define SSQ1 ((float*)(ws + WS_SMALL + SM_SSQ1))
#define SSQ2 ((float*)(ws + WS_SMALL + SM_SSQ2))
#define SSQ3 ((float*)(ws + WS_SSQ3))
#define XB ((bf16*)(ws + WS_XB))
#define U ((bf16*)(ws + WS_U))
#define QKraw ((float*)(ws + WS_QKRAW))
#define Qh ((bf16*)(ws + WS_QH))
#define Kh ((bf16*)(ws + WS_KH))
#define Vh ((bf16*)(ws + WS_VH))
#define GY ((bf16*)(ws + WS_GY))
#define MIX ((bf16*)(ws + WS_MIX))
#define X1B ((bf16*)(ws + WS_X1B))
#define Hb ((bf16*)(ws + WS_H))
#define CLK ((bf16*)(ws + WS_CLK))
#define CLQ ((bf16*)(ws + WS_CLQ))

    for (int rep_ = 0; rep_ < REPS(1); ++rep_) { if (rep_) GRID_SYNC();
        PHASE_PTRS
        const int tid = opaque_tid(wave), lane = tid & 63;
        LAS float* scr = (LAS float*)(lds + wave * 16384);
        constexpr int I_IN = 32 * 128;
        for (int it = gw; it < I_IN; it += NGW) p0_transpose_item(IN(8), NINW, DM, 128, IN(7), nullptr, Win_t, scr, it, lane);
        __syncthreads();
        LAS float* wfT = (LAS float*)lds;
        for (int e = tid; e < 8 * DM; e += 512) { const int k = e >> 3, h = e & 7; wfT[h * DM + k] = IN(8)[(size_t)k * NINW + 4096 + h] * IN(7)[k]; }
        __syncthreads();
        f32x4 vn[8];
        { const int m0 = gw < MT ? gw : 0; const float* xr0 = m0 < MP ? x_prompt + (size_t)m0 * DM : x_sample + (size_t)(m0 - MP) * DM;
#pragma unroll
          for (int j = 0; j < 8; ++j) vn[j] = *(const f32x4*)(xr0 + 4 * lane + 256 * j); }
        for (int m = gw; m < MT; m += NGW) {
            f32x4 v[8]; float s = 0.f; float dt[8];
#pragma unroll
            for (int h = 0; h < 8; ++h) dt[h] = 0.f;
#pragma unroll
            for (int j = 0; j < 8; ++j) { v[j] = vn[j]; s += (v[j][0] * v[j][0] + v[j][1] * v[j][1]) + (v[j][2] * v[j][2] + v[j][3] * v[j][3]); }
#pragma unroll
            for (int j = 0; j < 8; ++j) { u32x2 w; w.x = cvtpk(v[j][0], v[j][1]); w.y = cvtpk(v[j][2], v[j][3]); *(u32x2*)(XB + (size_t)m * DM + 4 * lane + 256 * j) = w; }
            { const int mn = m + NGW < MT ? m + NGW : m; const float* xrn = mn < MP ? x_prompt + (size_t)mn * DM : x_sample + (size_t)(mn - MP) * DM;
#pragma unroll
              for (int j = 0; j < 8; ++j) vn[j] = *(const f32x4*)(xrn + 4 * lane + 256 * j); }
#pragma unroll
            for (int j = 0; j < 8; ++j)
#pragma unroll
                for (int h = 0; h < 8; ++h) { const f32x4 w = *(const LAS f32x4*)(wfT + h * DM + 4 * lane + 256 * j); dt[h] += (v[j][0] * w[0] + v[j][1] * w[1]) + (v[j][2] * w[2] + v[j][3] * w[3]); }
            s = wave_sum(s); const float rs = 1.0f / sqrtf(s * (1.0f / DM) + EPS);
#pragma unroll
            for (int h = 0; h < 8; ++h) dt[h] = wave_sum(dt[h]);
            if (lane == 0) RS1[m] = rs;
            if (lane < 8) { float z = 0.f;
#pragma unroll
                for (int h = 0; h < 8; ++h) z = (lane == h) ? dt[h] : z;
                z = z * rs + IN(9)[lane];
                const float lf = log_sigmoidf_(z);
                out[(m < MP ? O_LFP + (size_t)m * 8 : O_LFS + (size_t)(m - MP) * 8) + lane] = lf; }
        }
    }
    GRID_SYNC();

    for (int rep_ = 0; rep_ < REPS(2); ++rep_) { if (rep_) GRID_SYNC();
        PHASE_PTRS
        pg8::Gemm g{XB, Win_t, MT, 4096, DM, DM}; pg8::StaticOrder S; S.init(MT, 4096, G, bx);
        EpiIn E{RS1, U, out, Qh, Kh, Vh, IN(19), IN(20), (LAS float*)(lds + AUX_OFF)};
        pg8::gemm_phase<EpiIn, pg8::StaticOrder>(lds, g, S, E, wave);
        { const int busy = S.nwg % G, nfree = busy ? G - busy : G, fi = busy ? bx - busy : bx;
          if (fi >= (nfree >= 144 ? 16 : 0) && rep_ == 0) { const int tq_ = opaque_tid(wave), f0_ = nfree >= 144 ? 16 : 0;
            if (tq_ < 32) for (int gt = (fi - f0_) * 32 + tq_; gt < NG * NP; gt += (nfree - f0_) * 32) {
            const int g = gt >> 6, p = gt & 63;
            const float a_re = IN(10)[gt], a_im = IN(11)[gt], step = expf(IN(12)[g]);
            const float mag = expf(a_re * step); float sn, cs; sincosf(a_im * step, &sn, &cs);
            const float ab_re = mag * cs, ab_im = mag * sn;
            const float den = a_re * a_re + a_im * a_im, nr = ab_re - 1.0f, ni = ab_im;
            const float fr_ = (nr * a_re + ni * a_im) / den, fi_ = (ni * a_re - nr * a_im) / den;
            ABAR[gt * 2] = ab_re; ABAR[gt * 2 + 1] = ab_im;
            float pr = ab_re, pi = ab_im;
#pragma unroll 1
            for (int q = 0; q < 9; ++q) { const float nr2 = pr * pr - pi * pi, ni2 = 2.f * pr * pi; pr = nr2; pi = ni2; }
            APOW[gt * 2] = pr; APOW[gt * 2 + 1] = pi;
            const float* bre = IN(13) + (size_t)gt * 16; const float* bim = IN(14) + (size_t)gt * 16;
#pragma unroll
            for (int j = 0; j < 16; ++j) { const float br = bre[j], bi = bim[j];
                BMT[((size_t)g * 128 + p) * 16 + j] = (bf16)f2bf(fr_ * br - fi_ * bi);
                BMT[((size_t)g * 128 + 64 + p) * 16 + j] = (bf16)f2bf(fr_ * bi + fi_ * br); }
#pragma unroll
            for (int i = 0; i < 16; ++i) { const float cr = IN(15)[((size_t)g * 16 + i) * 64 + p], ci = IN(16)[((size_t)g * 16 + i) * 64 + p];
                CMT[((size_t)g * 16 + i) * 128 + 2 * p] = (bf16)f2bf(cr); CMT[((size_t)g * 16 + i) * 128 + 2 * p + 1] = (bf16)f2bf(-ci); }
            } }
          if (fi >= 0 && fi < 16 && rep_ == 0) {
            const int tid = opaque_tid(wave), lane = tid & 63;
            const int bh = fi, b = bh >> 3, h = bh & 7;
            LAS float* red = (LAS float*)(lds + AUX_OFF);
            float gm = 0.f; if (tid < 128) gm = fabsf(IN(19)[tid] * IN(20)[tid]);
            gm = wave_max(gm);
            if (lane == 0) red[16 + wave] = gm;
            const float* lf = out + O_LFP + (size_t)b * SEQ * 8 + h;
            float loc[16]; float s = 0.f;
#pragma unroll
            for (int i = 0; i < 16; ++i) { loc[i] = lf[(size_t)(tid * 16 + i) * 8]; s += loc[i]; }
            const float inc = wave_incl_scan(s);
            if (lane == 63) red[wave] = inc;
            __syncthreads();
            float base = inc - s; for (int w2 = 0; w2 < wave; ++w2) base += red[w2];
            const float MB = fmaxf(red[16], red[17]) * 11.313708498984761f * LOG2E;
            float run = base;
#pragma unroll
            for (int i = 0; i < 16; ++i) { run += loc[i]; const int t = tid * 16 + i; const float cl = run * LOG2E;
                unsigned short a, bb, c; split3(-cl, a, bb, c);
                u32x4 w0 = {(unsigned)a | ((unsigned)bb << 16), (unsigned)c | (0x3F80u << 16), 0x3F803F80u, 0u}; const u32x4 z = {0u, 0u, 0u, 0u};
                u32x4* kx = (u32x4*)(CLK + ((size_t)bh * SEQ + t) * 16); kx[0] = w0; kx[1] = z;
                split3(cl - MB, a, bb, c);
                u32x4 w1 = {0x3F803F80u, 0x3F80u | ((unsigned)a << 16), (unsigned)bb | ((unsigned)c << 16), 0u};
                u32x4* qx = (u32x4*)(CLQ + ((size_t)bh * SEQ + t) * 16); qx[0] = w1; qx[1] = z;
                ((float*)(ws + WS_SMALL + SM_CLF))[(size_t)bh * SEQ + t] = cl; }
            if (tid == 0) ((float*)(ws + WS_SMALL + SM_CLF))[16 * SEQ] = 2.f * MB + 37.f;
            __syncthreads();
          }
          if (fi >= 0) { const int lane = opaque_tid(wave) & 63; LAS float* scr = (LAS float*)(lds + wave * 16384);
              constexpr int I_GLU = 16 * 32, I_OUT = 32 * 64, I_UP = 32 * 256;
              for (int it = fi * 8 + wave; it < I_GLU + I_OUT + I_UP; it += nfree * 8) { int r = it;
                  if (r < I_GLU) { p0_transpose_item(IN(18), 1024, 1024, 32, nullptr, nullptr, Wglu_t, scr, r, lane); continue; } r -= I_GLU;
                  if (r < I_OUT) { p0_transpose_item(IN(23), DM, DM, 64, IN(21), IN(22), Wout_t, scr, r, lane); continue; } r -= I_OUT;
                  p0_transpose_item(IN(25), DFF, DM, 256, IN(24), nullptr, Wup_t, scr, r, lane); } } }
    }
    GRID_SYNC();

    for (int rep_ = 0; rep_ < REPS(4); ++rep_) { if (rep_) GRID_SYNC();
        PHASE_PTRS
        const int tid = opaque_tid(wave), lane = tid & 63;
        {
            const int nb = bx >> 7, oc = (bx >> 4) & 7, seg = bx & 15, g = oc * 8 + wave, ng = nb * 64 + g;
            const int r32 = lane & 31, hi = lane >> 5, p = r32 + 32 * hi;
            const float a_re = ABAR[(g * 64 + p) * 2], a_im = ABAR[(g * 64 + p) * 2 + 1];
            bf16x8 bm[4], cm[4];
#pragma unroll
            for (int b = 0; b < 4; ++b) bm[b] = *(const bf16x8*)(BMT + ((size_t)g * 128 + 32 * b + r32) * 16 + 8 * hi);
#pragma unroll
            for (int kk = 0; kk < 4; ++kk) cm[kk] = *(const bf16x8*)(CMT + ((size_t)g * 16 + (lane & 15)) * 128 + 32 * kk + 8 * (lane >> 4));
            const float dsk = IN(17)[g * 16 + (lane & 15)];
            LAS unsigned char* Hs = lds + wave * 8704;
            LAS unsigned char* STG = lds + 8 * 8704 + wave * 4096;
            float* EX = (float*)(ws + WS_SMALL + SM_S5EX) + (size_t)ng * (16 * 128); unsigned* xcnt = (unsigned*)(ws + 40960) + (nb * 8 + oc);
            const int tokb = nb * SEQ + seg * 512;
            const bf16x8 dfrag = s5_dfrag(dsk, lane);
            float h_re = 0.f, h_im = 0.f;
            { S5Frag F = s5_load<false>(U, tokb, g, lane);
#pragma unroll 1
              for (int blk = 0; blk < 16; ++blk) { const S5Frag Fn = s5_load<false>(U, tokb + 32 * (blk < 15 ? blk + 1 : blk), g, lane);
                  s5_scan32<false>(F, nullptr, Hs, 0, tokb + 32 * blk, g, a_re, a_im, bm, cm, dfrag, Hs, h_re, h_im, lane); F = Fn; } }
            __hip_atomic_store(EX + (seg * 64 + p) * 2, h_re, __ATOMIC_RELAXED, __HIP_MEMORY_SCOPE_AGENT); __hip_atomic_store(EX + (seg * 64 + p) * 2 + 1, h_im, __ATOMIC_RELAXED, __HIP_MEMORY_SCOPE_AGENT);
            asm volatile("s_waitcnt vmcnt(0)" ::: "memory");
            __syncthreads();
            if (tid == 0) { __builtin_amdgcn_fence(__ATOMIC_RELEASE, "agent"); asm volatile("s_waitcnt vmcnt(0)" ::: "memory"); __hip_atomic_fetch_add(xcnt, 1u, __ATOMIC_RELAXED, __HIP_MEMORY_SCOPE_AGENT); }
            { const int n = nb * 16 + seg;
              float s_re = st_re[((size_t)n * 64 + g) * 64 + p], s_im = st_im[((size_t)n * 64 + g) * 64 + p];
              const S5Frag F = s5_load<true>(U, MP + n * 32, g, lane);
              s5_scan32<true, true>(F, GY, STG, 0, MP + n * 32, g, a_re, a_im, bm, cm, dfrag, Hs, s_re, s_im, lane);
              out[O_HRS + ((size_t)n * 64 + g) * 64 + p] = s_re; out[O_HIS + ((size_t)n * 64 + g) * 64 + p] = s_im;
              s5_flush(STG, GY, MP + n * 32, 32, g, lane); }
            if (tid == 0) { unsigned sp = 0; while (__hip_atomic_load(xcnt, __ATOMIC_RELAXED, __HIP_MEMORY_SCOPE_AGENT) < 16u) { __builtin_amdgcn_s_sleep(2); if (++sp > (1u << 22)) break; }
                __builtin_amdgcn_fence(__ATOMIC_ACQUIRE, "agent"); asm volatile("s_waitcnt vmcnt(0)" ::: "memory"); }
            __syncthreads();
            const float pw_re = APOW[(g * 64 + p) * 2], pw_im = APOW[(g * 64 + p) * 2 + 1];
            h_re = 0.f; h_im = 0.f;
            { float er[15], ei[15];
#pragma unroll
              for (int s2 = 0; s2 < 15; ++s2) { er[s2] = 0.f; ei[s2] = 0.f;
                  if (s2 < seg) { er[s2] = __hip_atomic_load(EX + (s2 * 64 + p) * 2, __ATOMIC_RELAXED, __HIP_MEMORY_SCOPE_AGENT); ei[s2] = __hip_atomic_load(EX + (s2 * 64 + p) * 2 + 1, __ATOMIC_RELAXED, __HIP_MEMORY_SCOPE_AGENT); } }
#pragma unroll
              for (int s2 = 0; s2 < 15; ++s2) if (s2 < seg) { const float nre = pw_re * h_re - pw_im * h_im + er[s2], nim = pw_re * h_im + pw_im * h_re + ei[s2]; h_re = nre; h_im = nim; } }
            { S5Frag F = s5_load<true>(U, tokb, g, lane);
#pragma unroll 1
              for (int ob = 0; ob < 4; ++ob) {
#pragma unroll 1
                for (int ib = 0; ib < 4; ++ib) { const int blk = ob * 4 + ib; const S5Frag Fn = s5_load<true>(U, tokb + 32 * (blk < 15 ? blk + 1 : blk), g, lane);
                  s5_scan32<true, PSTAGE>(F, GY, STG, ib * 32, tokb + 32 * blk, g, a_re, a_im, bm, cm, dfrag, Hs, h_re, h_im, lane); F = Fn; }
                if (PSTAGE) s5_flush(STG, GY, tokb + 128 * ob, 128, g, lane); } }
            if (seg == 15) { out[O_HRP + (size_t)(nb * 64 + g) * 64 + p] = h_re; out[O_HIP + (size_t)(nb * 64 + g) * 64 + p] = h_im; }
        }
    }
    GRID_SYNC();

    if (PHMASK & 8) {
        PHASE_PTRS
        const int tid = opaque_tid(wave), lane = tid & 63;
        for (int rep_ = 0; rep_ < REPS(256); ++rep_) { if (rep_) GRID_SYNC(); pg8::Gemm g{GY, Wglu_t, MT, 1024, 1024, 1024}; pg8::StaticOrder S; S.init(MT, 1024, G, bx);
          EpiGlu E{GY, MIX, SSQ1};
          pg8::gemm_phase<EpiGlu, pg8::StaticOrder>(lds, g, S, E, wave); }
        __syncthreads();
#pragma unroll 1
        for (int st_ = 0; st_ < 3; ++st_) {
        const int role_ = (bx & 1) ? (st_ == 0 ? 1 : st_ == 1 ? 0 : 2) : st_;
        if (role_ == 0) {
        for (int rep_ = 0; rep_ < REPS(512); ++rep_) for (int item = bx; item < DB * NH; item += G) {
            const int n = item >> 3, h = item & 7;
            const int tid = opaque_tid(wave), lane = tid & 63;
            const int r32 = lane & 31, hi = lane >> 5;
            LAS float* CLs = (LAS float*)(lds + AUX_OFF);
            LAS float* red = CLs + 2096;
            { const float* lfc = cache_logf + ((size_t)n * PAST) * 8 + h;
              float loc[4]; float s = 0.f;
#pragma unroll
              for (int i = 0; i < 4; ++i) { loc[i] = lfc[(size_t)(tid * 4 + i) * 8]; s += loc[i]; }
              const float inc = wave_incl_scan(s);
              float gm = 0.f; if (tid < 128) gm = fabsf(IN(19)[tid] * IN(20)[tid]);
              gm = wave_max(gm);
              if (lane == 63) red[wave] = inc;
              if (lane == 0) red[16 + wave] = gm;
              __syncthreads();
              float base = inc - s; float tot = 0.f;
              for (int w2 = 0; w2 < 8; ++w2) { const float rv = red[w2]; if (w2 < wave) base += rv; tot += rv; }
              float run = base;
#pragma unroll
              for (int i = 0; i < 4; ++i) { run += loc[i]; CLs[tid * 4 + i] = run * LOG2E; }
              if (wave == 0) { float v = (lane < 32) ? out[O_LFS + (size_t)(n * 32 + lane) * 8 + h] : 0.f;
                  v = wave_incl_scan(v);
                  if (lane < 32) CLs[2048 + lane] = (tot + v) * LOG2E; }
              __syncthreads(); }
            const float MB = fmaxf(red[16], red[17]) * 11.313708498984761f * LOG2E;
            int kb_lo;
            { const float thr = 2.f * MB + 37.f; const float ce = CLs[lane * 32 + 31];
              kb_lo = __builtin_amdgcn_readfirstlane(wave_min_i((CLs[2048] - ce >= -thr) ? lane : 64)); }
            const fox::srd_t sK = fox::mksrd(cache_k, (unsigned)DB * PAST * NH * HD * 4u), sV = fox::mksrd(cache_v, (unsigned)DB * PAST * NH * HD * 4u);
            const fox::srd_t sQh = fox::mksrd(Qh, 34u * 1048576u), sKh = fox::mksrd(Kh, 34u * 1048576u), sVh = fox::mksrd(Vh, 34u * 1048576u);
            const unsigned onew = (unsigned)(2 * NH * SEQ * HD + (n * NH + h) * DSEQ * HD) * 2u;
            bf16x8 qf[8];
#pragma unroll
            for (int d0 = 0; d0 < 8; ++d0) qf[d0] = fox::bload8(sQh, (unsigned)((r32 * HD + 64 * hi + 8 * d0) * 2), onew);
            bf16x8 qx;
            { unsigned short a, bb, c; split3(CLs[2048 + r32] - MB, a, bb, c);
              u32x4 w = {0x3F803F80u, 0x3F80u | ((unsigned)a << 16), (unsigned)bb | ((unsigned)c << 16), 0u}; if (hi) w = (u32x4){0u, 0u, 0u, 0u};
              qx = __builtin_bit_cast(bf16x8, w); }
            f32x16 o[4] = {}; float l_reg = 0.f;
            const unsigned vok = (unsigned)(r32 * (NH * HD * 4) + hi * 256), vov = (unsigned)(hi * 4 * (NH * HD * 4) + r32 * 4);
            const unsigned vokn = (unsigned)((r32 * HD + 64 * hi) * 2), vovn = (unsigned)((hi * 4 * HD + r32) * 2);
#pragma unroll 1
            for (int kb = kb_lo + wave; kb < 65; kb += 8) {
                unsigned vok_ = vok, vokn_ = vokn, vovn_ = vovn, vqv = (unsigned)hi * (NH * HD * 4) + (unsigned)r32 * 16u;
                asm volatile("" : "+v"(vok_), "+v"(vokn_), "+v"(vovn_), "+v"(vqv));
                f32x16 sc = {};
                bf16x8 kx;
                { unsigned short a, bb, c; const float clk = CLs[kb * 32 + r32]; split3(-clk, a, bb, c);
                  u32x4 w = {(unsigned)a | ((unsigned)bb << 16), (unsigned)c | (0x3F80u << 16), 0x3F803F80u, 0u}; if (hi) w = (u32x4){0u, 0u, 0u, 0u};
                  kx = __builtin_bit_cast(bf16x8, w); }
                const unsigned sob = (unsigned)(((n * PAST + kb * 32) * NH + h) * HD) * 4u;
                if (kb < 64) {
                    bf16x8 kf8[8];
                    { f32x4 kr[8][2];
#pragma unroll
                      for (int d0 = 0; d0 < 8; ++d0) {
                          kr[d0][0] = __builtin_bit_cast(f32x4, __builtin_amdgcn_raw_buffer_load_b128(sK, (int)(vok_ + d0 * 32), (int)sob, 0));
                          kr[d0][1] = __builtin_bit_cast(f32x4, __builtin_amdgcn_raw_buffer_load_b128(sK, (int)(vok_ + d0 * 32 + 16), (int)sob, 0)); }
                      asm volatile("" : "+v"(kr[0][0]), "+v"(kr[0][1]), "+v"(kr[1][0]), "+v"(kr[1][1]), "+v"(kr[2][0]), "+v"(kr[2][1]), "+v"(kr[3][0]), "+v"(kr[3][1]),
                                        "+v"(kr[4][0]), "+v"(kr[4][1]), "+v"(kr[5][0]), "+v"(kr[5][1]), "+v"(kr[6][0]), "+v"(kr[6][1]), "+v"(kr[7][0]), "+v"(kr[7][1]));
#pragma unroll
                      for (int d0 = 0; d0 < 8; ++d0) kf8[d0] = pack8(kr[d0][0], kr[d0][1]); }
#pragma unroll
                    for (int d0 = 0; d0 < 8; ++d0) sc = __builtin_amdgcn_mfma_f32_32x32x16_bf16(kf8[d0], qf[d0], sc, 0, 0, 0);
                    asm volatile("s_nop 15\n\ts_nop 15" :: "v"(kf8[0]), "v"(kf8[1]), "v"(kf8[2]), "v"(kf8[3]), "v"(kf8[4]), "v"(kf8[5]), "v"(kf8[6]), "v"(kf8[7]));
                } else {
                    { bf16x8 kn8[8];
#pragma unroll
                      for (int d0 = 0; d0 < 8; ++d0) kn8[d0] = fox::bload8(sKh, vokn_ + d0 * 16, onew);
                      asm volatile("" : "+v"(kn8[0]), "+v"(kn8[1]), "+v"(kn8[2]), "+v"(kn8[3]), "+v"(kn8[4]), "+v"(kn8[5]), "+v"(kn8[6]), "+v"(kn8[7]));
#pragma unroll
                      for (int d0 = 0; d0 < 8; ++d0) sc = __builtin_amdgcn_mfma_f32_32x32x16_bf16(kn8[d0], qf[d0], sc, 0, 0, 0);
                      asm volatile("s_nop 15\n\ts_nop 15" :: "v"(kn8[0]), "v"(kn8[1]), "v"(kn8[2]), "v"(kn8[3]), "v"(kn8[4]), "v"(kn8[5]), "v"(kn8[6]), "v"(kn8[7])); }
                }
                sc = __builtin_amdgcn_mfma_f32_32x32x16_bf16(kx, qx, sc, 0, 0, 0);
                if (kb == 64) {
#pragma unroll
                    for (int r = 0; r < 16; ++r) if (fox::crow(r, hi) > r32) sc[r] = -__builtin_inff();
                }
                float ps = 0.f;
#pragma unroll
                for (int r = 0; r < 16; ++r) { sc[r] = __builtin_amdgcn_exp2f(sc[r]); ps += sc[r]; }
                l_reg += ps;
                bf16x8 pa[2];
#pragma unroll
                for (int ks = 0; ks < 2; ++ks) { u32x4 w = {cvtpk(sc[8 * ks + 0], sc[8 * ks + 1]), cvtpk(sc[8 * ks + 2], sc[8 * ks + 3]), cvtpk(sc[8 * ks + 4], sc[8 * ks + 5]), cvtpk(sc[8 * ks + 6], sc[8 * ks + 7])};
                    pa[ks] = __builtin_bit_cast(bf16x8, w); }
                if (kb < 64) {
                    unsigned vta = (unsigned)(uintptr_t)lds + (unsigned)wave * 4224u + (unsigned)hi * 264u + (unsigned)r32 * 8u; asm volatile("" : "+v"(vta));
                    unsigned vra = (unsigned)(uintptr_t)lds + (unsigned)wave * 4224u + (unsigned)hi * (4u * 264u) + (unsigned)r32 * 2u; asm volatile("" : "+v"(vra));
                    LAS unsigned char* vtp = (LAS unsigned char*)(uintptr_t)vta; const LAS unsigned char* vrp = (const LAS unsigned char*)(uintptr_t)vra;
#pragma unroll
                    for (int ks = 0; ks < 2; ++ks) {
                        asm volatile("s_waitcnt lgkmcnt(0)" ::: "memory");
#pragma unroll
                        for (int qv = 0; qv < 2; ++qv) { f32x4 va[4];
#pragma unroll
                            for (int i = 0; i < 4; ++i) va[i] = __builtin_bit_cast(f32x4, __builtin_amdgcn_raw_buffer_load_b128(sV, (int)vqv, (int)(sob + (16 * ks + 8 * qv + 2 * i) * (NH * HD * 4)), 0));
                            asm volatile("" : "+v"(va[0]), "+v"(va[1]), "+v"(va[2]), "+v"(va[3]));
#pragma unroll
                            for (int i = 0; i < 4; ++i) { u32x2 w2; w2.x = cvtpk(va[i][0], va[i][1]); w2.y = cvtpk(va[i][2], va[i][3]); *(LAS u32x2*)(vtp + (8 * qv + 2 * i) * 264) = w2; } }
                        asm volatile("s_waitcnt lgkmcnt(0)" ::: "memory");
                        bf16x8 vw[4];
#pragma unroll
                        for (int d0 = 0; d0 < 4; ++d0) { u32x4 w;
#pragma unroll
                            for (int jj = 0; jj < 4; ++jj) { const int klo = 8 * (jj >> 1) + 2 * (jj & 1);
                                const unsigned lo16 = *(const LAS unsigned short*)(vrp + klo * 264 + d0 * 64), hi16 = *(const LAS unsigned short*)(vrp + (klo + 1) * 264 + d0 * 64);
                                w[jj] = lo16 | (hi16 << 16); }
                            vw[d0] = __builtin_bit_cast(bf16x8, w); }
                        asm volatile("" : "+v"(vw[0]), "+v"(vw[1]), "+v"(vw[2]), "+v"(vw[3]));
#pragma unroll
                        for (int d0 = 0; d0 < 4; ++d0) o[d0] = __builtin_amdgcn_mfma_f32_32x32x16_bf16(pa[ks], vw[d0], o[d0], 0, 0, 0);
                        asm volatile("s_nop 15\n\ts_nop 15" : "+v"(o[3]) : "v"(vw[0]), "v"(vw[1]), "v"(vw[2]), "v"(vw[3]), "v"(pa[ks]));
                    }
                } else {
                    unsigned vna = (unsigned)(uintptr_t)lds + (unsigned)wave * 4224u + (unsigned)(lane >> 4) * 264u + (unsigned)(lane & 15) * 16u; asm volatile("" : "+v"(vna));
                    unsigned vra = (unsigned)(uintptr_t)lds + (unsigned)wave * 4224u + (unsigned)hi * (4u * 264u) + (unsigned)r32 * 2u; asm volatile("" : "+v"(vra));
                    unsigned vnq = (unsigned)(lane >> 4) * 256u + (unsigned)(lane & 15) * 16u; asm volatile("" : "+v"(vnq));
                    LAS unsigned char* vnp = (LAS unsigned char*)(uintptr_t)vna; const LAS unsigned char* vrp = (const LAS unsigned char*)(uintptr_t)vra;
#pragma unroll
                    for (int ks = 0; ks < 2; ++ks) {
                        u32x4 vn4[4];
#pragma unroll
                        for (int i = 0; i < 4; ++i) vn4[i] = __builtin_amdgcn_raw_buffer_load_b128(sVh, (int)vnq, (int)(onew + (16 * ks + 4 * i) * (HD * 2)), 0);
                        asm volatile("" : "+v"(vn4[0]), "+v"(vn4[1]), "+v"(vn4[2]), "+v"(vn4[3]));
                        asm volatile("s_waitcnt lgkmcnt(0)" ::: "memory");
#pragma unroll
                        for (int i = 0; i < 4; ++i) { *(LAS u32x2*)(vnp + (4 * i) * 264) = (u32x2){vn4[i][0], vn4[i][1]}; *(LAS u32x2*)(vnp + (4 * i) * 264 + 8) = (u32x2){vn4[i][2], vn4[i][3]}; }
                        asm volatile("s_waitcnt lgkmcnt(0)" ::: "memory");
                        bf16x8 vw[4];
#pragma unroll
                        for (int d0 = 0; d0 < 4; ++d0) { u32x4 w;
#pragma unroll
                            for (int jj = 0; jj < 4; ++jj) { const int klo = 8 * (jj >> 1) + 2 * (jj & 1);
                                const unsigned lo16 = *(const LAS unsigned short*)(vrp + klo * 264 + d0 * 64), hi16 = *(const LAS unsigned short*)(vrp + (klo + 1) * 264 + d0 * 64);
                                w[jj] = lo16 | (hi16 << 16); }
                            vw[d0] = __builtin_bit_cast(bf16x8, w); }
                        asm volatile("" : "+v"(vw[0]), "+v"(vw[1]), "+v"(vw[2]), "+v"(vw[3]));
#pragma unroll
                        for (int d0 = 0; d0 < 4; ++d0) o[d0] = __builtin_amdgcn_mfma_f32_32x32x16_bf16(pa[ks], vw[d0], o[d0], 0, 0, 0);
                        asm volatile("s_nop 15\n\ts_nop 15" : "+v"(o[3]) : "v"(vw[0]), "v"(vw[1]), "v"(vw[2]), "v"(vw[3]), "v"(pa[ks]));
                    }
                }
                asm volatile("s_nop 15\n\ts_nop 15" : "+v"(o[3]));
            }
            __syncthreads();
            { const int tid = opaque_tid(wave), lane = tid & 63, r32 = lane & 31, hi = lane >> 5;
            LAS float* R = (LAS float*)lds;
#pragma unroll
            for (int d0 = 0; d0 < 4; ++d0)
#pragma unroll
                for (int r = 0; r < 16; ++r) R[(wave * 64 + d0 * 16 + r) * 64 + lane] = o[d0][r];
            red[32 + wave * 64 + lane] = l_reg;
            __syncthreads();
            float lt = 0.f;
#pragma unroll
            for (int w2 = 0; w2 < 8; ++w2) lt += red[32 + w2 * 64 + lane];
            { auto rr = __builtin_amdgcn_permlane32_swap(__float_as_uint(lt), __float_as_uint(lt), false, false); lt = __uint_as_float(rr[0]) + __uint_as_float(rr[1]); }
            float acc8[8];
#pragma unroll
            for (int k = 0; k < 8; ++k) { float a = 0.f;
#pragma unroll
                for (int w2 = 0; w2 < 8; ++w2) a += R[(w2 * 64 + wave * 8 + k) * 64 + lane];
                acc8[k] = a; }
            __syncthreads();
            LAS float* Of = (LAS float*)lds; LAS float* Lq = Of + 32 * 128;
            if (wave == 0 && hi == 0) Lq[r32] = lt;
            __syncthreads();
#pragma unroll
            for (int k = 0; k < 8; ++k) { const int r = 8 * (wave & 1) + k, q = fox::crow(r, hi); Of[q * 128 + (wave >> 1) * 32 + r32] = acc8[k] * __builtin_amdgcn_rcpf(Lq[q]); }
            __syncthreads();
            { const int q = wave * 4 + (lane >> 4), c8 = (lane & 15) * 8; const f32x4 a0 = *(const LAS f32x4*)(Of + q * 128 + c8), a1 = *(const LAS f32x4*)(Of + q * 128 + c8 + 4);
              float sq = (a0[0] * a0[0] + a0[1] * a0[1]) + (a0[2] * a0[2] + a0[3] * a0[3]) + (a1[0] * a1[0] + a1[1] * a1[1]) + (a1[2] * a1[2] + a1[3] * a1[3]);
              sq += lane_xor<1>(sq); sq += lane_xor<2>(sq); sq += lane_xor<4>(sq); sq += lane_xor<8>(sq);
              const size_t tok = (size_t)MP + n * 32 + q;
              *(bf16x8*)(MIX + tok * DM + 1024 + h * HD + c8) = pack8(a0, a1);
              if ((lane & 15) == 0) SSQ2[tok * 8 + h] = sq; }
            }
            __syncthreads();
        }
        } else {
        for (int rep_ = 0; rep_ < REPS(1024); ++rep_) for (int Lw = bx; Lw < 256; Lw += G) {
            const int L = (Lw & 7) * 32 + (Lw >> 3); const int bh = L >> 4, x = L & 15, qb_ = role_ == 1 ? x : 31 - x;
            const fox::Ctx FC{fox::mksrd(ws, (unsigned)WS_TOTAL), ws};
            fox::Seam Sm;
            const int lane_p = opaque_tid(wave) & 63; const int jl_ = fox::tile_lo(FC, bh, qb_, lane_p);
            fox::prime(FC, bh, qb_, jl_, (LAS char*)lds, Sm, wave);
            fox::block(FC, bh, qb_, jl_, qb_, jl_, (LAS char*)lds, Sm, wave);
            fox::finish(Sm);
        }
        }
        }
    }
    GRID_SYNC();

    for (int rep_ = 0; rep_ < REPS(16); ++rep_) { if (rep_) GRID_SYNC();
        PHASE_PTRS
        const int tid = opaque_tid(wave), lane = tid & 63;
        const bool tailfill = (G == 256);
        unsigned* cntS = (unsigned*)(ws + 32768 + 512);
        LAS float* RT = (LAS float*)(lds + AUX_OFF);
#define P4_RT(i_, pm_) do { if (tid < 256) { const int row = (pm_) * 256 + tid; float a = 0.f, c = 0.f; \
              _Pragma("unroll") for (int k = 0; k < 16; ++k) a += SSQ1[(size_t)row * 16 + k]; \
              _Pragma("unroll") for (int k = 0; k < 8; ++k) c += SSQ2[(size_t)row * 8 + k]; \
              const float rA = 1.0f / sqrtf(a * (1.0f / 1024.f) + EPS), rB = 1.0f / sqrtf(c * (1.0f / 1024.f) + EPS); \
              RT[((i_) * 256 + tid) * 2] = rA / rB; RT[((i_) * 256 + tid) * 2 + 1] = rB; } } while (0)
        const pg8::Gemm g{MIX, Wout_t, MT, DM, DM, DM};
        if (tailfill) {
            const pg8::OneUnit S1{64 + (bx >> 3), bx & 7, bx < 32};
            if (bx < 32) { P4_RT(0, S1.pm); }
            __syncthreads();
            { EpiOut E{XB, out, X1B, SSQ3, RT}; pg8::gemm_phase<EpiOut, pg8::OneUnit>(lds, g, S1, E, wave); }
            if (bx < 32) slab_done(cntS);
            __syncthreads();
        }
        { pg8::StaticOrder S; S.init(tailfill ? MP : MT, DM, G, bx);
          { pg8::Unit u; for (int i = 0; S.next(i, u); ++i) P4_RT(i, u.pm); }
          __syncthreads();
          EpiOut E{XB, out, X1B, SSQ3, RT};
          pg8::gemm_phase<EpiOut, pg8::StaticOrder>(lds, g, S, E, wave); }
#undef P4_RT
        if (tailfill && bx >= 32 && bx < 160) {
            slab_wait(cntS, 32u);
            const int j = bx - 32; const pg8::OneUnit S2{64 + (j >> 5), j & 31, true};
            LAS float* RT2 = (LAS float*)(lds + AUX_OFF);
            if (tid < 256) { const int row = S2.pm * 256 + tid; float a = 0.f;
#pragma unroll
                for (int k = 0; k < 32; ++k) a += SSQ3[(size_t)row * 32 + k];
                RT2[tid] = 1.0f / sqrtf(a * (1.0f / DM) + EPS); }
            __syncthreads();
            const pg8::Gemm g2{X1B, Wup_t, MT, DFF, DM, DM}; EpiUp E2{Hb, RT2};
            pg8::gemm_phase<EpiUp, pg8::OneUnit>(lds, g2, S2, E2, wave);
        }
        { const int fi = tailfill ? bx - 160 : bx, nfree = tailfill ? 96 : G;
          if (fi >= 0) { const int lane2 = opaque_tid(wave) & 63; LAS float* scr = (LAS float*)(lds + wave * 16384);
              for (int it = fi * 8 + wave; it < 128 * 64; it += nfree * 8) p0_transpose_item(IN(26), DM, DFF, 64, nullptr, nullptr, Wdn_t, scr, it, lane2); } }
    }
    GRID_SYNC();

    for (int rep_ = 0; rep_ < REPS(32); ++rep_) { if (rep_) GRID_SYNC();
        PHASE_PTRS
        const int tid = opaque_tid(wave), lane = tid & 63;
        pg8::StaticOrder S; S.init(G == 256 ? MP : MT, DFF, G, bx);
        LAS float* RT = (LAS float*)(lds + AUX_OFF);
        if (G == 256) {
            const int rowl = tid & 255, hf = wave >> 2; pg8::Unit u; f32x4 sv[4][8];
#pragma unroll
            for (int j = 0; j < 4; ++j) { S.next(2 * j + hf, u); const float* p = SSQ3 + (size_t)(u.pm * 256 + rowl) * 32;
#pragma unroll
                for (int q = 0; q < 8; ++q) sv[j][q] = *(const f32x4*)(p + 4 * q); }
#pragma unroll
            for (int j = 0; j < 4; ++j) asm volatile("" : "+v"(sv[j][0]), "+v"(sv[j][1]), "+v"(sv[j][2]), "+v"(sv[j][3]), "+v"(sv[j][4]), "+v"(sv[j][5]), "+v"(sv[j][6]), "+v"(sv[j][7]));
#pragma unroll
            for (int j = 0; j < 4; ++j) { f32x4 t = sv[j][0];
#pragma unroll
                for (int q = 1; q < 8; ++q) t += sv[j][q];
                RT[(2 * j + hf) * 256 + rowl] = 1.0f / sqrtf(((t[0] + t[1]) + (t[2] + t[3])) * (1.0f / DM) + EPS); }
        } else { pg8::Unit u;
          for (int i = 0; S.next(i, u); ++i) if (tid < 256) { const int row = u.pm * 256 + tid; float a = 0.f;
#pragma unroll
              for (int k = 0; k < 32; ++k) a += SSQ3[(size_t)row * 32 + k];
              RT[i * 256 + tid] = 1.0f / sqrtf(a * (1.0f / DM) + EPS); } }
        __syncthreads();
        pg8::Gemm g{X1B, Wup_t, MT, DFF, DM, DM};
        EpiUp E{Hb, RT};
        pg8::gemm_phase<EpiUp, pg8::StaticOrder>(lds, g, S, E, wave);
    }
    GRID_SYNC();

    if (PHMASK & 64) {
        PHASE_PTRS
        float* SL = (float*)(ws + WS_QKRAW); unsigned* slab_cnt = (unsigned*)(ws + 32768);
        const bool split = (G == 256);
        if (split) { pg8::Gemm g{Hb, Wdn_t, MT, DM, DFF / 8, DFF}; pg8::SplitOrder S{bx, DFF / 8}; EpiDownSlab E{SL, DFF / 8};
            pg8::gemm_phase<EpiDownSlab, pg8::SplitOrder>(lds, g, S, E, wave);
            if (threadIdx.x == 0) { __builtin_amdgcn_fence(__ATOMIC_RELEASE, "agent"); asm volatile("s_waitcnt vmcnt(0)" ::: "memory");
                __hip_atomic_fetch_add(slab_cnt, 1u, __ATOMIC_RELAXED, __HIP_MEMORY_SCOPE_AGENT); } }
        { pg8::Gemm g{Hb, Wdn_t, MT, DM, DFF, DFF}; pg8::StaticOrder S; S.init(split ? MP : MT, DM, G, bx);
          EpiDown E{out, X1B};
          pg8::gemm_phase<EpiDown, pg8::StaticOrder>(lds, g, S, E, wave); }
        if (split) {
            if (threadIdx.x == 0) { unsigned sp = 0; while (__hip_atomic_load(slab_cnt, __ATOMIC_RELAXED, __HIP_MEMORY_SCOPE_AGENT) < 256u) { __builtin_amdgcn_s_sleep(2); if (++sp > (1u << 22)) break; }
                __builtin_amdgcn_fence(__ATOMIC_ACQUIRE, "agent"); asm volatile("s_waitcnt vmcnt(0)" ::: "memory"); }
            __syncthreads();
            const int tid = opaque_tid(wave); const int r = 4 * bx + (tid >> 7);
            u32x2 xw[4]; f32x4 sv[4][8];
#pragma unroll
            for (int j = 0; j < 4; ++j) { const int c = (tid & 127) * 4 + 512 * j; xw[j] = *(const u32x2*)(X1B + (size_t)(MP + r) * DM + c);
#pragma unroll
                for (int s = 0; s < 8; ++s) sv[j][s] = *(const f32x4*)(SL + (size_t)s * (MS * DM) + (size_t)r * DM + c); }
#pragma unroll
            for (int j = 0; j < 4; ++j)
                asm volatile("" : "+v"(xw[j]), "+v"(sv[j][0]), "+v"(sv[j][1]), "+v"(sv[j][2]), "+v"(sv[j][3]), "+v"(sv[j][4]), "+v"(sv[j][5]), "+v"(sv[j][6]), "+v"(sv[j][7]));
#pragma unroll
            for (int j = 0; j < 4; ++j) { const int c = (tid & 127) * 4 + 512 * j; float* yp = out + O_Y + (size_t)(MP + r) * DM + c;
                f32x4 y; y[0] = __builtin_bit_cast(float, xw[j].x << 16); y[1] = __builtin_bit_cast(float, xw[j].x & 0xffff0000u); y[2] = __builtin_bit_cast(float, xw[j].y << 16); y[3] = __builtin_bit_cast(float, xw[j].y & 0xffff0000u);
#pragma unroll
                for (int s = 0; s < 8; ++s) y += sv[j][s];
                *(f32x4*)yp = y; }
        }
    }
}

extern "C" void kernel_launch(void* const* d_in, const int* in_sizes, int n_in, void* d_out, int out_size, void* d_ws, size_t ws_size, hipStream_t stream) {
    static int grid = 0;
    if (grid == 0) {
        if (n_in != 27 || ws_size < WS_TOTAL) { fprintf(stderr, "kernel_launch: unexpected n_in %d / ws_size %zu (need %zu)\n", n_in, ws_size, (size_t)WS_TOTAL); grid = -1; return; }
        int dev = 0, cus = 0, per_cu = 0;
        hipGetDevice(&dev);
        hipDeviceGetAttribute(&cus, hipDeviceAttributeMultiprocessorCount, dev);
        hipFuncSetAttribute((const void*)hymba_fwd, hipFuncAttributeMaxDynamicSharedMemorySize, LDS_BYTES);
        hipOccupancyMaxActiveBlocksPerMultiprocessor(&per_cu, (const void*)hymba_fwd, 512, LDS_BYTES);
        if (per_cu < 1) { fprintf(stderr, "kernel_launch: occupancy query says %d blocks per CU\n", per_cu); per_cu = 1; }
        if (per_cu > 1) per_cu = 1;
        grid = cus * per_cu;
        if (grid != 256) { fprintf(stderr, "kernel_launch: this kernel's work decomposition is written for 256 workgroups (one per CU of a 256-CU device); got %d; nothing launched\n", grid); grid = -1; return; }
        fprintf(stderr, "kernel_launch: grid %d (cus %d), ws %zu\n", grid, cus, ws_size);
    }
    if (grid < 0) return;
    if (hipMemsetAsync(d_ws, 0, 65536, stream) != hipSuccess) { fprintf(stderr, "kernel_launch: hipMemsetAsync failed\n"); return; }
    Args a{};
    for (int i = 0; i < 27; ++i) a.in[i] = (const float*)d_in[i];
    a.out = (float*)d_out; a.ws = (unsigned char*)d_ws;
    void* kargs[] = {&a};
    hipError_t e = hipLaunchCooperativeKernel((const void*)hymba_fwd, dim3(grid), dim3(512), kargs, LDS_BYTES, stream);
    if (e != hipSuccess) fprintf(stderr, "kernel_launch: cooperative launch failed: %s (grid %d)\n", hipGetErrorString(e), grid);
}
```

```cpp
#include <hip/hip_runtime.h>
#include <hip/hip_cooperative_groups.h>
#include <cstdio>
#include <cstdint>
namespace cg = cooperative_groups;
#ifndef PHMASK
#define PHMASK 2047
#endif
#ifndef DBL
#define DBL 0
#endif
#define REPS(bit) (((DBL) & (bit)) ? 2 : 1)

#define LAS __attribute__((address_space(3)))
typedef unsigned short bf16;
typedef short bf16x8 __attribute__((ext_vector_type(8)));
typedef short s16x4 __attribute__((ext_vector_type(4)));
typedef float f32x4 __attribute__((ext_vector_type(4)));
typedef float f32x16 __attribute__((ext_vector_type(16)));
typedef unsigned u32x4 __attribute__((ext_vector_type(4)));
typedef unsigned u32x2 __attribute__((ext_vector_type(2)));

constexpr int DM = 2048, MP = 16384, MS = 1024, MT = MP + MS, SEQ = 8192, NH = 8, HD = 128, DSSM = 1024, DATT = 1024, DFF = 8192;
constexpr int NINW = 4104, PAST = 2048, DSEQ = 32, DB = 32, NG = 64, NP = 64;
constexpr float EPS = 1e-6f;
constexpr float LOG2E = 1.4426950408889634f;
constexpr float QSCALE = 0.08838834764831845f * 1.4426950408889634f;

constexpr size_t O_Y = 0, O_KP = 35651584, O_VP = 52428800, O_LFP = 69206016, O_HRP = 69337088, O_HIP = 69345280,
                 O_KS = 69353472, O_VS = 70402048, O_LFS = 71450624, O_HRS = 71458816, O_HIS = 71589888;

constexpr size_t MiB = 1u << 20;
constexpr size_t WS_WIN = 1 * MiB;
constexpr size_t WS_WGLU = 17 * MiB;
constexpr size_t WS_WOUT = 19 * MiB;
constexpr size_t WS_WUP = 27 * MiB;
constexpr size_t WS_WDN = 59 * MiB;
constexpr size_t WS_SMALL = 91 * MiB;
constexpr size_t WS_XB = 96 * MiB;
constexpr size_t WS_U = 164 * MiB;
constexpr size_t WS_QKRAW = 198 * MiB;
constexpr size_t WS_QH = 334 * MiB;
constexpr size_t WS_KH = 368 * MiB;
constexpr size_t WS_VH = 402 * MiB;
constexpr size_t WS_GY = 436 * MiB;
constexpr size_t WS_MIX = 470 * MiB;
constexpr size_t WS_X1B = 538 * MiB;
constexpr size_t WS_H = 606 * MiB;
constexpr size_t WS_END = 878 * MiB;
constexpr size_t SM_RS1 = 0;
constexpr size_t SM_ABAR = 128 * 1024;
constexpr size_t SM_APOW = 192 * 1024;
constexpr size_t SM_CLF = 4 * MiB;
constexpr size_t SM_S5EX = 3 * MiB;
constexpr size_t SM_BMT = 256 * 1024;
constexpr size_t SM_CMT = 512 * 1024;
constexpr size_t SM_SSQ1 = 1 * MiB;
constexpr size_t SM_SSQ2 = 2 * MiB + 256 * 1024;
constexpr size_t SM_SSQ3 = 3 * MiB;
constexpr size_t WS_CLK = 878 * MiB;
constexpr size_t WS_CLQ = 882 * MiB;
constexpr size_t WS_SSQ3 = 886 * MiB;
constexpr size_t WS_TOTAL = 890 * MiB;

constexpr int RING_BYTES = 131072, AUX_OFF = 131072, AUX_BYTES = 32768, LDS_BYTES = 163840;

__device__ __forceinline__ int opaque_tid(int wave) { int t = (wave << 6) | (int)__builtin_amdgcn_mbcnt_hi(~0u, __builtin_amdgcn_mbcnt_lo(~0u, 0u)); asm volatile("" : "+v"(t)); return t; }
__device__ __forceinline__ unsigned f2bf(float f) { unsigned u = __builtin_bit_cast(unsigned, f); return (u + 0x7fffu + ((u >> 16) & 1u)) >> 16; }
__device__ __forceinline__ float bf2f(unsigned short b) { return __builtin_bit_cast(float, (unsigned)b << 16); }
__device__ __forceinline__ unsigned pk2(float lo, float hi) { return f2bf(lo) | (f2bf(hi) << 16); }
__device__ __forceinline__ unsigned cvtpk(float lo, float hi) { unsigned r; asm volatile("v_cvt_pk_bf16_f32 %0, %1, %2" : "=v"(r) : "v"(lo), "v"(hi)); return r; }
__device__ __forceinline__ unsigned cvtpk_nv(float lo, float hi) { unsigned r; asm("v_cvt_pk_bf16_f32 %0, %1, %2" : "=v"(r) : "v"(lo), "v"(hi)); return r; }
__device__ __forceinline__ bf16x8 pack8(f32x4 a, f32x4 b) { u32x4 w = {cvtpk(a[0], a[1]), cvtpk(a[2], a[3]), cvtpk(b[0], b[1]), cvtpk(b[2], b[3])}; return __builtin_bit_cast(bf16x8, w); }
__device__ __forceinline__ void st16_wt(void* p, u32x4 v) { asm volatile("global_store_dwordx4 %0, %1, off sc1\n\ts_nop 1" :: "v"(p), "v"(v) : "memory"); }
template <int K> __device__ __forceinline__ float lane_xor(float v) {
    return __builtin_bit_cast(float, __builtin_amdgcn_ds_swizzle(__builtin_bit_cast(int, v), (K << 10) | 0x1f));
}
__device__ __forceinline__ float half_swap_add(float v) { auto rr = __builtin_amdgcn_permlane32_swap(__float_as_uint(v), __float_as_uint(v), false, false); return __uint_as_float(rr[0]) + __uint_as_float(rr[1]); }
__device__ __forceinline__ float half_swap_max(float v) { auto rr = __builtin_amdgcn_permlane32_swap(__float_as_uint(v), __float_as_uint(v), false, false); return fmaxf(__uint_as_float(rr[0]), __uint_as_float(rr[1])); }
__device__ __forceinline__ float sum32(float v) { v += lane_xor<1>(v); v += lane_xor<2>(v); v += lane_xor<4>(v); v += lane_xor<8>(v); v += lane_xor<16>(v); return v; }
__device__ __forceinline__ float max32(float v) { v = fmaxf(v, lane_xor<1>(v)); v = fmaxf(v, lane_xor<2>(v)); v = fmaxf(v, lane_xor<4>(v)); v = fmaxf(v, lane_xor<8>(v)); v = fmaxf(v, lane_xor<16>(v)); return v; }
__device__ __forceinline__ float wave_sum(float v) { return half_swap_add(sum32(v)); }
__device__ __forceinline__ float wave_max(float v) { return half_swap_max(max32(v)); }
__device__ __forceinline__ int wave_min_i(int v) {
#define SWZI(K) v = min(v, __builtin_amdgcn_ds_swizzle(v, ((K) << 10) | 0x1f))
    SWZI(1); SWZI(2); SWZI(4); SWZI(8); SWZI(16);
#undef SWZI
    auto rr = __builtin_amdgcn_permlane32_swap((unsigned)v, (unsigned)v, false, false); return min((int)rr[0], (int)rr[1]);
}
__device__ __forceinline__ float wave_incl_scan(float v) {
#define DPPADD(ctrl, rmask) v += __builtin_bit_cast(float, __builtin_amdgcn_update_dpp(0, __builtin_bit_cast(int, v), ctrl, rmask, 0xf, false))
    DPPADD(0x111, 0xf); DPPADD(0x112, 0xf); DPPADD(0x114, 0xf); DPPADD(0x118, 0xf); DPPADD(0x142, 0xa); DPPADD(0x143, 0xc);
#undef DPPADD
    return v;
}
__device__ __forceinline__ float gelu_tanh(float y) {
    const float t = 0.7978845608028654f * (y + 0.044715f * y * y * y);
    const float e = __builtin_amdgcn_exp2f(-2.0f * LOG2E * fabsf(t));
    float th = (1.0f - e) * __builtin_amdgcn_rcpf(1.0f + e); th = t < 0.f ? -th : th;
    return 0.5f * y * (1.0f + th);
}
__device__ __forceinline__ float sigmoidf_(float x) { return __builtin_amdgcn_rcpf(1.0f + __builtin_amdgcn_exp2f(-LOG2E * x)); }
__device__ __forceinline__ float log_sigmoidf_(float z) { return fminf(z, 0.f) - log1pf(expf(-fabsf(z))); }

namespace pg8 {
#define PG8_LAS __attribute__((address_space(3)))
typedef unsigned short bf16_t;
constexpr int BM = 256, BK = 64, HALF = 128, HTB = HALF * BK * 2, STAGE_BYTES = 8 * HTB, NXCD = 8, WGM = 4;
__host__ __device__ __forceinline__ int lds_byte(int r, int c) { const int st = (r >> 4) * 2 + (c >> 5), rr = r & 15, cc = c & 31, ob = rr * 64 + cc * 2; return st * 1024 + (ob ^ (((ob >> 9) & 1) << 5)); }
__host__ __device__ __forceinline__ void stage_rc(int b, int& R, int& C) { const int st = b / 1024, sb = b % 1024, swz = sb ^ (((sb >> 9) & 1) << 5); R = (st >> 1) * 16 + swz / 64; C = (st & 1) * 32 + (swz % 64) / 2; }
__host__ __device__ __forceinline__ int perm32(int rho) { const int n = rho >> 4, i = rho & 15; return 8 * (i >> 2) + 4 * n + (i & 3); }
struct Unit { int pm, pn, ko; };
struct Gemm { const bf16_t* A; const bf16_t* Bt; int M, N, K, ld; };
struct StaticOrder {
    int nM, nN, nwg, G, c;
    __host__ __device__ __forceinline__ void init(int M, int N, int G_, int c_) { nM = M / BM; nN = N / BM; nwg = nM * nN; G = G_; c = c_; }
    __host__ __device__ __forceinline__ bool next(int i, Unit& u) const {
        const long L = (long)i * G + c; if (L >= nwg) return false;
        int wgid = (int)L; { const int q = nwg / NXCD, r = nwg % NXCD, xcd = wgid % NXCD, off = wgid / NXCD; wgid = (xcd < r ? xcd * (q + 1) : r * (q + 1) + (xcd - r) * q) + off; }
        const int nig = WGM * nN, gid = wgid / nig, fm = gid * WGM, gsz = (nM - fm) < WGM ? (nM - fm) : WGM;
        u.pm = fm + ((wgid % nig) % gsz); u.pn = (wgid % nig) / gsz; u.ko = 0; return true;
    }
};
struct SplitOrder {
    int c, kslice;
    __host__ __device__ __forceinline__ bool next(int i, Unit& u) const { if (i > 0 || c >= 256) return false; u.pm = 64 + (c >> 6); u.pn = (c >> 3) & 7; u.ko = (c & 7) * kslice; return true; }
};
struct OneUnit {
    int pm, pn; bool on;
    __host__ __device__ __forceinline__ bool next(int i, Unit& u) const { if (i > 0 || !on) return false; u.pm = pm; u.pn = pn; u.ko = 0; return true; }
};
template <class Epi, class Sched, bool ALIGN_EPI = true, bool SP2 = true>
__device__ __forceinline__ void gemm_phase(PG8_LAS unsigned char* lds, const Gemm g, const Sched& S, const Epi& E, const int wave) {
    const int tid = opaque_tid(wave), wid = wave, lane = tid & 63, wr = wid >> 2, wc = wid & 3, fr = lane & 15, fq = lane >> 4;
    const int K = g.K, nt = K / BK;
    unsigned voffA[2], voffB[2];
#pragma unroll
    for (int i = 0; i < 2; ++i) { int R, C; stage_rc(tid * 16 + i * 8192, R, C); const int Rb = Epi::PERM ? ((R & ~31) + perm32(R & 31)) : R;
        voffA[i] = (unsigned)(R * g.ld + C) * 2u; voffB[i] = (unsigned)(Rb * g.ld + C) * 2u; }
    const size_t kstep = (size_t)(BK * 2);
    const size_t hstep = (size_t)HALF * g.ld * 2;
    const size_t tstep = 2 * hstep;
    const unsigned ldsw = (unsigned)wid * 1024u;
    const int aoff = lds_byte(wr * 64 + fr, fq * 8), boff = lds_byte(wc * 32 + fr, fq * 8);
#define PG8_SA(b, h) (((b) * 2 + (h)) * HTB)
#define PG8_SB(b, h) ((4 + (b) * 2 + (h)) * HTB)
#define PG8_STAGE(bufoff, gbase, voff) do { _Pragma("unroll") for (int _i = 0; _i < 2; ++_i) \
        __builtin_amdgcn_global_load_lds((const unsigned*)((const char*)(gbase) + (voff)[_i]), (PG8_LAS unsigned*)(lds + (bufoff) + ldsw + _i * 8192), 16, 0, 0); } while (0)
#define PG8_LDA(dst, b, h) do { _Pragma("unroll") for (int m = 0; m < 4; ++m) _Pragma("unroll") for (int k = 0; k < 2; ++k) dst[m][k] = *(const PG8_LAS bf16x8*)(lds + PG8_SA(b, h) + aoff + m * 2048 + k * 1024); } while (0)
#define PG8_LDB(dst, b, h) do { _Pragma("unroll") for (int n = 0; n < 2; ++n) _Pragma("unroll") for (int k = 0; k < 2; ++k) dst[n][k] = *(const PG8_LAS bf16x8*)(lds + PG8_SB(b, h) + boff + n * 2048 + k * 1024); } while (0)
#define PG8_MMA(ai, bj, At, Bt) do { __builtin_amdgcn_s_setprio(1); _Pragma("unroll") for (int m = 0; m < 4; ++m) _Pragma("unroll") for (int n = 0; n < 2; ++n) _Pragma("unroll") for (int k = 0; k < 2; ++k) \
        acc[ai][bj][m][n] = __builtin_amdgcn_mfma_f32_16x16x32_bf16(Bt[n][k], At[m][k], acc[ai][bj][m][n], 0, 0, 0); __builtin_amdgcn_s_setprio(0); } while (0)
#define PG8_WAIT_V(n) asm volatile("s_waitcnt vmcnt(" #n ")" ::: "memory")
#define PG8_WAIT_L(n) asm volatile("s_waitcnt lgkmcnt(" #n ")" ::: "memory")
#define PG8_BAR __builtin_amdgcn_s_barrier()
#define PG8_SCHED __builtin_amdgcn_sched_barrier(0)
    Unit cur, nxt; int ui = 0;
    if (!S.next(0, cur)) return;
    f32x4 acc[2][2][4][2];
#pragma unroll
    for (int a = 0; a < 2; ++a)
#pragma unroll
        for (int b = 0; b < 2; ++b)
#pragma unroll
            for (int m = 0; m < 4; ++m)
#pragma unroll
                for (int n = 0; n < 2; ++n) acc[a][b][m][n] = (f32x4){0.f, 0.f, 0.f, 0.f};
    bf16x8 At[4][2], B0[2][2], B1[2][2];
    const char* cA = (const char*)g.A + (size_t)cur.pm * tstep + (size_t)cur.ko * 2; const char* cB = (const char*)g.Bt + (size_t)cur.pn * tstep + (size_t)cur.ko * 2;
    {
        PG8_STAGE(PG8_SB(0, 0), cB, voffB); PG8_STAGE(PG8_SB(0, 1), cB + hstep, voffB); PG8_STAGE(PG8_SA(0, 0), cA, voffA); PG8_STAGE(PG8_SA(0, 1), cA + hstep, voffA);
        if (wr == 1) PG8_BAR;
        PG8_WAIT_V(2); PG8_BAR;
        PG8_STAGE(PG8_SB(1, 0), cB + kstep, voffB); PG8_STAGE(PG8_SA(1, 0), cA + kstep, voffA); PG8_STAGE(PG8_SB(1, 1), cB + hstep + kstep, voffB);
        PG8_WAIT_V(6); PG8_BAR;
    }
    for (;;) {
        const bool has_next = S.next(ui + 1, nxt);
        const char* nA = has_next ? (const char*)g.A + (size_t)nxt.pm * tstep + (size_t)nxt.ko * 2 : cA; const char* nB = has_next ? (const char*)g.Bt + (size_t)nxt.pn * tstep + (size_t)nxt.ko * 2 : cB;
        for (int t = 0; t < nt; t += 2) {
            const bool last = (t == nt - 2);
            const char* a1 = cA + (size_t)(t + 1) * kstep;
            const char* a2 = last ? nA : cA + (size_t)(t + 2) * kstep; const char* b2 = last ? nB : cB + (size_t)(t + 2) * kstep;
            const char* a3 = a2 + kstep; const char* b3 = b2 + kstep;
            if constexpr (Epi::HAS_MID) { if (t == (nt >> 1)) E.mid(acc, ui, wr, fr); }
            PG8_LDB(B0, 0, 0); PG8_LDB(B1, 0, 1); PG8_SCHED; PG8_LDA(At, 0, 0); PG8_STAGE(PG8_SA(1, 1), a1 + hstep, voffA);
            PG8_WAIT_V(8); PG8_WAIT_L(0); PG8_BAR; PG8_MMA(0, 0, At, B0); PG8_MMA(0, 1, At, B1); PG8_BAR; PG8_SCHED;
            PG8_LDA(At, 0, 1); PG8_STAGE(PG8_SB(0, 0), b2, voffB); PG8_STAGE(PG8_SB(0, 1), b2 + hstep, voffB); PG8_STAGE(PG8_SA(0, 0), a2, voffA);
            PG8_WAIT_V(8); PG8_WAIT_L(0); PG8_BAR; PG8_MMA(1, 0, At, B0); PG8_MMA(1, 1, At, B1); PG8_BAR; PG8_SCHED;
            PG8_LDB(B0, 1, 0); PG8_LDB(B1, 1, 1); PG8_SCHED; PG8_LDA(At, 1, 0); PG8_STAGE(PG8_SA(0, 1), a2 + hstep, voffA);
            PG8_WAIT_V(8); PG8_WAIT_L(0); PG8_BAR; PG8_MMA(0, 0, At, B0); PG8_MMA(0, 1, At, B1); PG8_BAR; PG8_SCHED;
            PG8_LDA(At, 1, 1); PG8_STAGE(PG8_SB(1, 0), b3, voffB); PG8_STAGE(PG8_SB(1, 1), b3 + hstep, voffB); PG8_STAGE(PG8_SA(1, 0), a3, voffA);
            PG8_WAIT_V(8); PG8_WAIT_L(0); PG8_BAR; PG8_MMA(1, 0, At, B0); PG8_MMA(1, 1, At, B1); PG8_BAR; PG8_SCHED;
        }
        if constexpr (ALIGN_EPI) { if (wr == 0) PG8_BAR; }
        E(acc, cur, ui, wr, wc, fr, fq);
        if (!has_next) break;
#pragma unroll
        for (int a = 0; a < 2; ++a)
#pragma unroll
            for (int b = 0; b < 2; ++b)
#pragma unroll
                for (int m = 0; m < 4; ++m)
#pragma unroll
                    for (int n = 0; n < 2; ++n) acc[a][b][m][n] = (f32x4){0.f, 0.f, 0.f, 0.f};
        cur = nxt; cA = nA; cB = nB; ++ui;
        if constexpr (ALIGN_EPI) { if (wr == 1) PG8_BAR; }
    }
    PG8_WAIT_V(0);
    if constexpr (!ALIGN_EPI) { if (wr == 0) PG8_BAR; }
    PG8_BAR;
#undef PG8_SA
#undef PG8_SB
#undef PG8_STAGE
#undef PG8_LDA
#undef PG8_LDB
#undef PG8_MMA
#undef PG8_WAIT_V
#undef PG8_WAIT_L
#undef PG8_BAR
#undef PG8_SCHED
}
}

struct Args {
    const float* in[27];
    float* out;
    unsigned char* ws;
};

__device__ __forceinline__ size_t headmajor_off_u(bool smp, int m, int h) {
    if (!smp) { const int b = m >> 13, t = m & 8191; return ((size_t)(b * NH + h) * SEQ + t) * HD; }
    const int ms = m - MP, n = ms >> 5, i = ms & 31; return (size_t)2 * NH * SEQ * HD + ((size_t)(n * NH + h) * DSEQ + i) * HD;
}
__device__ __forceinline__ size_t headmajor_off(int m, int h) {
    if (m < MP) { const int b = m >> 13, t = m & 8191; return ((size_t)(b * NH + h) * SEQ + t) * HD; }
    const int ms = m - MP, n = ms >> 5, i = ms & 31; return (size_t)2 * NH * SEQ * HD + ((size_t)(n * NH + h) * DSEQ + i) * HD;
}

struct EpiIn {
    static constexpr bool PERM = true, HAS_MID = false;
    const float* rs1; bf16* U; float* out; bf16* Qh; bf16* Kh; bf16* Vh; const float* gq; const float* gk; LAS float* RED;
    __device__ __forceinline__ void operator()(const f32x4 (&acc)[2][2][4][2], const pg8::Unit& u, int ui, int wr, int wc, int fr, int fq) const {
        asm volatile("" : "+v"(fr), "+v"(fq));
        const int row0 = u.pm * 256 + wr * 64 + fr, colb = u.pn * 256 + wc * 32 + 8 * fq;
        const bool smp = u.pm >= MP / 256;
        float* outv = out + (u.pm < MP / 256 ? (size_t)O_VP : (size_t)O_VS - (size_t)MP * 1024); float* outk = out + (u.pm < MP / 256 ? (size_t)O_KP : (size_t)O_KS - (size_t)MP * 1024);
        float rsv[2][4];
#pragma unroll
        for (int ai = 0; ai < 2; ++ai)
#pragma unroll
            for (int m = 0; m < 4; ++m) rsv[ai][m] = rs1[row0 + ai * 128 + m * 16];
        asm volatile("" : "+v"(rsv[0][0]), "+v"(rsv[0][1]), "+v"(rsv[0][2]), "+v"(rsv[0][3]), "+v"(rsv[1][0]), "+v"(rsv[1][1]), "+v"(rsv[1][2]), "+v"(rsv[1][3]));
        if (u.pn < 4 || u.pn >= 12) {
#pragma unroll
            for (int ai = 0; ai < 2; ++ai)
#pragma unroll
                for (int m = 0; m < 4; ++m) {
                    const int row = row0 + ai * 128 + m * 16; const float rs = rsv[ai][m];
#pragma unroll
                    for (int bj = 0; bj < 2; ++bj) {
                        const int col = colb + bj * 128; const f32x4 v0 = acc[ai][bj][m][0] * rs, v1 = acc[ai][bj][m][1] * rs;
                        if (u.pn < 4) { *(bf16x8*)(U + (size_t)row * DSSM + col) = pack8(v0, v1); }
                        else { const int c = col - 3072, h = c >> 7, d = c & 127;
                            float* p = outv + (size_t)row * 1024 + c; *(f32x4*)p = v0; *(f32x4*)(p + 4) = v1;
                            *(bf16x8*)(Vh + headmajor_off_u(smp, row, h) + d) = pack8(v0, v1); }
                    }
                }
        } else {
#pragma unroll
            for (int ai = 0; ai < 2; ++ai)
#pragma unroll
                for (int m = 0; m < 4; ++m)
#pragma unroll
                    for (int bj = 0; bj < 2; ++bj) { const f32x4 a = acc[ai][bj][m][0], b = acc[ai][bj][m][1];
                        float s = (a[0] * a[0] + a[1] * a[1]) + (a[2] * a[2] + a[3] * a[3]) + (b[0] * b[0] + b[1] * b[1]) + (b[2] * b[2] + b[3] * b[3]);
                        s += lane_xor<16>(s); s = half_swap_add(s);
                        if (fq == 0) RED[((ai * 128 + wr * 64 + m * 16 + fr) * 2 + bj) * 4 + wc] = s; }
            asm volatile("s_waitcnt lgkmcnt(0)" ::: "memory"); __builtin_amdgcn_s_barrier(); asm volatile("" ::: "memory");
            const bool isq = u.pn < 8; const float* g = isq ? gq : gk; const int hb = ((u.pn - (isq ? 4 : 8)) * 2);
            const f32x4 g0 = *(const f32x4*)(g + wc * 32 + 8 * fq), g1 = *(const f32x4*)(g + wc * 32 + 8 * fq + 4);
#pragma unroll
            for (int ai = 0; ai < 2; ++ai)
#pragma unroll
                for (int m = 0; m < 4; ++m) {
                    const int rl = ai * 128 + wr * 64 + m * 16 + fr, row = u.pm * 256 + rl; const float rs = rsv[ai][m];
#pragma unroll
                    for (int bj = 0; bj < 2; ++bj) {
                        const f32x4 t = *(const LAS f32x4*)(RED + (rl * 2 + bj) * 4); const float tot = ((t[0] + t[1]) + (t[2] + t[3])) * rs * rs;
                        const float rn = rs * __builtin_amdgcn_rsqf(tot * (1.0f / HD) + EPS);
                        const int h = hb + bj, d = wc * 32 + 8 * fq;
                        f32x4 v0 = acc[ai][bj][m][0] * rn * g0, v1 = acc[ai][bj][m][1] * rn * g1;
                        if (isq) { v0 = v0 * QSCALE; v1 = v1 * QSCALE; *(bf16x8*)(Qh + headmajor_off_u(smp, row, h) + d) = pack8(v0, v1); }
                        else { float* p = outk + (size_t)row * 1024 + h * HD + d; *(f32x4*)p = v0; *(f32x4*)(p + 4) = v1;
                            *(bf16x8*)(Kh + headmajor_off_u(smp, row, h) + d) = pack8(v0, v1); }
                    }
                }
        }
    }
};
struct EpiGlu {
    static constexpr bool PERM = true, HAS_MID = false;
    const bf16* GY; bf16* MIX; float* SSQ1;
    __device__ __forceinline__ void operator()(const f32x4 (&acc)[2][2][4][2], const pg8::Unit& u, int ui, int wr, int wc, int fr, int fq) const {
        asm volatile("" : "+v"(fr), "+v"(fq));
        const int row0 = u.pm * 256 + wr * 64 + fr, colb = u.pn * 256 + wc * 32 + 8 * fq;
        bf16x8 gvv[2][4][2];
#pragma unroll
        for (int ai = 0; ai < 2; ++ai)
#pragma unroll
            for (int m = 0; m < 4; ++m)
#pragma unroll
                for (int bj = 0; bj < 2; ++bj) gvv[ai][m][bj] = *(const bf16x8*)(GY + (size_t)(row0 + ai * 128 + m * 16) * DSSM + colb + bj * 128);
        asm volatile("" : "+v"(gvv[0][0][0]), "+v"(gvv[0][0][1]), "+v"(gvv[0][1][0]), "+v"(gvv[0][1][1]), "+v"(gvv[0][2][0]), "+v"(gvv[0][2][1]), "+v"(gvv[0][3][0]), "+v"(gvv[0][3][1]),
                          "+v"(gvv[1][0][0]), "+v"(gvv[1][0][1]), "+v"(gvv[1][1][0]), "+v"(gvv[1][1][1]), "+v"(gvv[1][2][0]), "+v"(gvv[1][2][1]), "+v"(gvv[1][3][0]), "+v"(gvv[1][3][1]));
#pragma unroll
        for (int ai = 0; ai < 2; ++ai)
#pragma unroll
            for (int m = 0; m < 4; ++m) {
                const int row = row0 + ai * 128 + m * 16; float ssq = 0.f;
#pragma unroll
                for (int bj = 0; bj < 2; ++bj) {
                    const int col = colb + bj * 128; const bf16x8 gv = gvv[ai][m][bj];
                    f32x4 o0, o1;
#pragma unroll
                    for (int e = 0; e < 4; ++e) { o0[e] = bf2f((unsigned short)gv[e]) * sigmoidf_(acc[ai][bj][m][0][e]); o1[e] = bf2f((unsigned short)gv[4 + e]) * sigmoidf_(acc[ai][bj][m][1][e]);
                        ssq += o0[e] * o0[e] + o1[e] * o1[e]; }
                    *(bf16x8*)(MIX + (size_t)row * DM + col) = pack8(o0, o1);
                }
                ssq += lane_xor<16>(ssq); ssq = half_swap_add(ssq);
                if (fq == 0) SSQ1[(size_t)row * 16 + u.pn * 4 + wc] = ssq;
            }
    }
};
struct EpiOut {
    static constexpr bool PERM = true, HAS_MID = true;
    const bf16* XBr; float* out; bf16* X1B; float* SSQ3; const LAS float* RT; bool wt;
    __device__ __forceinline__ void mid(f32x4 (&acc)[2][2][4][2], int ui, int wr, int fr) const {
        asm volatile("" : "+v"(fr));
#pragma unroll
        for (int ai = 0; ai < 2; ++ai)
#pragma unroll
            for (int m = 0; m < 4; ++m) { const float r = RT[(ui * 256 + ai * 128 + wr * 64 + m * 16 + fr) * 2];
#pragma unroll
                for (int bj = 0; bj < 2; ++bj)
#pragma unroll
                    for (int n = 0; n < 2; ++n) acc[ai][bj][m][n] *= r; }
    }
    __device__ __forceinline__ void operator()(const f32x4 (&acc)[2][2][4][2], const pg8::Unit& u, int ui, int wr, int wc, int fr, int fq) const {
        asm volatile("" : "+v"(fr), "+v"(fq));
        const int col0 = u.pn * 256 + wc * 32 + 8 * fq;
        u32x4 xv[2][4][2];
#pragma unroll
        for (int ai = 0; ai < 2; ++ai)
#pragma unroll
            for (int m = 0; m < 4; ++m) { const bf16* xrow = XBr + (size_t)(u.pm * 256 + ai * 128 + wr * 64 + m * 16 + fr) * DM;
#pragma unroll
                for (int bj = 0; bj < 2; ++bj) xv[ai][m][bj] = *(const u32x4*)(xrow + col0 + bj * 128); }
        asm volatile("" : "+v"(xv[0][0][0]), "+v"(xv[0][0][1]), "+v"(xv[0][1][0]), "+v"(xv[0][1][1]), "+v"(xv[0][2][0]), "+v"(xv[0][2][1]), "+v"(xv[0][3][0]), "+v"(xv[0][3][1]),
                          "+v"(xv[1][0][0]), "+v"(xv[1][0][1]), "+v"(xv[1][1][0]), "+v"(xv[1][1][1]), "+v"(xv[1][2][0]), "+v"(xv[1][2][1]), "+v"(xv[1][3][0]), "+v"(xv[1][3][1]));
#pragma unroll
        for (int ai = 0; ai < 2; ++ai) { float ssel = 0.f;
#pragma unroll
            for (int m = 0; m < 4; ++m) {
                const int rl = ai * 128 + wr * 64 + m * 16 + fr, row = u.pm * 256 + rl; const float rB = RT[(ui * 256 + rl) * 2 + 1];
                float ssq = 0.f;
#pragma unroll
                for (int bj = 0; bj < 2; ++bj) { const u32x4 xw = xv[ai][m][bj]; u32x4 w;
#pragma unroll
                    for (int n = 0; n < 2; ++n) { const unsigned w0 = xw[2 * n], w1 = xw[2 * n + 1];
                        f32x4 xf; xf[0] = __builtin_bit_cast(float, w0 << 16); xf[1] = __builtin_bit_cast(float, w0 & 0xffff0000u); xf[2] = __builtin_bit_cast(float, w1 << 16); xf[3] = __builtin_bit_cast(float, w1 & 0xffff0000u);
                        const f32x4 x1 = xf + acc[ai][bj][m][n] * rB;
                        w[2 * n] = cvtpk(x1[0], x1[1]); w[2 * n + 1] = cvtpk(x1[2], x1[3]);
                        ssq += (x1[0] * x1[0] + x1[1] * x1[1]) + (x1[2] * x1[2] + x1[3] * x1[3]); }
                    if (wt) st16_wt(X1B + (size_t)row * DM + col0 + bj * 128, w); else *(u32x4*)(X1B + (size_t)row * DM + col0 + bj * 128) = w; }
                ssq += lane_xor<16>(ssq); ssq = half_swap_add(ssq);
                ssel = (fq == m) ? ssq : ssel;
            }
            { float* sp_ = SSQ3 + (size_t)(u.pm * 256 + ai * 128 + wr * 64 + fq * 16 + fr) * 32 + u.pn * 4 + wc;
              if (wt) __hip_atomic_store(sp_, ssel, __ATOMIC_RELAXED, __HIP_MEMORY_SCOPE_AGENT); else *sp_ = ssel; } }
    }
};
struct EpiUp {
    static constexpr bool PERM = true, HAS_MID = false;
    bf16* H; const LAS float* RT;
    __device__ __forceinline__ void operator()(const f32x4 (&acc)[2][2][4][2], const pg8::Unit& u, int ui, int wr, int wc, int fr, int fq) const {
        asm volatile("" : "+v"(fr), "+v"(fq));
        const int colb = u.pn * 256 + wc * 32 + 8 * fq;
#pragma unroll
        for (int ai = 0; ai < 2; ++ai)
#pragma unroll
            for (int m = 0; m < 4; ++m) {
                const int rl = ai * 128 + wr * 64 + m * 16 + fr, row = u.pm * 256 + rl; const float rs = RT[ui * 256 + rl];
#pragma unroll
                for (int bj = 0; bj < 2; ++bj) { f32x4 v0 = acc[ai][bj][m][0] * rs, v1 = acc[ai][bj][m][1] * rs;
#pragma unroll
                    for (int e = 0; e < 4; ++e) { const float a = fmaxf(v0[e], 0.f), b = fmaxf(v1[e], 0.f); v0[e] = a * a; v1[e] = b * b; }
                    st16_wt(H + (size_t)row * DFF + colb + bj * 128, __builtin_bit_cast(u32x4, pack8(v0, v1))); }
            }
    }
};
struct EpiDown {
    static constexpr bool PERM = false, HAS_MID = false;
    float* out; const bf16* X1B;
    __device__ __forceinline__ void operator()(const f32x4 (&acc)[2][2][4][2], const pg8::Unit& u, int ui, int wr, int wc, int fr, int fq) const {
        asm volatile("" : "+v"(fr), "+v"(fq));
        const int row0 = u.pm * 256 + wr * 64 + fr, col0 = u.pn * 256 + wc * 32 + 4 * fq;
        u32x2 wv[2][4][2][2];
#pragma unroll
        for (int ai = 0; ai < 2; ++ai)
#pragma unroll
            for (int m = 0; m < 4; ++m)
#pragma unroll
                for (int bj = 0; bj < 2; ++bj)
#pragma unroll
                    for (int n = 0; n < 2; ++n) wv[ai][m][bj][n] = *(const u32x2*)(X1B + (size_t)(row0 + ai * 128 + m * 16) * DM + col0 + bj * 128 + n * 16);
#pragma unroll
        for (int ai = 0; ai < 2; ++ai)
            asm volatile("" : "+v"(wv[ai][0][0][0]), "+v"(wv[ai][0][0][1]), "+v"(wv[ai][0][1][0]), "+v"(wv[ai][0][1][1]), "+v"(wv[ai][1][0][0]), "+v"(wv[ai][1][0][1]), "+v"(wv[ai][1][1][0]), "+v"(wv[ai][1][1][1]),
                              "+v"(wv[ai][2][0][0]), "+v"(wv[ai][2][0][1]), "+v"(wv[ai][2][1][0]), "+v"(wv[ai][2][1][1]), "+v"(wv[ai][3][0][0]), "+v"(wv[ai][3][0][1]), "+v"(wv[ai][3][1][0]), "+v"(wv[ai][3][1][1]));
#pragma unroll
        for (int ai = 0; ai < 2; ++ai)
#pragma unroll
            for (int m = 0; m < 4; ++m) { const size_t ro = (size_t)(row0 + ai * 128 + m * 16) * DM + col0;
#pragma unroll
                for (int bj = 0; bj < 2; ++bj)
#pragma unroll
                    for (int n = 0; n < 2; ++n) { const size_t o = ro + bj * 128 + n * 16; const u32x2 w = wv[ai][m][bj][n];
                        f32x4 x1; x1[0] = __builtin_bit_cast(float, w.x << 16); x1[1] = __builtin_bit_cast(float, w.x & 0xffff0000u); x1[2] = __builtin_bit_cast(float, w.y << 16); x1[3] = __builtin_bit_cast(float, w.y & 0xffff0000u);
                        *(f32x4*)(out + O_Y + o) = x1 + acc[ai][bj][m][n]; } }
    }
};
struct EpiDownSlab {
    static constexpr bool PERM = false, HAS_MID = false;
    float* SL; int kslice;
    __device__ __forceinline__ void operator()(const f32x4 (&acc)[2][2][4][2], const pg8::Unit& u, int ui, int wr, int wc, int fr, int fq) const {
        asm volatile("" : "+v"(fr), "+v"(fq));
        const int row0 = (u.pm - 64) * 256 + wr * 64 + fr, col0 = u.pn * 256 + wc * 32 + 4 * fq;
        float* base = SL + (size_t)(u.ko / kslice) * (MS * DM);
#pragma unroll
        for (int ai = 0; ai < 2; ++ai)
#pragma unroll
            for (int m = 0; m < 4; ++m) { float* rowp = base + (size_t)(row0 + ai * 128 + m * 16) * DM + col0;
#pragma unroll
                for (int bj = 0; bj < 2; ++bj)
#pragma unroll
                    for (int n = 0; n < 2; ++n) st16_wt(rowp + bj * 128 + n * 16, __builtin_bit_cast(u32x4, acc[ai][bj][m][n])); }
    }
};
__device__ __forceinline__ void slab_done(unsigned* cnt) {
    if (threadIdx.x == 0) { __builtin_amdgcn_fence(__ATOMIC_RELEASE, "agent"); asm volatile("s_waitcnt vmcnt(0)" ::: "memory"); __hip_atomic_fetch_add(cnt, 1u, __ATOMIC_RELAXED, __HIP_MEMORY_SCOPE_AGENT); }
}
__device__ __forceinline__ void slab_wait(unsigned* cnt, unsigned need) {
    if (threadIdx.x == 0) { unsigned sp = 0; while (__hip_atomic_load(cnt, __ATOMIC_RELAXED, __HIP_MEMORY_SCOPE_AGENT) < need) { __builtin_amdgcn_s_sleep(2); if (++sp > (1u << 22)) break; }
        __builtin_amdgcn_fence(__ATOMIC_ACQUIRE, "agent"); asm volatile("s_waitcnt vmcnt(0)" ::: "memory"); }
    __syncthreads();
}
__device__ __forceinline__ void p0_transpose_item(const float* W, int ldw, int K, int nblk, const float* g0, const float* g1, bf16* WT, LAS float* scr, int item, int lane) {
    const int kb = item / nblk, nb = item % nblk, k0 = 64 * kb, n0 = 32 * nb;
    f32x4 v[8];
#pragma unroll
    for (int i = 0; i < 8; ++i) { const int k = k0 + 8 * i + (lane >> 3); v[i] = *(const f32x4*)(W + (size_t)k * ldw + n0 + (lane & 7) * 4); }
#pragma unroll
    for (int i = 0; i < 8; ++i) { const int kk = 8 * i + (lane >> 3), k = k0 + kk;
        float gv = 1.f; if (g0) gv = (g1 && k >= 1024) ? g1[k - 1024] : g0[k];
        LAS float* d = scr + kk * 33 + (lane & 7) * 4; d[0] = v[i][0] * gv; d[1] = v[i][1] * gv; d[2] = v[i][2] * gv; d[3] = v[i][3] * gv; }
    asm volatile("s_waitcnt lgkmcnt(0)" ::: "memory");
    const int c = lane & 7;
#pragma unroll
    for (int j = 0; j < 4; ++j) { const int n = (lane >> 3) + 8 * j; const LAS float* s = scr + (8 * c) * 33 + n;
        u32x4 o; o.x = pk2(s[0 * 33], s[1 * 33]); o.y = pk2(s[2 * 33], s[3 * 33]); o.z = pk2(s[4 * 33], s[5 * 33]); o.w = pk2(s[6 * 33], s[7 * 33]);
        st16_wt(WT + (size_t)(n0 + n) * K + k0 + 8 * c, o); }
    asm volatile("s_waitcnt lgkmcnt(0)" ::: "memory");
}

namespace fox {
constexpr int D = 128, NW = 8, QBLK = 32, KVBLK = 64, QB = 256;
constexpr int SHM_V = 16384, SHM_K = 16384, SHM_X = 2048;
constexpr int QROWB = 144, SHM_Q = 32 * QROWB;
constexpr int NVB = 3;
constexpr int OFF_V = 0, OFF_K = NVB * SHM_V, OFF_X = OFF_K + 2 * SHM_K, OFF_WS = OFF_X + 2 * SHM_X, OFF_Q = OFF_WS + NW * 64 * 4, OFF_QX = OFF_Q + NW * SHM_Q, LDSB = OFF_QX + NW * 1024;
#define KSWZ(row, colB) ((row) * 256 + ((colB) ^ (((row) & 15) << 4)))
#define SBAR() __builtin_amdgcn_sched_barrier(0)
__device__ __forceinline__ int v_st(int k, int c) { const int kk = (k & ~0xC) | ((k & 4) << 1) | ((k & 8) >> 1); return ((kk >> 3) * 4 + (c >> 5)) * 512 + ((kk & 7) * 32 + (c & 31)) * 2; }
__device__ __forceinline__ int v_rd_base(int lane) { return ((lane & 3) << 3) | (((lane >> 2) & 3) << 6) | (((lane >> 4) & 1) << 5) | (((lane >> 5) & 1) << 8); }
constexpr int v_rd_off(int d0, int ks, int half) { return d0 * 512 + ks * 4096 + half * 2048; }
__device__ __forceinline__ int crow(int r, int hi) { return (r & 3) + 8 * (r >> 2) + 4 * hi; }
__device__ __forceinline__ bf16x8 load8(const bf16* p) { return *reinterpret_cast<const bf16x8*>(p); }
__device__ __forceinline__ void mask_tile(f32x16& p0, f32x16& p1, int dq) {
#pragma unroll
    for (int r = 0; r < 16; ++r) { const int c = (r & 3) + 8 * (r >> 2);
        const unsigned m0 = (unsigned)((dq - c) >> 31), m1 = (unsigned)((dq - c - 32) >> 31);
        p0[r] = __uint_as_float((m0 & 0xff800000u) | (~m0 & __float_as_uint(p0[r])));
        p1[r] = __uint_as_float((m1 & 0xff800000u) | (~m1 & __float_as_uint(p1[r]))); }
}
__device__ __forceinline__ void partialSM(f32x16& p0) {
#pragma unroll
    for (int r = 0; r < 16; ++r) p0[r] = __builtin_amdgcn_exp2f(p0[r]);
}
__device__ __forceinline__ void finishSM(f32x16& p0, f32x16& p1, float& l_reg, bf16x8& pa0, bf16x8& pa1, bf16x8& pa2, bf16x8& pa3) {
#pragma unroll
    for (int r = 0; r < 16; ++r) p1[r] = __builtin_amdgcn_exp2f(p1[r]);
    float ps = 0;
#pragma unroll
    for (int r = 0; r < 16; ++r) ps += p0[r];
#pragma unroll
    for (int r = 0; r < 16; ++r) ps += p1[r];
    l_reg += ps;
#define PK4(P, B_, OUT) do { unsigned a0 = cvtpk(P[B_+0], P[B_+1]), a1 = cvtpk(P[B_+2], P[B_+3]);                          \
        unsigned b0 = cvtpk(P[B_+4], P[B_+5]), b1 = cvtpk(P[B_+6], P[B_+7]);                                             \
        auto r0 = __builtin_amdgcn_permlane32_swap(a0, b0, false, false); auto r1 = __builtin_amdgcn_permlane32_swap(a1, b1, false, false); \
        u32x4 w = {r0[0], r1[0], r0[1], r1[1]}; OUT = __builtin_bit_cast(bf16x8, w); } while (0)
    PK4(p0, 0, pa0); PK4(p0, 8, pa1); PK4(p1, 0, pa2); PK4(p1, 8, pa3);
#undef PK4
}
template <int VB>
__device__ __forceinline__ void pv_tile(f32x16* o, int vb0, bf16x8 pa0, bf16x8 pa1, bf16x8 pa2, bf16x8 pa3) {
#define TRRD(dst, off) asm volatile("ds_read_b64_tr_b16 %0, %1 offset:%2" : "=&v"(dst) : "v"(vb0), "i"(off) : "memory")
#define PV_D0(d0) do { s16x4 l0, l1, l2, l3, h0, h1, h2, h3; constexpr int b_ = VB * SHM_V + v_rd_off(d0, 0, 0); \
        TRRD(l0, b_); TRRD(h0, b_ + 2048); TRRD(l1, b_ + 4096); TRRD(h1, b_ + 6144); TRRD(l2, b_ + 8192); TRRD(h2, b_ + 10240); TRRD(l3, b_ + 12288); TRRD(h3, b_ + 14336); \
        asm volatile("s_waitcnt lgkmcnt(0)" ::: "memory"); SBAR();   \
        o[d0] = __builtin_amdgcn_mfma_f32_32x32x16_bf16(pa0, (bf16x8){l0[0], l0[1], l0[2], l0[3], h0[0], h0[1], h0[2], h0[3]}, o[d0], 0, 0, 0);   \
        o[d0] = __builtin_amdgcn_mfma_f32_32x32x16_bf16(pa1, (bf16x8){l1[0], l1[1], l1[2], l1[3], h1[0], h1[1], h1[2], h1[3]}, o[d0], 0, 0, 0);   \
        o[d0] = __builtin_amdgcn_mfma_f32_32x32x16_bf16(pa2, (bf16x8){l2[0], l2[1], l2[2], l2[3], h2[0], h2[1], h2[2], h2[3]}, o[d0], 0, 0, 0);   \
        o[d0] = __builtin_amdgcn_mfma_f32_32x32x16_bf16(pa3, (bf16x8){l3[0], l3[1], l3[2], l3[3], h3[0], h3[1], h3[2], h3[3]}, o[d0], 0, 0, 0); } while (0)
    PV_D0(0); PV_D0(1); PV_D0(2); PV_D0(3);
#undef PV_D0
#undef TRRD
}
typedef __amdgpu_buffer_rsrc_t srd_t;
__device__ __forceinline__ srd_t mksrd(const void* p, unsigned bytes) { return __builtin_amdgcn_make_buffer_rsrc((void*)p, 0, (int)bytes, 0x00020000); }
__device__ __forceinline__ bf16x8 bload8(srd_t r, unsigned voff, unsigned soff) { return __builtin_bit_cast(bf16x8, __builtin_amdgcn_raw_buffer_load_b128(r, (int)voff, (int)soff, 0)); }
struct Ctx { srd_t W; unsigned char* ws; };
struct Seam { bf16x8 qr[8]; bf16x8 qx; };
#define WAITBAR() asm volatile("s_waitcnt vmcnt(0) lgkmcnt(0)\n\ts_barrier" ::: "memory")
#define OKV(bh, t) ((unsigned)(bh) * (SEQ * HD * 2) + (unsigned)(t) * (KVBLK * D * 2))
#define DMA16(dst, voff, soff, imm) __builtin_amdgcn_raw_ptr_buffer_load_lds(C.W, (LAS void*)(dst), 16, (int)(voff), (int)(soff), (imm), 0)
#define DMA_TILE(bh, t, kb, vb) do { const unsigned so_ = OKV(bh, t); \
        DMA16(lds + OFF_K + (kb) * SHM_K + wid * 2048, vok0, (unsigned)WS_KH + so_, 0); DMA16(lds + OFF_K + (kb) * SHM_K + wid * 2048 + 1024, vok1, (unsigned)WS_KH + so_, 0); \
        DMA16(lds + OFF_V + (vb) * SHM_V + wid * 2048, vov, (unsigned)WS_VH + so_, 0);  DMA16(lds + OFF_V + (vb) * SHM_V + wid * 2048 + 1024, vov, (unsigned)WS_VH + so_ + 128u, 0);   \
        if (wid < 2) DMA16(lds + OFF_X + (kb) * SHM_X + wid * 1024, vox, (unsigned)WS_CLK + (unsigned)(bh) * (SEQ * 32) + (unsigned)(t) * (KVBLK * 32), 0); } while (0)
#define DMA_OFFS(tid_) const int lane_ = (tid_) & 63; \
        const int kr0_ = 8 * wid + (lane_ >> 4), kr1_ = kr0_ + 4;                                     \
        const unsigned vok0 = (unsigned)(kr0_ * 256 + (((lane_ & 15) ^ (kr0_ & 15)) << 4)), vok1 = (unsigned)(kr1_ * 256 + (((lane_ & 15) ^ (kr1_ & 15)) << 4)); \
        const int vkk_ = 8 * wid + ((lane_ >> 2) & 7), vk_ = (vkk_ & ~0xC) | ((vkk_ & 4) << 1) | ((vkk_ & 8) >> 1);     \
        const unsigned vov = (unsigned)(vk_ * 256 + ((lane_ >> 5) * 32 + (lane_ & 3) * 8) * 2), vox = (unsigned)(tid_) * 16u
#define QLOAD(bh, qb, R32, HI) do { const unsigned voq_ = (unsigned)(((wid * QBLK + (R32)) * D + (HI) * 8) * 2); const unsigned row0_ = (unsigned)(bh) * SEQ + (unsigned)(qb) * QB; \
    _Pragma("unroll") for (int d0 = 0; d0 < 8; ++d0) S.qr[d0] = bload8(C.W, voq_ + d0 * 32, (unsigned)WS_QH + row0_ * (HD * 2)); \
    S.qx = bload8(C.W, (unsigned)(((wid * QBLK + (R32)) * 16 + (HI) * 8) * 2), (unsigned)WS_CLQ + row0_ * 32); } while (0)
__device__ __forceinline__ int tile_lo(const Ctx& C, int bh, int qb, int lane) {
    const unsigned base = (unsigned)(WS_SMALL + SM_CLF) + (unsigned)bh * (SEQ * 4);
    const float thr = __builtin_bit_cast(float, __builtin_amdgcn_raw_buffer_load_b32(C.W, 0, (int)((unsigned)(WS_SMALL + SM_CLF) + 16u * SEQ * 4u), 0));
    const float cr0 = __builtin_bit_cast(float, __builtin_amdgcn_raw_buffer_load_b32(C.W, 0, (int)(base + (unsigned)qb * (QB * 4)), 0));
    const int NT = 4 * qb + 4; int first = NT - 4;
    for (int j = lane; j < NT - 4; j += 64) { const float ce = __builtin_bit_cast(float, __builtin_amdgcn_raw_buffer_load_b32(C.W, (int)((KVBLK * j + KVBLK - 1) * 4), (int)base, 0));
        if (cr0 - ce >= -thr) first = min(first, j); }
    first = __builtin_amdgcn_readfirstlane(wave_min_i(first));
    return first & ~1;
}
__device__ __forceinline__ void prime(const Ctx& C, int bh, int qb, int jlo, LAS char* lds, Seam& S, const int wave) {
    const int tid = opaque_tid(wave), wid = wave, r32 = tid & 31, hi = (tid >> 5) & 1;
    DMA_OFFS(tid);
    QLOAD(bh, qb, r32, hi);
    DMA_TILE(bh, jlo, 0, 0);
}
template <int KB>
__device__ __forceinline__ void qkt(f32x16& p0, f32x16& p1, LAS const char* lds, int r32, int hi, const bf16x8 (&q4)[4], LAS const char* qb, LAS const char* qxb) {
    p0 = f32x16{}; p1 = f32x16{};
    unsigned kb0 = (unsigned)(uintptr_t)(lds + OFF_K + KB * SHM_K) + (unsigned)KSWZ(r32, hi * 16);
    asm volatile("" : "+v"(kb0));
#pragma unroll
    for (int d0 = 0; d0 < 8; ++d0) { LAS const char* a = (LAS const char*)(uintptr_t)(kb0 ^ (unsigned)(d0 << 5));
        bf16x8 b0 = *reinterpret_cast<LAS const bf16x8*>(a);
        bf16x8 b1 = *reinterpret_cast<LAS const bf16x8*>(a + 32 * 256);
        bf16x8 qf; if (d0 < 4) qf = q4[d0]; else qf = *reinterpret_cast<LAS const bf16x8*>(qb + (d0 - 4) * 32);
        p0 = __builtin_amdgcn_mfma_f32_32x32x16_bf16(b0, qf, p0, 0, 0, 0);
        p1 = __builtin_amdgcn_mfma_f32_32x32x16_bf16(b1, qf, p1, 0, 0, 0); }
    { LAS const char* xa = lds + OFF_X + KB * SHM_X + r32 * 32 + hi * 16;
        bf16x8 x0 = *reinterpret_cast<LAS const bf16x8*>(xa); bf16x8 x1 = *reinterpret_cast<LAS const bf16x8*>(xa + 32 * 32);
        const bf16x8 qx = *reinterpret_cast<LAS const bf16x8*>(qxb);
        p0 = __builtin_amdgcn_mfma_f32_32x32x16_bf16(x0, qx, p0, 0, 0, 0);
        p1 = __builtin_amdgcn_mfma_f32_32x32x16_bf16(x1, qx, p1, 0, 0, 0); }
}
__device__ __forceinline__ void block(const Ctx& C, int bh, int qb_cur, int jlo, int qb_nxt, int jlo_nxt, LAS char* lds, Seam& S, const int wave) {
    const int tid = opaque_tid(wave), wid = wave, lane = tid & 63, r32 = lane & 31, hi = lane >> 5;
    const int P0 = qb_cur * QB;
    const int NT = (P0 + QB - 1) / KVBLK + 1 - jlo;
    const int qlo = P0 + wid * QBLK, qm = qlo + r32 - 4 * hi;
    float l_reg = 0; f32x16 o[4] = {};
    DMA_OFFS(tid);
    const int vb0 = (int)(unsigned)(uintptr_t)(lds + OFF_V) + v_rd_base(lane);
#define KBASE(t) ((jlo + (t)) * KVBLK)
#define MASKT(P0_, P1_, t) do { const int kb_ = KBASE(t); if (kb_ + KVBLK - 1 > qlo) mask_tile(P0_, P1_, qm - kb_); } while (0)
    f32x16 pA0, pA1, pB0, pB1; bf16x8 pa0, pa1, pa2, pa3;
    bf16x8 q4[4] = {S.qr[0], S.qr[1], S.qr[2], S.qr[3]};
    LAS char* qb = lds + OFF_Q + wid * SHM_Q + r32 * QROWB + hi * 16;
#pragma unroll
    for (int d0 = 4; d0 < 8; ++d0) *reinterpret_cast<LAS bf16x8*>(qb + (d0 - 4) * 32) = S.qr[d0];
    LAS char* qxb = lds + OFF_QX + wid * 1024 + r32 * 32 + hi * 16; *reinterpret_cast<LAS bf16x8*>(qxb) = S.qx;
    WAITBAR();
    SBAR(); qkt<0>(pA0, pA1, lds, r32, hi, q4, qb, qxb);
    DMA_TILE(bh, jlo + 1, 1, 1); SBAR();
    MASKT(pA0, pA1, 0); partialSM(pA0);
    WAITBAR();
    int vr = 0, vw = 2;
#define HALF_STEP(PX0, PX1, PY0, PY1, t, KB) do {                                                      \
        SBAR(); qkt<KB>(PX0, PX1, lds, r32, hi, q4, qb, qxb);                                             \
        finishSM(PY0, PY1, l_reg, pa0, pa1, pa2, pa3); SBAR();                                                           \
        if ((t) + 1 < NT) { DMA_TILE(bh, jlo + (t) + 1, (KB) ^ 1, vw); SBAR(); }                                         \
        pv_tile<0>(o, vb0 + vr * SHM_V, pa0, pa1, pa2, pa3); MASKT(PX0, PX1, (t)); partialSM(PX0);                         \
        WAITBAR();                                                                                                            \
        vr = (vr == NVB - 1) ? 0 : vr + 1; vw = (vw == NVB - 1) ? 0 : vw + 1; } while (0)
    for (int t = 1; t + 1 < NT; t += 2) {
        HALF_STEP(pB0, pB1, pA0, pA1, t, 1);
        HALF_STEP(pA0, pA1, pB0, pB1, t + 1, 0);
    }
    SBAR(); qkt<1>(pB0, pB1, lds, r32, hi, q4, qb, qxb); SBAR();
    finishSM(pA0, pA1, l_reg, pa0, pa1, pa2, pa3); SBAR();
    pv_tile<0>(o, vb0 + vr * SHM_V, pa0, pa1, pa2, pa3);
    vr = (vr == NVB - 1) ? 0 : vr + 1;
    MASKT(pB0, pB1, NT - 1); partialSM(pB0);
    finishSM(pB0, pB1, l_reg, pa0, pa1, pa2, pa3); SBAR(); pv_tile<0>(o, vb0 + vr * SHM_V, pa0, pa1, pa2, pa3);
    WAITBAR();
    { const int tid2 = opaque_tid(wave), r32b = tid2 & 31, hib = (tid2 >> 5) & 1;
      QLOAD(bh, qb_nxt, r32b, hib);
      DMA_TILE(bh, jlo_nxt, 0, 0); SBAR();
      l_reg = half_swap_add(l_reg);
      LAS float* li2 = (LAS float*)(lds + OFF_WS) + wid * 64;
      if (hib == 0) li2[r32b] = l_reg; asm volatile("s_waitcnt lgkmcnt(0)" ::: "memory");
      const unsigned tok0 = (unsigned)(bh >> 3) * SEQ + (unsigned)P0 + (unsigned)(wid * QBLK);
      bf16* Ow = (bf16*)(C.ws + WS_MIX) + (size_t)tok0 * DM + 1024 + (bh & 7) * HD; float* SSw = (float*)(C.ws + WS_SMALL + SM_SSQ2) + (size_t)tok0 * 8 + (bh & 7);
      const unsigned stg0 = (unsigned)(uintptr_t)lds + (unsigned)(wid < 4 ? 16384 + wid * 8192 : wid < 6 ? 65536 + (wid - 4) * 8192 : LDSB + (wid - 6) * 8192);
      unsigned swa = stg0 + (unsigned)hib * 1024u + (unsigned)r32b * 2u; asm volatile("" : "+v"(swa));
      LAS unsigned char* swp = (LAS unsigned char*)(uintptr_t)swa;
      const unsigned sbase = (unsigned)(4 * hib) * 8; float sqk = 0.f;
#pragma unroll
      for (int r = 0; r < 16; ++r) { const unsigned ro = (unsigned)((r & 3) + 8 * (r >> 2)); const float rli = __builtin_amdgcn_rcpf(li2[ro + 4 * hib]); float sq = 0.f;
#pragma unroll
          for (int d0 = 0; d0 < 4; ++d0) { const float v = o[d0][r] * rli; sq += v * v;
              const float vn = lane_xor<1>(v);
              if ((r32b & 1) == 0) *(LAS unsigned*)(swp + ro * 256 + d0 * 64) = cvtpk(v, vn); }
          sq = sum32(sq);
          sqk = (r32b == r) ? sq : sqk; }
      if (r32b < 16) SSw[sbase + ((r32b & 3) + 8 * (r32b >> 2)) * 8] = sqk;
      asm volatile("s_waitcnt lgkmcnt(0)" ::: "memory");
      { const int ln = r32b + 32 * hib; unsigned sra = stg0 + (unsigned)(ln >> 4) * 256u + (unsigned)(ln & 15) * 16u; asm volatile("" : "+v"(sra));
        const LAS unsigned char* srp = (const LAS unsigned char*)(uintptr_t)sra;
        bf16* Or = Ow + (size_t)(ln >> 4) * DM + (ln & 15) * 8;
#pragma unroll
        for (int hb = 0; hb < 2; ++hb) { u32x4 vq[4];
#pragma unroll
          for (int it = 0; it < 4; ++it) vq[it] = *(const LAS u32x4*)(srp + (16 * hb + 4 * it) * 256);
#pragma unroll
          for (int it = 0; it < 4; ++it) *(u32x4*)(Or + (size_t)(16 * hb + 4 * it) * DM) = vq[it]; } } }
#undef KBASE
#undef MASKT
#undef HALF_STEP
}
__device__ __forceinline__ void finish(Seam& S) { asm volatile("" :: "v"(S.qx)); asm volatile("s_waitcnt vmcnt(0) lgkmcnt(0)" ::: "memory"); __syncthreads(); }
#undef WAITBAR
#undef OKV
#undef DMA16
#undef DMA_TILE
#undef DMA_OFFS
#undef QLOAD
}


struct S5Frag { bf16x8 ua, uf0, uf1; };
template <bool READOUT>
__device__ __forceinline__ S5Frag s5_load(const bf16* U, int tok0, int g, int lane) {
    S5Frag f; const int r32 = lane & 31, hi = lane >> 5;
    f.ua = *(const bf16x8*)(U + (size_t)(tok0 + r32) * DSSM + g * 16 + 8 * hi);
    if (READOUT) { f.uf0 = *(const bf16x8*)(U + (size_t)(tok0 + (lane & 15)) * DSSM + g * 16 + 8 * ((lane >> 4) & 1));
                   f.uf1 = *(const bf16x8*)(U + (size_t)(tok0 + 16 + (lane & 15)) * DSSM + g * 16 + 8 * ((lane >> 4) & 1)); }
    else { f.uf0 = f.ua; f.uf1 = f.ua; }
    return f;
}
#ifndef PSTAGE
#define PSTAGE true
#endif
#ifndef SSTAGE
#define SSTAGE true
#endif
template <bool READOUT, bool STAGE = true>
__device__ __forceinline__ void s5_scan32(const S5Frag& F, bf16* GYD, LAS unsigned char* ST, int srow, int tok0, int g, float a_re, float a_im, const bf16x8 (&bm)[4], const bf16x8 (&cm)[4], const bf16x8 dfrag,
                                          LAS unsigned char* Hs, float& h_re, float& h_im, int lane) {
    const int r32 = lane & 31, hi = lane >> 5, p = r32 + 32 * hi;
    f32x16 D0 = __builtin_amdgcn_mfma_f32_32x32x16_bf16(F.ua, bm[0], f32x16{}, 0, 0, 0);
    f32x16 D1 = __builtin_amdgcn_mfma_f32_32x32x16_bf16(F.ua, bm[1], f32x16{}, 0, 0, 0);
    f32x16 D2 = __builtin_amdgcn_mfma_f32_32x32x16_bf16(F.ua, bm[2], f32x16{}, 0, 0, 0);
    f32x16 D3 = __builtin_amdgcn_mfma_f32_32x32x16_bf16(F.ua, bm[3], f32x16{}, 0, 0, 0);
#pragma unroll
    for (int r = 0; r < 16; ++r) {
        auto s0 = __builtin_amdgcn_permlane32_swap(__float_as_uint(D0[r]), __float_as_uint(D1[r]), false, false); D0[r] = __uint_as_float(s0[0]); D1[r] = __uint_as_float(s0[1]);
        auto s1 = __builtin_amdgcn_permlane32_swap(__float_as_uint(D2[r]), __float_as_uint(D3[r]), false, false); D2[r] = __uint_as_float(s1[0]); D3[r] = __uint_as_float(s1[1]);
    }
#pragma unroll
    for (int s = 0; s < 32; ++s) {
        const int hs = (s >> 2) & 1, rs_ = (s & 3) + 4 * (s >> 3);
        const float bre = hs ? D1[rs_] : D0[rs_], bim = hs ? D3[rs_] : D2[rs_];
        const float nre = fmaf(a_re, h_re, fmaf(-a_im, h_im, bre)), nim = fmaf(a_re, h_im, fmaf(a_im, h_re, bim));
        h_re = nre; h_im = nim;
        if (READOUT) *(LAS unsigned*)(Hs + s * 272 + p * 4) = cvtpk_nv(h_re, h_im);
    }
    if (READOUT) {
        asm volatile("s_waitcnt lgkmcnt(0)" ::: "memory");
#pragma unroll
        for (int tb = 0; tb < 2; ++tb) {
            f32x4 y = __builtin_amdgcn_mfma_f32_16x16x32_bf16(tb == 0 ? F.uf0 : F.uf1, dfrag, (f32x4){0.f, 0.f, 0.f, 0.f}, 0, 0, 0);
#pragma unroll
            for (int kk = 0; kk < 4; ++kk) { const bf16x8 ha = *(const LAS bf16x8*)(Hs + (16 * tb + (lane & 15)) * 272 + kk * 64 + (lane >> 4) * 16);
                y = __builtin_amdgcn_mfma_f32_16x16x32_bf16(ha, cm[kk], y, 0, 0, 0); }
#pragma unroll
            for (int r = 0; r < 4; ++r) { const int t = 16 * tb + 4 * (lane >> 4) + r; const size_t tok = (size_t)(tok0 + t);
                if (STAGE) *(LAS unsigned short*)(ST + (srow + t) * 32 + (lane & 15) * 2) = (unsigned short)f2bf(gelu_tanh(y[r]));
                else GYD[tok * DSSM + g * 16 + (lane & 15)] = f2bf(gelu_tanh(y[r])); }
        }
        asm volatile("s_waitcnt lgkmcnt(0)" ::: "memory");
    }
}
__device__ __forceinline__ void s5_flush(LAS const unsigned char* ST, bf16* GY, int tok0, int nrow, int g, int lane) {
    asm volatile("s_waitcnt lgkmcnt(0)" ::: "memory");
    for (int r = lane >> 1; r < nrow; r += 32) { const u32x4 v = *(const LAS u32x4*)(ST + r * 32 + (lane & 1) * 16);
        *(u32x4*)(GY + (size_t)(tok0 + r) * DSSM + g * 16 + (lane & 1) * 8) = v; }
    asm volatile("s_waitcnt lgkmcnt(0)" ::: "memory");
}
__device__ __forceinline__ bf16x8 s5_dfrag(float dsk, int lane) {
    const int i = lane & 15, kq = lane >> 4; bf16x8 d = {0, 0, 0, 0, 0, 0, 0, 0};
    const short dv = (short)f2bf(dsk);
#pragma unroll
    for (int jj = 0; jj < 8; ++jj) d[jj] = (8 * kq + jj == i) ? dv : (short)0;
    return d;
}

#define XB_TMO      128
#define XB_XCNT(j)  (256  + 64 * (j))
#define XB_XSUB(j)  (1280 + 64 * (j))
#define XB_XGEN(j)  (2304 + 64 * (j))
#define XB_TOP      3328
#define XB_TOPGEN   3392
#define XCD_BAR_WORDS 3456
#define XB_SPIN_CAP (1u << 18)
__device__ __forceinline__ unsigned xb_ld(unsigned* p)              { return __hip_atomic_load(p, __ATOMIC_RELAXED, __HIP_MEMORY_SCOPE_AGENT); }
__device__ __forceinline__ unsigned xb_add(unsigned* p, unsigned v) { return __hip_atomic_fetch_add(p, v, __ATOMIC_RELAXED, __HIP_MEMORY_SCOPE_AGENT); }
__device__ __forceinline__ unsigned xb_xcc_id() { return (unsigned)__builtin_amdgcn_s_getreg((3 << 11) | 20) & 0xFu; }
#define XB_SPIN(cond, bar) do { unsigned _sp = 0; while (cond) { __builtin_amdgcn_s_sleep(1); \
    if ((++_sp & 255u) == 0u) { if (xb_ld(&(bar)[XB_TMO])) break; if (_sp > XB_SPIN_CAP) { atomicAdd(&(bar)[XB_TMO], 1u); break; } } } } while (0)
struct XcdBarrier { unsigned* bar; unsigned x; volatile LAS unsigned* st; };
__device__ __forceinline__ XcdBarrier xcd_barrier_post(unsigned* bar, volatile LAS unsigned* st) {
    XcdBarrier b; b.bar = bar; b.x = xb_xcc_id(); b.st = st;
    if (threadIdx.x == 0) (void)xb_add(&bar[XB_XCNT(b.x)], 1u);
    return b;
}
__device__ __forceinline__ void xcd_barrier_complete(unsigned* bar, unsigned x, unsigned& nloc, unsigned& nx) {
    const unsigned G = gridDim.x * gridDim.y * gridDim.z;
    unsigned sum, cnt, mine, sp = 0u;
    for (;;) {
        sum = 0u; cnt = 0u; mine = 0u;
#pragma unroll
        for (unsigned j = 0; j < 16; ++j) { const unsigned c = xb_ld(&bar[XB_XCNT(j)]); sum += c; cnt += (c > 0u) ? 1u : 0u; mine = (j == x) ? c : mine; }
        if (sum == G) break;
        __builtin_amdgcn_s_sleep(1);
        if ((++sp & 255u) == 0u) { if (xb_ld(&bar[XB_TMO])) break; if (sp > XB_SPIN_CAP) { atomicAdd(&bar[XB_TMO], 1u); break; } }
    }
    nloc = mine > 0u ? mine : 1u; nx = cnt > 0u ? cnt : 1u;
}
__device__ __forceinline__ void xcd_barrier(const XcdBarrier& b) {
    asm volatile("s_waitcnt vmcnt(0)" ::: "memory");
    __syncthreads();
    if (threadIdx.x == 0) {
        unsigned* bar = b.bar;
        __builtin_amdgcn_s_waitcnt(0);
        unsigned nloc = b.st[0], nx = b.st[1];
        if (nloc == 0u) { xcd_barrier_complete(bar, b.x, nloc, nx); b.st[0] = nloc; b.st[1] = nx; }
        const unsigned old = xb_add(&bar[XB_XSUB(b.x)], 1u);
        const unsigned gen = old / nloc;
        if (old + 1u == (gen + 1u) * nloc) {
            __builtin_amdgcn_fence(__ATOMIC_RELEASE, "agent");
            asm volatile("s_waitcnt vmcnt(0)" ::: "memory");
            const unsigned og = xb_add(&bar[XB_TOP], 1u);
            const unsigned tg = og / nx;
            if (og + 1u == (tg + 1u) * nx) xb_add(&bar[XB_TOPGEN], 1u);
            else XB_SPIN(xb_ld(&bar[XB_TOPGEN]) == tg, bar);
            xb_add(&bar[XB_XGEN(b.x)], 1u);
            __builtin_amdgcn_fence(__ATOMIC_ACQUIRE, "agent");
            asm volatile("s_waitcnt vmcnt(0)" ::: "memory");
        } else {
            XB_SPIN(xb_ld(&bar[XB_XGEN(b.x)]) == gen, bar);
            __builtin_amdgcn_fence(__ATOMIC_ACQUIRE, "agent");
            asm volatile("s_waitcnt vmcnt(0)" ::: "memory");
        }
    }
    __syncthreads();
}

__device__ __forceinline__ void split3(float x, unsigned short& h, unsigned short& m, unsigned short& l) {
    h = (unsigned short)f2bf(x); const float r1 = x - bf2f(h); m = (unsigned short)f2bf(r1); const float r2 = r1 - bf2f(m); l = (unsigned short)f2bf(r2);
}

__global__ void __launch_bounds__(512, 2) hymba_fwd(Args args) {
    extern __shared__ __attribute__((aligned(16))) unsigned char lds_raw[];
    cg::grid_group grid = cg::this_grid();
    LAS unsigned char* lds = (LAS unsigned char*)lds_raw;
    const int wave = __builtin_amdgcn_readfirstlane(threadIdx.x >> 6);
    const int G = gridDim.x, bx = blockIdx.x;
    volatile LAS unsigned* xst = (volatile LAS unsigned*)(lds + LDS_BYTES - 16);
    if (threadIdx.x < 4) xst[threadIdx.x] = 0u;
    __syncthreads();
    const XcdBarrier xbar = xcd_barrier_post((unsigned*)((const __attribute__((address_space(4))) Args*)__builtin_amdgcn_kernarg_segment_ptr())->ws, xst);
    if (gridDim.y == 0x7fffffffu) grid.sync();
#define GRID_SYNC() xcd_barrier(xbar)
    const int gw = bx * 8 + wave, NGW = G * 8;
#define PHASE_PTRS \
    const __attribute__((address_space(4))) Args* A_ = (const __attribute__((address_space(4))) Args*)__builtin_amdgcn_kernarg_segment_ptr(); asm volatile("" : "+s"(A_)); \
    unsigned char* const ws = A_->ws; float* const out = A_->out; (void)ws; (void)out;
#define IN(i) (A_->in[i])
#define x_prompt IN(0)
#define x_sample IN(1)
#define cache_k IN(2)
#define cache_v IN(3)
#define cache_logf IN(4)
#define st_re IN(5)
#define st_im IN(6)
#define Win_t ((bf16*)(ws + WS_WIN))
#define Wglu_t ((bf16*)(ws + WS_WGLU))
#define Wout_t ((bf16*)(ws + WS_WOUT))
#define Wup_t ((bf16*)(ws + WS_WUP))
#define Wdn_t ((bf16*)(ws + WS_WDN))
#define RS1 ((float*)(ws + WS_SMALL + SM_RS1))
#define ABAR ((float*)(ws + WS_SMALL + SM_ABAR))
#define APOW ((float*)(ws + WS_SMALL + SM_APOW))
#define BMT ((bf16*)(ws + WS_SMALL + SM_BMT))
#define CMT ((bf16*)(ws + WS_SMALL + SM_CMT))
#define SSQ1 ((float*)(ws + WS_SMALL + SM_SSQ1))
#define SSQ2 ((float*)(ws + WS_SMALL + SM_SSQ2))
#define SSQ3 ((float*)(ws + WS_SSQ3))
#define XB ((bf16*)(ws + WS_XB))
#define U ((bf16*)(ws + WS_U))
#define QKraw ((float*)(ws + WS_QKRAW))
#define Qh ((bf16*)(ws + WS_QH))
#define Kh ((bf16*)(ws + WS_KH))
#define Vh ((bf16*)(ws + WS_VH))
#define GY ((bf16*)(ws + WS_GY))
#define MIX ((bf16*)(ws + WS_MIX))
#define X1B ((bf16*)(ws + WS_X1B))
#define Hb ((bf16*)(ws + WS_H))
#define CLK ((bf16*)(ws + WS_CLK))
#define CLQ ((bf16*)(ws + WS_CLQ))

    for (int rep_ = 0; rep_ < REPS(1); ++rep_) { if (rep_) GRID_SYNC();
        PHASE_PTRS
        const int tid = opaque_tid(wave), lane = tid & 63;
        LAS float* scr = (LAS float*)(lds + wave * 16384);
        constexpr int I_IN = 32 * 128;
        for (int it = gw; it < I_IN; it += NGW) p0_transpose_item(IN(8), NINW, DM, 128, IN(7), nullptr, Win_t, scr, it, lane);
        __syncthreads();
        LAS float* wfT = (LAS float*)lds;
        for (int e = tid; e < 8 * DM; e += 512) { const int k = e >> 3, h = e & 7; wfT[h * DM + k] = IN(8)[(size_t)k * NINW + 4096 + h] * IN(7)[k]; }
        __syncthreads();
        f32x4 vn[8];
        { const int m0 = gw < MT ? gw : 0; const float* xr0 = m0 < MP ? x_prompt + (size_t)m0 * DM : x_sample + (size_t)(m0 - MP) * DM;
#pragma unroll
          for (int j = 0; j < 8; ++j) vn[j] = *(const f32x4*)(xr0 + 4 * lane + 256 * j); }
        for (int m = gw; m < MT; m += NGW) {
            f32x4 v[8]; float s = 0.f; float dt[8];
#pragma unroll
            for (int h = 0; h < 8; ++h) dt[h] = 0.f;
#pragma unroll
            for (int j = 0; j < 8; ++j) { v[j] = vn[j]; s += (v[j][0] * v[j][0] + v[j][1] * v[j][1]) + (v[j][2] * v[j][2] + v[j][3] * v[j][3]); }
#pragma unroll
            for (int j = 0; j < 8; ++j) { u32x2 w; w.x = cvtpk(v[j][0], v[j][1]); w.y = cvtpk(v[j][2], v[j][3]); *(u32x2*)(XB + (size_t)m * DM + 4 * lane + 256 * j) = w; }
            { const int mn = m + NGW < MT ? m + NGW : m; const float* xrn = mn < MP ? x_prompt + (size_t)mn * DM : x_sample + (size_t)(mn - MP) * DM;
#pragma unroll
              for (int j = 0; j < 8; ++j) vn[j] = *(const f32x4*)(xrn + 4 * lane + 256 * j); }
#pragma unroll
            for (int j = 0; j < 8; ++j)
#pragma unroll
                for (int h = 0; h < 8; ++h) { const f32x4 w = *(const LAS f32x4*)(wfT + h * DM + 4 * lane + 256 * j); dt[h] += (v[j][0] * w[0] + v[j][1] * w[1]) + (v[j][2] * w[2] + v[j][3] * w[3]); }
            s = wave_sum(s); const float rs = 1.0f / sqrtf(s * (1.0f / DM) + EPS);
#pragma unroll
            for (int h = 0; h < 8; ++h) dt[h] = wave_sum(dt[h]);
            if (lane == 0) RS1[m] = rs;
            if (lane < 8) { float z = 0.f;
#pragma unroll
                for (int h = 0; h < 8; ++h) z = (lane == h) ? dt[h] : z;
                z = z * rs + IN(9)[lane];
                const float lf = log_sigmoidf_(z);
                out[(m < MP ? O_LFP + (size_t)m * 8 : O_LFS + (size_t)(m - MP) * 8) + lane] = lf; }
        }
    }
    GRID_SYNC();

    for (int rep_ = 0; rep_ < REPS(2); ++rep_) { if (rep_) GRID_SYNC();
        PHASE_PTRS
        pg8::Gemm g{XB, Win_t, MT, 4096, DM, DM}; pg8::StaticOrder S; S.init(MT, 4096, G, bx);
        EpiIn E{RS1, U, out, Qh, Kh, Vh, IN(19), IN(20), (LAS float*)(lds + AUX_OFF)};
        pg8::gemm_phase<EpiIn, pg8::StaticOrder>(lds, g, S, E, wave);
        { const int busy = S.nwg % G, nfree = busy ? G - busy : G, fi = busy ? bx - busy : bx;
          if (fi >= (nfree >= 144 ? 16 : 0) && rep_ == 0) { const int tq_ = opaque_tid(wave), f0_ = nfree >= 144 ? 16 : 0;
            if (tq_ < 32) for (int gt = (fi - f0_) * 32 + tq_; gt < NG * NP; gt += (nfree - f0_) * 32) {
            const int g = gt >> 6, p = gt & 63;
            const float a_re = IN(10)[gt], a_im = IN(11)[gt], step = expf(IN(12)[g]);
            const float mag = expf(a_re * step); float sn, cs; sincosf(a_im * step, &sn, &cs);
            const float ab_re = mag * cs, ab_im = mag * sn;
            const float den = a_re * a_re + a_im * a_im, nr = ab_re - 1.0f, ni = ab_im;
            const float fr_ = (nr * a_re + ni * a_im) / den, fi_ = (ni * a_re - nr * a_im) / den;
            ABAR[gt * 2] = ab_re; ABAR[gt * 2 + 1] = ab_im;
            float pr = ab_re, pi = ab_im;
#pragma unroll 1
            for (int q = 0; q < 9; ++q) { const float nr2 = pr * pr - pi * pi, ni2 = 2.f * pr * pi; pr = nr2; pi = ni2; }
            APOW[gt * 2] = pr; APOW[gt * 2 + 1] = pi;
            const float* bre = IN(13) + (size_t)gt * 16; const float* bim = IN(14) + (size_t)gt * 16;
#pragma unroll
            for (int j = 0; j < 16; ++j) { const float br = bre[j], bi = bim[j];
                BMT[((size_t)g * 128 + p) * 16 + j] = (bf16)f2bf(fr_ * br - fi_ * bi);
                BMT[((size_t)g * 128 + 64 + p) * 16 + j] = (bf16)f2bf(fr_ * bi + fi_ * br); }
#pragma unroll
            for (int i = 0; i < 16; ++i) { const float cr = IN(15)[((size_t)g * 16 + i) * 64 + p], ci = IN(16)[((size_t)g * 16 + i) * 64 + p];
                CMT[((size_t)g * 16 + i) * 128 + 2 * p] = (bf16)f2bf(cr); CMT[((size_t)g * 16 + i) * 128 + 2 * p + 1] = (bf16)f2bf(-ci); }
            } }
          if (fi >= 0 && fi < 16 && rep_ == 0) {
            const int tid = opaque_tid(wave), lane = tid & 63;
            const int bh = fi, b = bh >> 3, h = bh & 7;
            LAS float* red = (LAS float*)(lds + AUX_OFF);
            float gm = 0.f; if (tid < 128) gm = fabsf(IN(19)[tid] * IN(20)[tid]);
            gm = wave_max(gm);
            if (lane == 0) red[16 + wave] = gm;
            const float* lf = out + O_LFP + (size_t)b * SEQ * 8 + h;
            float loc[16]; float s = 0.f;
#pragma unroll
            for (int i = 0; i < 16; ++i) { loc[i] = lf[(size_t)(tid * 16 + i) * 8]; s += loc[i]; }
            const float inc = wave_incl_scan(s);
            if (lane == 63) red[wave] = inc;
            __syncthreads();
            float base = inc - s; for (int w2 = 0; w2 < wave; ++w2) base += red[w2];
            const float MB = fmaxf(red[16], red[17]) * 11.313708498984761f * LOG2E;
            float run = base;
#pragma unroll
            for (int i = 0; i < 16; ++i) { run += loc[i]; const int t = tid * 16 + i; const float cl = run * LOG2E;
                unsigned short a, bb, c; split3(-cl, a, bb, c);
                u32x4 w0 = {(unsigned)a | ((unsigned)bb << 16), (unsigned)c | (0x3F80u << 16), 0x3F803F80u, 0u}; const u32x4 z = {0u, 0u, 0u, 0u};
                u32x4* kx = (u32x4*)(CLK + ((size_t)bh * SEQ + t) * 16); kx[0] = w0; kx[1] = z;
                split3(cl - MB, a, bb, c);
                u32x4 w1 = {0x3F803F80u, 0x3F80u | ((unsigned)a << 16), (unsigned)bb | ((unsigned)c << 16), 0u};
                u32x4* qx = (u32x4*)(CLQ + ((size_t)bh * SEQ + t) * 16); qx[0] = w1; qx[1] = z;
                ((float*)(ws + WS_SMALL + SM_CLF))[(size_t)bh * SEQ + t] = cl; }
            if (tid == 0) ((float*)(ws + WS_SMALL + SM_CLF))[16 * SEQ] = 2.f * MB + 37.f;
            __syncthreads();
          }
          if (fi >= 0) { const int lane = opaque_tid(wave) & 63; LAS float* scr = (LAS float*)(lds + wave * 16384);
              constexpr int I_GLU = 16 * 32, I_OUT = 32 * 64, I_UP = 32 * 256;
              for (int it = fi * 8 + wave; it < I_GLU + I_OUT + I_UP; it += nfree * 8) { int r = it;
                  if (r < I_GLU) { p0_transpose_item(IN(18), 1024, 1024, 32, nullptr, nullptr, Wglu_t, scr, r, lane); continue; } r -= I_GLU;
                  if (r < I_OUT) { p0_transpose_item(IN(23), DM, DM, 64, IN(21), IN(22), Wout_t, scr, r, lane); continue; } r -= I_OUT;
                  p0_transpose_item(IN(25), DFF, DM, 256, IN(24), nullptr, Wup_t, scr, r, lane); } } }
    }
    GRID_SYNC();

    for (int rep_ = 0; rep_ < REPS(4); ++rep_) { if (rep_) GRID_SYNC();
        PHASE_PTRS
        const int tid = opaque_tid(wave), lane = tid & 63;
        {
            const int nb = bx >> 7, oc = (bx >> 4) & 7, seg = bx & 15, g = oc * 8 + wave, ng = nb * 64 + g;
            const int r32 = lane & 31, hi = lane >> 5, p = r32 + 32 * hi;
            const float a_re = ABAR[(g * 64 + p) * 2], a_im = ABAR[(g * 64 + p) * 2 + 1];
            bf16x8 bm[4], cm[4];
#pragma unroll
            for (int b = 0; b < 4; ++b) bm[b] = *(const bf16x8*)(BMT + ((size_t)g * 128 + 32 * b + r32) * 16 + 8 * hi);
#pragma unroll
            for (int kk = 0; kk < 4; ++kk) cm[kk] = *(const bf16x8*)(CMT + ((size_t)g * 16 + (lane & 15)) * 128 + 32 * kk + 8 * (lane >> 4));
            const float dsk = IN(17)[g * 16 + (lane & 15)];
            LAS unsigned char* Hs = lds + wave * 8704;
            LAS unsigned char* STG = lds + 8 * 8704 + wave * 4096;
            float* EX = (float*)(ws + WS_SMALL + SM_S5EX) + (size_t)ng * (16 * 128); unsigned* xcnt = (unsigned*)(ws + 40960) + (nb * 8 + oc);
            const int tokb = nb * SEQ + seg * 512;
            const bf16x8 dfrag = s5_dfrag(dsk, lane);
            float h_re = 0.f, h_im = 0.f;
            { S5Frag F = s5_load<false>(U, tokb, g, lane);
#pragma unroll 1
              for (int blk = 0; blk < 16; ++blk) { const S5Frag Fn = s5_load<false>(U, tokb + 32 * (blk < 15 ? blk + 1 : blk), g, lane);
                  s5_scan32<false>(F, nullptr, Hs, 0, tokb + 32 * blk, g, a_re, a_im, bm, cm, dfrag, Hs, h_re, h_im, lane); F = Fn; } }
            __hip_atomic_store(EX + (seg * 64 + p) * 2, h_re, __ATOMIC_RELAXED, __HIP_MEMORY_SCOPE_AGENT); __hip_atomic_store(EX + (seg * 64 + p) * 2 + 1, h_im, __ATOMIC_RELAXED, __HIP_MEMORY_SCOPE_AGENT);
            asm volatile("s_waitcnt vmcnt(0)" ::: "memory");
            __syncthreads();
            if (tid == 0) { asm volatile("s_waitcnt vmcnt(0)" ::: "memory"); __hip_atomic_fetch_add(xcnt, 1u, __ATOMIC_RELAXED, __HIP_MEMORY_SCOPE_AGENT); }
            { const int n = nb * 16 + seg;
              float s_re = st_re[((size_t)n * 64 + g) * 64 + p], s_im = st_im[((size_t)n * 64 + g) * 64 + p];
              const S5Frag F = s5_load<true>(U, MP + n * 32, g, lane);
              s5_scan32<true, true>(F, GY, STG, 0, MP + n * 32, g, a_re, a_im, bm, cm, dfrag, Hs, s_re, s_im, lane);
              out[O_HRS + ((size_t)n * 64 + g) * 64 + p] = s_re; out[O_HIS + ((size_t)n * 64 + g) * 64 + p] = s_im;
              s5_flush(STG, GY, MP + n * 32, 32, g, lane); }
            if (tid == 0) { unsigned sp = 0; while (__hip_atomic_load(xcnt, __ATOMIC_RELAXED, __HIP_MEMORY_SCOPE_AGENT) < 16u) { __builtin_amdgcn_s_sleep(2); if (++sp > (1u << 22)) break; }
                __builtin_amdgcn_fence(__ATOMIC_ACQUIRE, "agent"); asm volatile("s_waitcnt vmcnt(0)" ::: "memory"); }
            __syncthreads();
            const float pw_re = APOW[(g * 64 + p) * 2], pw_im = APOW[(g * 64 + p) * 2 + 1];
            h_re = 0.f; h_im = 0.f;
            { float er[15], ei[15];
#pragma unroll
              for (int s2 = 0; s2 < 15; ++s2) { er[s2] = 0.f; ei[s2] = 0.f;
                  if (s2 < seg) { er[s2] = __hip_atomic_load(EX + (s2 * 64 + p) * 2, __ATOMIC_RELAXED, __HIP_MEMORY_SCOPE_AGENT); ei[s2] = __hip_atomic_load(EX + (s2 * 64 + p) * 2 + 1, __ATOMIC_RELAXED, __HIP_MEMORY_SCOPE_AGENT); } }
#pragma unroll
              for (int s2 = 0; s2 < 15; ++s2) if (s2 < seg) { const float nre = pw_re * h_re - pw_im * h_im + er[s2], nim = pw_re * h_im + pw_im * h_re + ei[s2]; h_re = nre; h_im = nim; } }
            { S5Frag F = s5_load<true>(U, tokb, g, lane);
#pragma unroll 1
              for (int ob = 0; ob < 4; ++ob) {
#pragma unroll 1
                for (int ib = 0; ib < 4; ++ib) { const int blk = ob * 4 + ib; const S5Frag Fn = s5_load<true>(U, tokb + 32 * (blk < 15 ? blk + 1 : blk), g, lane);
                  s5_scan32<true, PSTAGE>(F, GY, STG, ib * 32, tokb + 32 * blk, g, a_re, a_im, bm, cm, dfrag, Hs, h_re, h_im, lane); F = Fn; }
                if (PSTAGE) s5_flush(STG, GY, tokb + 128 * ob, 128, g, lane); } }
            if (seg == 15) { out[O_HRP + (size_t)(nb * 64 + g) * 64 + p] = h_re; out[O_HIP + (size_t)(nb * 64 + g) * 64 + p] = h_im; }
        }
    }
    GRID_SYNC();

    if (PHMASK & 8) {
        PHASE_PTRS
        const int tid = opaque_tid(wave), lane = tid & 63;
        for (int rep_ = 0; rep_ < REPS(256); ++rep_) { if (rep_) GRID_SYNC(); pg8::Gemm g{GY, Wglu_t, MT, 1024, 1024, 1024}; pg8::StaticOrder S; S.init(MT, 1024, G, bx);
          EpiGlu E{GY, MIX, SSQ1};
          pg8::gemm_phase<EpiGlu, pg8::StaticOrder>(lds, g, S, E, wave); }
        __syncthreads();
#pragma unroll 1
        for (int st_ = 0; st_ < 3; ++st_) {
        const int role_ = (bx & 1) ? (st_ == 0 ? 1 : st_ == 1 ? 0 : 2) : st_;
        if (role_ == 0) {
        for (int rep_ = 0; rep_ < REPS(512); ++rep_) for (int item = bx; item < DB * NH; item += G) {
            const int n = item >> 3, h = item & 7;
            const int tid = opaque_tid(wave), lane = tid & 63;
            const int r32 = lane & 31, hi = lane >> 5;
            LAS float* CLs = (LAS float*)(lds + AUX_OFF);
            LAS float* red = CLs + 2096;
            { const float* lfc = cache_logf + ((size_t)n * PAST) * 8 + h;
              float loc[4]; float s = 0.f;
#pragma unroll
              for (int i = 0; i < 4; ++i) { loc[i] = lfc[(size_t)(tid * 4 + i) * 8]; s += loc[i]; }
              const float inc = wave_incl_scan(s);
              float gm = 0.f; if (tid < 128) gm = fabsf(IN(19)[tid] * IN(20)[tid]);
              gm = wave_max(gm);
              if (lane == 63) red[wave] = inc;
              if (lane == 0) red[16 + wave] = gm;
              __syncthreads();
              float base = inc - s; float tot = 0.f;
              for (int w2 = 0; w2 < 8; ++w2) { const float rv = red[w2]; if (w2 < wave) base += rv; tot += rv; }
              float run = base;
#pragma unroll
              for (int i = 0; i < 4; ++i) { run += loc[i]; CLs[tid * 4 + i] = run * LOG2E; }
              if (wave == 0) { float v = (lane < 32) ? out[O_LFS + (size_t)(n * 32 + lane) * 8 + h] : 0.f;
                  v = wave_incl_scan(v);
                  if (lane < 32) CLs[2048 + lane] = (tot + v) * LOG2E; }
              __syncthreads(); }
            const float MB = fmaxf(red[16], red[17]) * 11.313708498984761f * LOG2E;
            int kb_lo;
            { const float thr = 2.f * MB + 37.f; const float ce = CLs[lane * 32 + 31];
              kb_lo = __builtin_amdgcn_readfirstlane(wave_min_i((CLs[2048] - ce >= -thr) ? lane : 64)); }
            const fox::srd_t sK = fox::mksrd(cache_k, (unsigned)DB * PAST * NH * HD * 4u), sV = fox::mksrd(cache_v, (unsigned)DB * PAST * NH * HD * 4u);
            const fox::srd_t sQh = fox::mksrd(Qh, 34u * 1048576u), sKh = fox::mksrd(Kh, 34u * 1048576u), sVh = fox::mksrd(Vh, 34u * 1048576u);
            const unsigned onew = (unsigned)(2 * NH * SEQ * HD + (n * NH + h) * DSEQ * HD) * 2u;
            bf16x8 qf[8];
#pragma unroll
            for (int d0 = 0; d0 < 8; ++d0) qf[d0] = fox::bload8(sQh, (unsigned)((r32 * HD + 64 * hi + 8 * d0) * 2), onew);
            bf16x8 qx;
            { unsigned short a, bb, c; split3(CLs[2048 + r32] - MB, a, bb, c);
              u32x4 w = {0x3F803F80u, 0x3F80u | ((unsigned)a << 16), (unsigned)bb | ((unsigned)c << 16), 0u}; if (hi) w = (u32x4){0u, 0u, 0u, 0u};
              qx = __builtin_bit_cast(bf16x8, w); }
            f32x16 o[4] = {}; float l_reg = 0.f;
            const unsigned vok = (unsigned)(r32 * (NH * HD * 4) + hi * 256), vov = (unsigned)(hi * 4 * (NH * HD * 4) + r32 * 4);
            const unsigned vokn = (unsigned)((r32 * HD + 64 * hi) * 2), vovn = (unsigned)((hi * 4 * HD + r32) * 2);
#pragma unroll 1
            for (int kb = kb_lo + wave; kb < 65; kb += 8) {
                unsigned vok_ = vok, vokn_ = vokn, vovn_ = vovn, vqv = (unsigned)hi * (NH * HD * 4) + (unsigned)r32 * 16u;
                asm volatile("" : "+v"(vok_), "+v"(vokn_), "+v"(vovn_), "+v"(vqv));
                f32x16 sc = {};
                bf16x8 kx;
                { unsigned short a, bb, c; const float clk = CLs[kb * 32 + r32]; split3(-clk, a, bb, c);
                  u32x4 w = {(unsigned)a | ((unsigned)bb << 16), (unsigned)c | (0x3F80u << 16), 0x3F803F80u, 0u}; if (hi) w = (u32x4){0u, 0u, 0u, 0u};
                  kx = __builtin_bit_cast(bf16x8, w); }
                const unsigned sob = (unsigned)(((n * PAST + kb * 32) * NH + h) * HD) * 4u;
                if (kb < 64) {
                    bf16x8 kf8[8];
                    { f32x4 kr[8][2];
#pragma unroll
                      for (int d0 = 0; d0 < 8; ++d0) {
                          kr[d0][0] = __builtin_bit_cast(f32x4, __builtin_amdgcn_raw_buffer_load_b128(sK, (int)(vok_ + d0 * 32), (int)sob, 0));
                          kr[d0][1] = __builtin_bit_cast(f32x4, __builtin_amdgcn_raw_buffer_load_b128(sK, (int)(vok_ + d0 * 32 + 16), (int)sob, 0)); }
                      asm volatile("" : "+v"(kr[0][0]), "+v"(kr[0][1]), "+v"(kr[1][0]), "+v"(kr[1][1]), "+v"(kr[2][0]), "+v"(kr[2][1]), "+v"(kr[3][0]), "+v"(kr[3][1]),
                                        "+v"(kr[4][0]), "+v"(kr[4][1]), "+v"(kr[5][0]), "+v"(kr[5][1]), "+v"(kr[6][0]), "+v"(kr[6][1]), "+v"(kr[7][0]), "+v"(kr[7][1]));
#pragma unroll
                      for (int d0 = 0; d0 < 8; ++d0) kf8[d0] = pack8(kr[d0][0], kr[d0][1]); }
#pragma unroll
                    for (int d0 = 0; d0 < 8; ++d0) sc = __builtin_amdgcn_mfma_f32_32x32x16_bf16(kf8[d0], qf[d0], sc, 0, 0, 0);
                    asm volatile("s_nop 15\n\ts_nop 15" :: "v"(kf8[0]), "v"(kf8[1]), "v"(kf8[2]), "v"(kf8[3]), "v"(kf8[4]), "v"(kf8[5]), "v"(kf8[6]), "v"(kf8[7]));
                } else {
                    { bf16x8 kn8[8];
#pragma unroll
                      for (int d0 = 0; d0 < 8; ++d0) kn8[d0] = fox::bload8(sKh, vokn_ + d0 * 16, onew);
                      asm volatile("" : "+v"(kn8[0]), "+v"(kn8[1]), "+v"(kn8[2]), "+v"(kn8[3]), "+v"(kn8[4]), "+v"(kn8[5]), "+v"(kn8[6]), "+v"(kn8[7]));
#pragma unroll
                      for (int d0 = 0; d0 < 8; ++d0) sc = __builtin_amdgcn_mfma_f32_32x32x16_bf16(kn8[d0], qf[d0], sc, 0, 0, 0);
                      asm volatile("s_nop 15\n\ts_nop 15" :: "v"(kn8[0]), "v"(kn8[1]), "v"(kn8[2]), "v"(kn8[3]), "v"(kn8[4]), "v"(kn8[5]), "v"(kn8[6]), "v"(kn8[7])); }
                }
                sc = __builtin_amdgcn_mfma_f32_32x32x16_bf16(kx, qx, sc, 0, 0, 0);
                if (kb == 64) {
#pragma unroll
                    for (int r = 0; r < 16; ++r) if (fox::crow(r, hi) > r32) sc[r] = -__builtin_inff();
                }
                float ps = 0.f;
#pragma unroll
                for (int r = 0; r < 16; ++r) { sc[r] = __builtin_amdgcn_exp2f(sc[r]); ps += sc[r]; }
                l_reg += ps;
                bf16x8 pa[2];
#pragma unroll
                for (int ks = 0; ks < 2; ++ks) { u32x4 w = {cvtpk(sc[8 * ks + 0], sc[8 * ks + 1]), cvtpk(sc[8 * ks + 2], sc[8 * ks + 3]), cvtpk(sc[8 * ks + 4], sc[8 * ks + 5]), cvtpk(sc[8 * ks + 6], sc[8 * ks + 7])};
                    pa[ks] = __builtin_bit_cast(bf16x8, w); }
                if (kb < 64) {
                    unsigned vta = (unsigned)(uintptr_t)lds + (unsigned)wave * 4224u + (unsigned)hi * 264u + (unsigned)r32 * 8u; asm volatile("" : "+v"(vta));
                    unsigned vra = (unsigned)(uintptr_t)lds + (unsigned)wave * 4224u + (unsigned)hi * (4u * 264u) + (unsigned)r32 * 2u; asm volatile("" : "+v"(vra));
                    LAS unsigned char* vtp = (LAS unsigned char*)(uintptr_t)vta; const LAS unsigned char* vrp = (const LAS unsigned char*)(uintptr_t)vra;
#pragma unroll
                    for (int ks = 0; ks < 2; ++ks) {
                        asm volatile("s_waitcnt lgkmcnt(0)" ::: "memory");
#pragma unroll
                        for (int qv = 0; qv < 2; ++qv) { f32x4 va[4];
#pragma unroll
                            for (int i = 0; i < 4; ++i) va[i] = __builtin_bit_cast(f32x4, __builtin_amdgcn_raw_buffer_load_b128(sV, (int)vqv, (int)(sob + (16 * ks + 8 * qv + 2 * i) * (NH * HD * 4)), 0));
                            asm volatile("" : "+v"(va[0]), "+v"(va[1]), "+v"(va[2]), "+v"(va[3]));
#pragma unroll
                            for (int i = 0; i < 4; ++i) { u32x2 w2; w2.x = cvtpk(va[i][0], va[i][1]); w2.y = cvtpk(va[i][2], va[i][3]); *(LAS u32x2*)(vtp + (8 * qv + 2 * i) * 264) = w2; } }
                        asm volatile("s_waitcnt lgkmcnt(0)" ::: "memory");
                        bf16x8 vw[4];
#pragma unroll
                        for (int d0 = 0; d0 < 4; ++d0) { u32x4 w;
#pragma unroll
                            for (int jj = 0; jj < 4; ++jj) { const int klo = 8 * (jj >> 1) + 2 * (jj & 1);
                                const unsigned lo16 = *(const LAS unsigned short*)(vrp + klo * 264 + d0 * 64), hi16 = *(const LAS unsigned short*)(vrp + (klo + 1) * 264 + d0 * 64);
                                w[jj] = lo16 | (hi16 << 16); }
                            vw[d0] = __builtin_bit_cast(bf16x8, w); }
                        asm volatile("" : "+v"(vw[0]), "+v"(vw[1]), "+v"(vw[2]), "+v"(vw[3]));
#pragma unroll
                        for (int d0 = 0; d0 < 4; ++d0) o[d0] = __builtin_amdgcn_mfma_f32_32x32x16_bf16(pa[ks], vw[d0], o[d0], 0, 0, 0);
                        asm volatile("s_nop 15\n\ts_nop 15" : "+v"(o[3]) : "v"(vw[0]), "v"(vw[1]), "v"(vw[2]), "v"(vw[3]), "v"(pa[ks]));
                    }
                } else {
                    unsigned vna = (unsigned)(uintptr_t)lds + (unsigned)wave * 4224u + (unsigned)(lane >> 4) * 264u + (unsigned)(lane & 15) * 16u; asm volatile("" : "+v"(vna));
                    unsigned vra = (unsigned)(uintptr_t)lds + (unsigned)wave * 4224u + (unsigned)hi * (4u * 264u) + (unsigned)r32 * 2u; asm volatile("" : "+v"(vra));
                    unsigned vnq = (unsigned)(lane >> 4) * 256u + (unsigned)(lane & 15) * 16u; asm volatile("" : "+v"(vnq));
                    LAS unsigned char* vnp = (LAS unsigned char*)(uintptr_t)vna; const LAS unsigned char* vrp = (const LAS unsigned char*)(uintptr_t)vra;
#pragma unroll
                    for (int ks = 0; ks < 2; ++ks) {
                        u32x4 vn4[4];
#pragma unroll
                        for (int i = 0; i < 4; ++i) vn4[i] = __builtin_amdgcn_raw_buffer_load_b128(sVh, (int)vnq, (int)(onew + (16 * ks + 4 * i) * (HD * 2)), 0);
                        asm volatile("" : "+v"(vn4[0]), "+v"(vn4[1]), "+v"(vn4[2]), "+v"(vn4[3]));
                        asm volatile("s_waitcnt lgkmcnt(0)" ::: "memory");
#pragma unroll
                        for (int i = 0; i < 4; ++i) { *(LAS u32x2*)(vnp + (4 * i) * 264) = (u32x2){vn4[i][0], vn4[i][1]}; *(LAS u32x2*)(vnp + (4 * i) * 264 + 8) = (u32x2){vn4[i][2], vn4[i][3]}; }
                        asm volatile("s_waitcnt lgkmcnt(0)" ::: "memory");
                        bf16x8 vw[4];
#pragma unroll
                        for (int d0 = 0; d0 < 4; ++d0) { u32x4 w;
#pragma unroll
                            for (int jj = 0; jj < 4; ++jj) { const int klo = 8 * (jj >> 1) + 2 * (jj & 1);
                                const unsigned lo16 = *(const LAS unsigned short*)(vrp + klo * 264 + d0 * 64), hi16 = *(const LAS unsigned short*)(vrp + (klo + 1) * 264 + d0 * 64);
                                w[jj] = lo16 | (hi16 << 16); }
                            vw[d0] = __builtin_bit_cast(bf16x8, w); }
                        asm volatile("" : "+v"(vw[0]), "+v"(vw[1]), "+v"(vw[2]), "+v"(vw[3]));
#pragma unroll
                        for (int d0 = 0; d0 < 4; ++d0) o[d0] = __builtin_amdgcn_mfma_f32_32x32x16_bf16(pa[ks], vw[d0], o[d0], 0, 0, 0);
                        asm volatile("s_nop 15\n\ts_nop 15" : "+v"(o[3]) : "v"(vw[0]), "v"(vw[1]), "v"(vw[2]), "v"(vw[3]), "v"(pa[ks]));
                    }
                }
                asm volatile("s_nop 15\n\ts_nop 15" : "+v"(o[3]));
            }
            __syncthreads();
            { const int tid = opaque_tid(wave), lane = tid & 63, r32 = lane & 31, hi = lane >> 5;
            LAS float* R = (LAS float*)lds;
#pragma unroll
            for (int d0 = 0; d0 < 4; ++d0)
#pragma unroll
                for (int r = 0; r < 16; ++r) R[(wave * 64 + d0 * 16 + r) * 64 + lane] = o[d0][r];
            red[32 + wave * 64 + lane] = l_reg;
            __syncthreads();
            float lt = 0.f;
#pragma unroll
            for (int w2 = 0; w2 < 8; ++w2) lt += red[32 + w2 * 64 + lane];
            { auto rr = __builtin_amdgcn_permlane32_swap(__float_as_uint(lt), __float_as_uint(lt), false, false); lt = __uint_as_float(rr[0]) + __uint_as_float(rr[1]); }
            float acc8[8];
#pragma unroll
            for (int k = 0; k < 8; ++k) { float a = 0.f;
#pragma unroll
                for (int w2 = 0; w2 < 8; ++w2) a += R[(w2 * 64 + wave * 8 + k) * 64 + lane];
                acc8[k] = a; }
            __syncthreads();
            LAS float* Of = (LAS float*)lds; LAS float* Lq = Of + 32 * 128;
            if (wave == 0 && hi == 0) Lq[r32] = lt;
            __syncthreads();
#pragma unroll
            for (int k = 0; k < 8; ++k) { const int r = 8 * (wave & 1) + k, q = fox::crow(r, hi); Of[q * 128 + (wave >> 1) * 32 + r32] = acc8[k] * __builtin_amdgcn_rcpf(Lq[q]); }
            __syncthreads();
            { const int q = wave * 4 + (lane >> 4), c8 = (lane & 15) * 8; const f32x4 a0 = *(const LAS f32x4*)(Of + q * 128 + c8), a1 = *(const LAS f32x4*)(Of + q * 128 + c8 + 4);
              float sq = (a0[0] * a0[0] + a0[1] * a0[1]) + (a0[2] * a0[2] + a0[3] * a0[3]) + (a1[0] * a1[0] + a1[1] * a1[1]) + (a1[2] * a1[2] + a1[3] * a1[3]);
              sq += lane_xor<1>(sq); sq += lane_xor<2>(sq); sq += lane_xor<4>(sq); sq += lane_xor<8>(sq);
              const size_t tok = (size_t)MP + n * 32 + q;
              *(bf16x8*)(MIX + tok * DM + 1024 + h * HD + c8) = pack8(a0, a1);
              if ((lane & 15) == 0) SSQ2[tok * 8 + h] = sq; }
            }
            __syncthreads();
        }
        } else {
        for (int rep_ = 0; rep_ < REPS(1024); ++rep_) for (int Lw = bx; Lw < 256; Lw += G) {
            const int L = (Lw & 7) * 32 + (Lw >> 3); const int bh = L >> 4, x = L & 15, qb_ = role_ == 1 ? x : 31 - x;
            const fox::Ctx FC{fox::mksrd(ws, (unsigned)WS_TOTAL), ws};
            fox::Seam Sm;
            const int lane_p = opaque_tid(wave) & 63; const int jl_ = fox::tile_lo(FC, bh, qb_, lane_p);
            fox::prime(FC, bh, qb_, jl_, (LAS char*)lds, Sm, wave);
            fox::block(FC, bh, qb_, jl_, qb_, jl_, (LAS char*)lds, Sm, wave);
            fox::finish(Sm);
        }
        }
        }
    }
    GRID_SYNC();

    for (int rep_ = 0; rep_ < REPS(16); ++rep_) { if (rep_) GRID_SYNC();
        PHASE_PTRS
        const int tid = opaque_tid(wave), lane = tid & 63;
        const bool tailfill = (G == 256);
        unsigned* cntS = (unsigned*)(ws + 32768 + 512);
        LAS float* RT = (LAS float*)(lds + AUX_OFF);
#define P4_RT(i_, pm_) do { if (tid < 256) { const int row = (pm_) * 256 + tid; float a = 0.f, c = 0.f; \
              _Pragma("unroll") for (int k = 0; k < 16; ++k) a += SSQ1[(size_t)row * 16 + k]; \
              _Pragma("unroll") for (int k = 0; k < 8; ++k) c += SSQ2[(size_t)row * 8 + k]; \
              const float rA = 1.0f / sqrtf(a * (1.0f / 1024.f) + EPS), rB = 1.0f / sqrtf(c * (1.0f / 1024.f) + EPS); \
              RT[((i_) * 256 + tid) * 2] = rA / rB; RT[((i_) * 256 + tid) * 2 + 1] = rB; } } while (0)
        const pg8::Gemm g{MIX, Wout_t, MT, DM, DM, DM};
        if (tailfill) {
            const pg8::OneUnit S1{64 + (bx >> 3), bx & 7, bx < 32};
            if (bx < 32) { P4_RT(0, S1.pm); }
            __syncthreads();
            { EpiOut E{XB, out, X1B, SSQ3, RT, true}; pg8::gemm_phase<EpiOut, pg8::OneUnit>(lds, g, S1, E, wave); }
            if (bx < 32 && threadIdx.x == 0) { asm volatile("s_waitcnt vmcnt(0)" ::: "memory"); __hip_atomic_fetch_add(cntS, 1u, __ATOMIC_RELAXED, __HIP_MEMORY_SCOPE_AGENT); }
            __syncthreads();
        }
        { pg8::StaticOrder S; S.init(tailfill ? MP : MT, DM, G, bx);
          { pg8::Unit u; for (int i = 0; S.next(i, u); ++i) P4_RT(i, u.pm); }
          __syncthreads();
          EpiOut E{XB, out, X1B, SSQ3, RT, false};
          pg8::gemm_phase<EpiOut, pg8::StaticOrder>(lds, g, S, E, wave); }
#undef P4_RT
        if (tailfill && bx >= 32 && bx < 160) {
            slab_wait(cntS, 32u);
            const int j = bx - 32; const pg8::OneUnit S2{64 + (j >> 5), j & 31, true};
            LAS float* RT2 = (LAS float*)(lds + AUX_OFF);
            if (tid < 256) { const int row = S2.pm * 256 + tid; float a = 0.f;
#pragma unroll
                for (int k = 0; k < 32; ++k) a += SSQ3[(size_t)row * 32 + k];
                RT2[tid] = 1.0f / sqrtf(a * (1.0f / DM) + EPS); }
            __syncthreads();
            const pg8::Gemm g2{X1B, Wup_t, MT, DFF, DM, DM}; EpiUp E2{Hb, RT2};
            pg8::gemm_phase<EpiUp, pg8::OneUnit>(lds, g2, S2, E2, wave);
        }
        { const int fi = tailfill ? bx - 160 : bx, nfree = tailfill ? 96 : G;
          if (fi >= 0) { const int lane2 = opaque_tid(wave) & 63; LAS float* scr = (LAS float*)(lds + wave * 16384);
              for (int it = fi * 8 + wave; it < 128 * 64; it += nfree * 8) p0_transpose_item(IN(26), DM, DFF, 64, nullptr, nullptr, Wdn_t, scr, it, lane2); } }
    }
    GRID_SYNC();

    for (int rep_ = 0; rep_ < REPS(32); ++rep_) { if (rep_) GRID_SYNC();
        PHASE_PTRS
        const int tid = opaque_tid(wave), lane = tid & 63;
        pg8::StaticOrder S; S.init(G == 256 ? MP : MT, DFF, G, bx);
        LAS float* RT = (LAS float*)(lds + AUX_OFF);
        if (G == 256) {
            const int rowl = tid & 255, hf = wave >> 2; pg8::Unit u; f32x4 sv[4][8];
#pragma unroll
            for (int j = 0; j < 4; ++j) { S.next(2 * j + hf, u); const float* p = SSQ3 + (size_t)(u.pm * 256 + rowl) * 32;
#pragma unroll
                for (int q = 0; q < 8; ++q) sv[j][q] = *(const f32x4*)(p + 4 * q); }
#pragma unroll
            for (int j = 0; j < 4; ++j) asm volatile("" : "+v"(sv[j][0]), "+v"(sv[j][1]), "+v"(sv[j][2]), "+v"(sv[j][3]), "+v"(sv[j][4]), "+v"(sv[j][5]), "+v"(sv[j][6]), "+v"(sv[j][7]));
#pragma unroll
            for (int j = 0; j < 4; ++j) { f32x4 t = sv[j][0];
#pragma unroll
                for (int q = 1; q < 8; ++q) t += sv[j][q];
                RT[(2 * j + hf) * 256 + rowl] = 1.0f / sqrtf(((t[0] + t[1]) + (t[2] + t[3])) * (1.0f / DM) + EPS); }
        } else { pg8::Unit u;
          for (int i = 0; S.next(i, u); ++i) if (tid < 256) { const int row = u.pm * 256 + tid; float a = 0.f;
#pragma unroll
              for (int k = 0; k < 32; ++k) a += SSQ3[(size_t)row * 32 + k];
              RT[i * 256 + tid] = 1.0f / sqrtf(a * (1.0f / DM) + EPS); } }
        __syncthreads();
        pg8::Gemm g{X1B, Wup_t, MT, DFF, DM, DM};
        EpiUp E{Hb, RT};
        pg8::gemm_phase<EpiUp, pg8::StaticOrder>(lds, g, S, E, wave);
    }
    GRID_SYNC();

    if (PHMASK & 64) {
        PHASE_PTRS
        float* SL = (float*)(ws + WS_QKRAW); unsigned* slab_cnt = (unsigned*)(ws + 32768);
        const bool split = (G == 256);
        if (split) { pg8::Gemm g{Hb, Wdn_t, MT, DM, DFF / 8, DFF}; pg8::SplitOrder S{bx, DFF / 8}; EpiDownSlab E{SL, DFF / 8};
            pg8::gemm_phase<EpiDownSlab, pg8::SplitOrder>(lds, g, S, E, wave);
            if (threadIdx.x == 0) { asm volatile("s_waitcnt vmcnt(0)" ::: "memory");
                __hip_atomic_fetch_add(slab_cnt, 1u, __ATOMIC_RELAXED, __HIP_MEMORY_SCOPE_AGENT); } }
        { pg8::Gemm g{Hb, Wdn_t, MT, DM, DFF, DFF}; pg8::StaticOrder S; S.init(split ? MP : MT, DM, G, bx);
          EpiDown E{out, X1B};
          pg8::gemm_phase<EpiDown, pg8::StaticOrder>(lds, g, S, E, wave); }
        if (split) {
            if (threadIdx.x == 0) { unsigned sp = 0; while (__hip_atomic_load(slab_cnt, __ATOMIC_RELAXED, __HIP_MEMORY_SCOPE_AGENT) < 256u) { __builtin_amdgcn_s_sleep(2); if (++sp > (1u << 22)) break; }
                __builtin_amdgcn_fence(__ATOMIC_ACQUIRE, "agent"); asm volatile("s_waitcnt vmcnt(0)" ::: "memory"); }
            __syncthreads();
            const int tid = opaque_tid(wave); const int r = 4 * bx + (tid >> 7);
            u32x2 xw[4]; f32x4 sv[4][8];
#pragma unroll
            for (int j = 0; j < 4; ++j) { const int c = (tid & 127) * 4 + 512 * j; xw[j] = *(const u32x2*)(X1B + (size_t)(MP + r) * DM + c);
#pragma unroll
                for (int s = 0; s < 8; ++s) sv[j][s] = *(const f32x4*)(SL + (size_t)s * (MS * DM) + (size_t)r * DM + c); }
#pragma unroll
            for (int j = 0; j < 4; ++j)
                asm volatile("" : "+v"(xw[j]), "+v"(sv[j][0]), "+v"(sv[j][1]), "+v"(sv[j][2]), "+v"(sv[j][3]), "+v"(sv[j][4]), "+v"(sv[j][5]), "+v"(sv[j][6]), "+v"(sv[j][7]));
#pragma unroll
            for (int j = 0; j < 4; ++j) { const int c = (tid & 127) * 4 + 512 * j; float* yp = out + O_Y + (size_t)(MP + r) * DM + c;
                f32x4 y; y[0] = __builtin_bit_cast(float, xw[j].x << 16); y[1] = __builtin_bit_cast(float, xw[j].x & 0xffff0000u); y[2] = __builtin_bit_cast(float, xw[j].y << 16); y[3] = __builtin_bit_cast(float, xw[j].y & 0xffff0000u);
#pragma unroll
                for (int s = 0; s < 8; ++s) y += sv[j][s];
                *(f32x4*)yp = y; }
        }
    }
}

extern "C" void kernel_launch(void* const* d_in, const int* in_sizes, int n_in, void* d_out, int out_size, void* d_ws, size_t ws_size, hipStream_t stream) {
    static int grid = 0;
    if (grid == 0) {
        if (n_in != 27 || ws_size < WS_TOTAL) { fprintf(stderr, "kernel_launch: unexpected n_in %d / ws_size %zu (need %zu)\n", n_in, ws_size, (size_t)WS_TOTAL); grid = -1; return; }
        int dev = 0, cus = 0, per_cu = 0;
        hipGetDevice(&dev);
        hipDeviceGetAttribute(&cus, hipDeviceAttributeMultiprocessorCount, dev);
        hipFuncSetAttribute((const void*)hymba_fwd, hipFuncAttributeMaxDynamicSharedMemorySize, LDS_BYTES);
        hipOccupancyMaxActiveBlocksPerMultiprocessor(&per_cu, (const void*)hymba_fwd, 512, LDS_BYTES);
        if (per_cu < 1) { fprintf(stderr, "kernel_launch: occupancy query says %d blocks per CU\n", per_cu); per_cu = 1; }
        if (per_cu > 1) per_cu = 1;
        grid = cus * per_cu;
        if (grid != 256) { fprintf(stderr, "kernel_launch: this kernel's work decomposition is written for 256 workgroups (one per CU of a 256-CU device); got %d; nothing launched\n", grid); grid = -1; return; }
        fprintf(stderr, "kernel_launch: grid %d (cus %d), ws %zu\n", grid, cus, ws_size);
    }
    if (grid < 0) return;
    if (hipMemsetAsync(d_ws, 0, 65536, stream) != hipSuccess) { fprintf(stderr, "kernel_launch: hipMemsetAsync failed\n"); return; }
    Args a{};
    for (int i = 0; i < 27; ++i) a.in[i] = (const float*)d_in[i];
    a.out = (float*)d_out; a.ws = (unsigned char*)d_ws;
    void* kargs[] = {&a};
    hipError_t e = hipLaunchCooperativeKernel((const void*)hymba_fwd, dim3(grid), dim3(512), kargs, LDS_BYTES, stream);
    if (e != hipSuccess) fprintf(stderr, "kernel_launch: cooperative launch failed: %s (grid %d)\n", hipGetErrorString(e), grid);
}
```
